# Optimizing an MI355X kernel written in HIP

```python
import math
import jax, jax.numpy as jnp
from jax import lax
import numpy as np

D_MODEL = 1024
BATCH = 2
SEQ = 8192
DEPTH = 2

GRID_W = 64
CTX_LEN = 256
HEAD_DIM = 64
N_HEADS_A = 8
N_KV_A = 2
N_HEADS_B = 8
N_HEADS_C = 8
N_KV_C = 2
MIX_WIDTH = HEAD_DIM * (N_HEADS_A + N_HEADS_B + N_HEADS_C)
Q_BLOCK = 128
NB_ROWS = 8
NB_COLS = 16
WINDOW = 128
ROPE_THETA = 10000.0
EPS = 1e-6
IN_SIZES = (
    N_HEADS_A * HEAD_DIM, N_KV_A * HEAD_DIM, N_KV_A * HEAD_DIM,
    N_HEADS_B * HEAD_DIM, N_HEADS_B * HEAD_DIM, N_HEADS_B * HEAD_DIM,
    N_HEADS_C * HEAD_DIM, N_KV_C * HEAD_DIM, N_KV_C * HEAD_DIM,
    MIX_WIDTH,
)
IN_WIDTH = sum(IN_SIZES)

kernel_name = "hybrid_parallel_groups_flow_backbone"


def rmsnorm(x, w):
    xf = x.astype(jnp.float32)
    y = xf * lax.rsqrt(jnp.mean(xf * xf, axis=-1, keepdims=True) + EPS)
    return y.astype(x.dtype) * w


def softmax_f32(s, dtype):
    return jax.nn.softmax(s.astype(jnp.float32), axis=-1).astype(dtype)


def heads(z, h):
    return z.reshape(z.shape[:-1] + (h, HEAD_DIM))


def split_cols(z):
    outs, off = [], 0
    for sz in IN_SIZES:
        outs.append(z[..., off:off + sz])
        off += sz
    return outs


def axial_rope(n, dtype):
    t = jnp.arange(n, dtype=jnp.int32)
    rows = (t // GRID_W).astype(jnp.float32)
    cols = (t % GRID_W).astype(jnp.float32)
    n_freq = HEAD_DIM // 4
    freq = ROPE_THETA ** (-jnp.arange(n_freq, dtype=jnp.float32) / n_freq)
    ang = jnp.concatenate([rows[:, None] * freq, cols[:, None] * freq], axis=-1)
    return jnp.cos(ang).astype(dtype), jnp.sin(ang).astype(dtype)


def apply_rope(x, cos, sin):
    x1, x2 = jnp.split(x, 2, axis=-1)
    c = cos[None, :, None, :]
    s = sin[None, :, None, :]
    return jnp.concatenate([x1 * c - x2 * s, x1 * s + x2 * c], axis=-1)


def global_gqa(q, k, v, qc, kc, vc, cos, sin, qn, kn, need_ctx):
    B, N = q.shape[0], q.shape[1]
    C = qc.shape[1]
    G = N_HEADS_A // N_KV_A
    scale = HEAD_DIM ** -0.5
    q = apply_rope(rmsnorm(heads(q, N_HEADS_A), qn), cos, sin) * scale
    k = apply_rope(rmsnorm(heads(k, N_KV_A), kn), cos, sin)
    v = heads(v, N_KV_A)
    qc = rmsnorm(heads(qc, N_HEADS_A), qn) * scale
    kc = rmsnorm(heads(kc, N_KV_A), kn)
    vc = heads(vc, N_KV_A)
    k_all = jnp.concatenate([k, kc], axis=1)
    v_all = jnp.concatenate([v, vc], axis=1)
    nblk = N // Q_BLOCK
    qb = q.reshape(B, nblk, Q_BLOCK, N_KV_A, G, HEAD_DIM).transpose(1, 0, 2, 3, 4, 5)

    def block(qi):
        s = jnp.einsum('bqhgd,bkhd->bhgqk', qi, k_all)
        p = softmax_f32(s, v_all.dtype)
        return jnp.einsum('bhgqk,bkhd->bqhgd', p, v_all)

    y = lax.map(block, qb).transpose(1, 0, 2, 3, 4, 5).reshape(B, N, N_HEADS_A * HEAD_DIM)
    yc = None
    if need_ctx:
        qcg = qc.reshape(B, C, N_KV_A, G, HEAD_DIM)
        p = softmax_f32(jnp.einsum('bqhgd,bkhd->bhgqk', qcg, kc), vc.dtype)
        yc = jnp.einsum('bhgqk,bkhd->bqhgd', p, vc).reshape(B, C, N_HEADS_A * HEAD_DIM)
    return y, yc


def neighbourhood_attn(q, k, v, qc, kc, vc, rpb, need_ctx):
    B, N = q.shape[0], q.shape[1]
    C = qc.shape[1]
    H = N_HEADS_B
    scale = HEAD_DIM ** -0.5
    rows = N // GRID_W
    kh = min(NB_ROWS, rows)
    kw = NB_COLS
    t = jnp.arange(N, dtype=jnp.int32)
    r = t // GRID_W
    col = t % GRID_W
    rs = jnp.clip(r - kh // 2, 0, rows - kh)
    cs = jnp.clip(col - kw // 2, 0, GRID_W - kw)
    key_r = rs[:, None, None] + jnp.arange(kh, dtype=jnp.int32)[None, :, None]
    key_c = cs[:, None, None] + jnp.arange(kw, dtype=jnp.int32)[None, None, :]
    idx = (key_r * GRID_W + key_c).reshape(N, kh * kw)
    rel = ((key_r - r[:, None, None] + NB_ROWS - 1) * (2 * NB_COLS - 1)
           + (key_c - col[:, None, None] + NB_COLS - 1)).reshape(N, kh * kw)
    rpb_flat = rpb.reshape(H, -1)
    q = heads(q, H) * scale
    k = heads(k, H)
    v = heads(v, H)
    qc = heads(qc, H) * scale
    kc = heads(kc, H)
    vc = heads(vc, H)
    nblk = N // Q_BLOCK
    kn = kh * kw
    xs = (q.reshape(B, nblk, Q_BLOCK, H, HEAD_DIM).transpose(1, 0, 2, 3, 4),
          idx.reshape(nblk, Q_BLOCK, kn), rel.reshape(nblk, Q_BLOCK, kn))

    def block(args):
        qi, ii, ri = args
        kg = jnp.take(k, ii, axis=1)
        vg = jnp.take(v, ii, axis=1)
        s_nb = jnp.einsum('bqhd,bqkhd->bhqk', qi, kg) + jnp.take(rpb_flat, ri, axis=1)[None]
        s_ctx = jnp.einsum('bqhd,bchd->bhqc', qi, kc)
        p = softmax_f32(jnp.concatenate([s_nb, s_ctx], axis=-1), v.dtype)
        return (jnp.einsum('bhqk,bqkhd->bqhd', p[..., :kn], vg)
                + jnp.einsum('bhqc,bchd->bqhd', p[..., kn:], vc))

    y = lax.map(block, xs).transpose(1, 0, 2, 3, 4).reshape(B, N, H * HEAD_DIM)
    yc = None
    if need_ctx:
        p = softmax_f32(jnp.einsum('bqhd,bchd->bhqc', qc, kc), vc.dtype)
        yc = jnp.einsum('bhqc,bchd->bqhd', p, vc).reshape(B, C, H * HEAD_DIM)
    return y, yc


def window_gqa(q, k, v, qc, kc, vc, cos, sin, sink, need_ctx):
    B, N = q.shape[0], q.shape[1]
    C = qc.shape[1]
    G = N_HEADS_C // N_KV_C
    scale = HEAD_DIM ** -0.5
    q = (apply_rope(heads(q, N_HEADS_C), cos, sin) * scale).reshape(B, N, N_KV_C, G, HEAD_DIM)
    k = apply_rope(heads(k, N_KV_C), cos, sin)
    v = heads(v, N_KV_C)
    qc = (heads(qc, N_HEADS_C) * scale).reshape(B, C, N_KV_C, G, HEAD_DIM)
    kc = heads(kc, N_KV_C)
    vc = heads(vc, N_KV_C)
    pad = ((0, 0), (WINDOW, WINDOW), (0, 0), (0, 0))
    kp = jnp.pad(k, pad)
    vp = jnp.pad(v, pad)
    span = Q_BLOCK + 2 * WINDOW
    sink_l = sink.astype(jnp.float32).reshape(N_KV_C, G)
    neg = jnp.finfo(jnp.float32).min
    nblk = N // Q_BLOCK
    qs = q.reshape(B, nblk, Q_BLOCK, N_KV_C, G, HEAD_DIM).transpose(1, 0, 2, 3, 4, 5)

    def block(args):
        i, qi = args
        start = i * Q_BLOCK
        kb = lax.dynamic_slice_in_dim(kp, start, span, axis=1)
        vb = lax.dynamic_slice_in_dim(vp, start, span, axis=1)
        qpos = start + jnp.arange(Q_BLOCK, dtype=jnp.int32)
        kpos = start - WINDOW + jnp.arange(span, dtype=jnp.int32)
        valid = (jnp.abs(qpos[:, None] - kpos[None, :]) <= WINDOW) & (kpos >= 0)[None, :] & (kpos < N)[None, :]
        s = jnp.where(valid, jnp.einsum('bqhgd,bkhd->bhgqk', qi, kb).astype(jnp.float32), neg)
        s_ctx = jnp.einsum('bqhgd,bkhd->bhgqk', qi, kc).astype(jnp.float32)
        s_sink = jnp.broadcast_to(sink_l[None, :, :, None, None], s.shape[:-1] + (1,))
        p = softmax_f32(jnp.concatenate([s, s_ctx, s_sink], axis=-1), v.dtype)
        return (jnp.einsum('bhgqk,bkhd->bqhgd', p[..., :span], vb)
                + jnp.einsum('bhgqk,bkhd->bqhgd', p[..., span:span + C], vc))

    y = lax.map(block, (jnp.arange(nblk, dtype=jnp.int32), qs))
    y = y.transpose(1, 0, 2, 3, 4, 5).reshape(B, N, N_HEADS_C * HEAD_DIM)
    yc = None
    if need_ctx:
        s = jnp.einsum('bqhgd,bkhd->bhgqk', qc, kc).astype(jnp.float32)
        s_sink = jnp.broadcast_to(sink_l[None, :, :, None, None], s.shape[:-1] + (1,))
        p = softmax_f32(jnp.concatenate([s, s_sink], axis=-1), vc.dtype)
        yc = jnp.einsum('bhgqk,bkhd->bqhgd', p[..., :C], vc).reshape(B, C, N_HEADS_C * HEAD_DIM)
    return y, yc


def layer(x, cx, c_silu, cctx_silu, norm_w, ada_w, ada_b, w_in, w_out, qn, kn, rpb, sink, cos, sin, need_ctx):
    mod = c_silu @ ada_w + ada_b
    mod_c = cctx_silu @ ada_w + ada_b
    shift, scale, gate = jnp.split(mod, 3, axis=-1)
    shift_c, scale_c, gate_c = jnp.split(mod_c, 3, axis=-1)
    hx = rmsnorm(x, norm_w) * (1 + scale[:, None, :]) + shift[:, None, :]
    hc = rmsnorm(cx, norm_w) * (1 + scale_c) + shift_c
    px = split_cols(hx @ w_in)
    pc = split_cols(hc @ w_in)
    ya, yca = global_gqa(px[0], px[1], px[2], pc[0], pc[1], pc[2], cos, sin, qn, kn, need_ctx)
    yb, ycb = neighbourhood_attn(px[3], px[4], px[5], pc[3], pc[4], pc[5], rpb, need_ctx)
    yc_, ycc = window_gqa(px[6], px[7], px[8], pc[6], pc[7], pc[8], cos, sin, sink, need_ctx)
    ux = jnp.concatenate([ya, yb, yc_], axis=-1) * jax.nn.silu(px[9])
    x = x + gate[:, None, :] * (ux @ w_out)
    if need_ctx:
        uc = jnp.concatenate([yca, ycb, ycc], axis=-1) * jax.nn.silu(pc[9])
        cx = cx + gate_c * (uc @ w_out)
    return x, cx


def setup_inputs(seed: int = 0) -> dict:
    key = jax.random.key(seed)
    ks = jax.random.split(key, 14)
    f32 = jnp.float32
    n_rel = (2 * NB_ROWS - 1, 2 * NB_COLS - 1)
    return {
        "x": jax.random.normal(ks[0], (BATCH, SEQ, D_MODEL), f32),
        "c": jax.random.normal(ks[1], (BATCH, D_MODEL), f32),
        "ctx": jax.random.normal(ks[2], (BATCH, CTX_LEN, D_MODEL), f32),
        "c_ctx": jax.random.normal(ks[3], (D_MODEL,), f32),
        "norm_w": 1.0 + 0.05 * jax.random.normal(ks[4], (DEPTH, D_MODEL), f32),
        "ada_w": jax.random.normal(ks[5], (DEPTH, D_MODEL, 3 * D_MODEL), f32) * D_MODEL ** -0.5,
        "ada_b": 0.02 * jax.random.normal(ks[6], (DEPTH, 3 * D_MODEL), f32),
        "w_in": jax.random.normal(ks[7], (DEPTH, D_MODEL, IN_WIDTH), f32) * D_MODEL ** -0.5,
        "w_out": jax.random.normal(ks[8], (DEPTH, MIX_WIDTH, D_MODEL), f32) * MIX_WIDTH ** -0.5,
        "q_norm_a": 1.0 + 0.05 * jax.random.normal(ks[9], (DEPTH, HEAD_DIM), f32),
        "k_norm_a": 1.0 + 0.05 * jax.random.normal(ks[10], (DEPTH, HEAD_DIM), f32),
        "rpb_b": 0.1 * jax.random.normal(ks[11], (DEPTH, N_HEADS_B) + n_rel, f32),
        "sink_c": 0.5 * jax.random.normal(ks[12], (DEPTH, N_HEADS_C), f32),
        "final_norm_w": 1.0 + 0.05 * jax.random.normal(ks[13], (D_MODEL,), f32),
    }


def reference(x, c, ctx, c_ctx, norm_w, ada_w, ada_b, w_in, w_out, q_norm_a, k_norm_a, rpb_b, sink_c, final_norm_w):
    n_tok = x.shape[1]
    cos, sin = axial_rope(n_tok, x.dtype)
    c_silu = jax.nn.silu(c)
    cctx_silu = jax.nn.silu(c_ctx)
    cx = ctx
    for l in range(DEPTH):
        x, cx = layer(x, cx, c_silu, cctx_silu, norm_w[l], ada_w[l], ada_b[l], w_in[l], w_out[l],
                      q_norm_a[l], k_norm_a[l], rpb_b[l], sink_c[l], cos, sin, l < DEPTH - 1)
    return rmsnorm(x, final_norm_w)
```

```cpp
#include <hip/hip_runtime.h>
#include <cstdint>
#include <cstdio>

typedef unsigned short bf16_t;
typedef short bf16x8 __attribute__((ext_vector_type(8)));
typedef float f32x4 __attribute__((ext_vector_type(4)));
typedef unsigned u32x4 __attribute__((ext_vector_type(4)));

constexpr int DM = 1024, NB = 2, SEQ = 8192, CTX = 256;
constexpr int ML = NB * SEQ;
constexpr int MT = ML + NB * CTX;
constexpr int NIN = 4608, MIX = 1536;
constexpr int C_QA = 0, C_KA = 512, C_VA = 640, C_QB = 768, C_KB = 1280, C_VB = 1792, C_QC = 2304, C_KC = 2816, C_VC = 2944, C_G = 3072;
constexpr float LOG2E = 1.4426950408889634f;
constexpr float QSCALE = 0.125f * LOG2E;
constexpr float EPS = 1e-6f;

constexpr size_t MiB = 1u << 20;
constexpr size_t WS_CTL = 0;
constexpr size_t WS_TAB = 1 * MiB;
constexpr size_t WS_MOD = 1 * MiB + 65536;
constexpr size_t WS_MODP = 2 * MiB;
constexpr size_t WS_WTIN = 4 * MiB;
constexpr size_t WS_WTOUT = 22 * MiB;
constexpr size_t WS_XCTX = 28 * MiB;
constexpr size_t WS_HXU = 32 * MiB;
constexpr size_t WS_P = 82 * MiB;
constexpr size_t WS_END = WS_P + (size_t)MT * NIN * 2;
static_assert(WS_END <= 256 * MiB, "ws map");

__device__ __forceinline__ unsigned f2bf(float f) { unsigned u = __builtin_bit_cast(unsigned, f); return (u + 0x7fffu + ((u >> 16) & 1u)) >> 16; }
__device__ __forceinline__ float bf2f(unsigned h) { return __builtin_bit_cast(float, h << 16); }
__device__ __forceinline__ float silu_f(float v) { return v / (1.f + __expf(-v)); }
__device__ __forceinline__ float wave_sum(float v) {
#pragma unroll
    for (int o = 1; o < 64; o <<= 1) v += __shfl_xor(v, o);
    return v;
}

__global__ void __launch_bounds__(256) k_transpose(const float* __restrict__ W, bf16_t* __restrict__ WT, int K, int N) {
    __shared__ float t[32][33];
    const int n0 = blockIdx.x * 32, k0 = blockIdx.y * 32, tx = threadIdx.x & 31, ty = threadIdx.x >> 5;
    for (int i = ty; i < 32; i += 8) t[i][tx] = W[(size_t)(k0 + i) * N + n0 + tx];
    __syncthreads();
    for (int i = ty; i < 32; i += 8) WT[(size_t)(n0 + i) * K + k0 + tx] = (bf16_t)f2bf(t[tx][i]);
}

__global__ void k_tables(float* tab) {
    const int idx = blockIdx.x * blockDim.x + threadIdx.x;
    if (idx < 128 * 16) {
        const int pos = idx >> 4, i = idx & 15;
        const float freq = powf(10000.f, -(float)i / 16.f);
        const float ang = (float)pos * freq;
        tab[idx * 2] = cosf(ang); tab[idx * 2 + 1] = sinf(ang);
    }
}

__global__ void __launch_bounds__(256) k_mod_partial(const float* __restrict__ c, const float* __restrict__ c_ctx, const float* __restrict__ ada_w, float* __restrict__ part) {
    const int nb = blockIdx.x % 12, kc = (blockIdx.x / 12) % 16, l = blockIdx.x / 192;
    const int n = nb * 256 + threadIdx.x;
    float a0 = 0.f, a1 = 0.f, a2 = 0.f;
    const float* w = ada_w + ((size_t)l * DM + kc * 64) * 3072 + n;
#pragma unroll 8
    for (int k = 0; k < 64; ++k) {
        const float wv = w[(size_t)k * 3072];
        const int kk = kc * 64 + k;
        a0 += silu_f(c[kk]) * wv; a1 += silu_f(c[DM + kk]) * wv; a2 += silu_f(c_ctx[kk]) * wv;
    }
    float* p = part + ((size_t)(l * 16 + kc) * 3) * 3072 + n;
    p[0] = a0; p[3072] = a1; p[2 * 3072] = a2;
}
__global__ void __launch_bounds__(256) k_mod_final(const float* __restrict__ part, const float* __restrict__ ada_b, float* __restrict__ mod) {
    const int idx = blockIdx.x * 256 + threadIdx.x;
    if (idx >= 2 * 3 * 3072) return;
    const int n = idx % 3072, v = (idx / 3072) % 3, l = idx / (3 * 3072);
    float s = ada_b[l * 3072 + n];
    for (int kc = 0; kc < 16; ++kc) s += part[((size_t)(l * 16 + kc) * 3 + v) * 3072 + n];
    mod[idx] = s;
}

__global__ void __launch_bounds__(256) k_norm_mod(const float* __restrict__ xlat, const float* __restrict__ xctx, const float* __restrict__ nw, const float* __restrict__ mod  , bf16_t* __restrict__ HX) {
    const int row = blockIdx.x * 4 + (threadIdx.x >> 6), lane = threadIdx.x & 63;
    if (row >= MT) return;
    const int v = row < ML ? row / SEQ : 2;
    const float* xr = row < ML ? xlat + (size_t)row * DM : xctx + (size_t)(row - ML) * DM;
    f32x4 xv[4]; float ss = 0.f;
#pragma unroll
    for (int j = 0; j < 4; ++j) { xv[j] = *(const f32x4*)(xr + 256 * j + 4 * lane); ss += xv[j][0] * xv[j][0] + xv[j][1] * xv[j][1] + xv[j][2] * xv[j][2] + xv[j][3] * xv[j][3]; }
    const float rstd = rsqrtf(wave_sum(ss) * (1.f / DM) + EPS);
    const float* shift = mod + (size_t)v * 3072; const float* scale = shift + 1024;
#pragma unroll
    for (int j = 0; j < 4; ++j) {
        const int k = 256 * j + 4 * lane;
        const f32x4 w = *(const f32x4*)(nw + k), sc = *(const f32x4*)(scale + k), sh = *(const f32x4*)(shift + k);
        float y[4];
#pragma unroll
        for (int e = 0; e < 4; ++e) y[e] = xv[j][e] * rstd * w[e] * (1.f + sc[e]) + sh[e];
        uint2 o; o.x = f2bf(y[0]) | (f2bf(y[1]) << 16); o.y = f2bf(y[2]) | (f2bf(y[3]) << 16);
        *(uint2*)(HX + (size_t)row * DM + k) = o;
    }
}

template <int K>
__device__ __forceinline__ void wave_gemm_32x64(const bf16_t* __restrict__ A, const bf16_t* __restrict__ Bt, int row0, int col0, int lane, f32x4 (&acc)[2][4]) {
    const int fr = lane & 15, fq = lane >> 4;
#pragma unroll
    for (int m = 0; m < 2; ++m)
#pragma unroll
        for (int n = 0; n < 4; ++n) acc[m][n] = (f32x4){0.f, 0.f, 0.f, 0.f};
    const bf16_t* ap = A + (size_t)(row0 + fr) * K + 8 * fq;
    const bf16_t* bp = Bt + (size_t)(col0 + fr) * K + 8 * fq;
#pragma unroll 2
    for (int k0 = 0; k0 < K; k0 += 32) {
        bf16x8 a[2], b[4];
#pragma unroll
        for (int m = 0; m < 2; ++m) a[m] = *(const bf16x8*)(ap + (size_t)(16 * m) * K + k0);
#pragma unroll
        for (int n = 0; n < 4; ++n) b[n] = *(const bf16x8*)(bp + (size_t)(16 * n) * K + k0);
#pragma unroll
        for (int m = 0; m < 2; ++m)
#pragma unroll
            for (int n = 0; n < 4; ++n) acc[m][n] = __builtin_amdgcn_mfma_f32_16x16x32_bf16(a[m], b[n], acc[m][n], 0, 0, 0);
    }
}

__global__ void __launch_bounds__(256) k_gemm_in(const bf16_t* __restrict__ HX, const bf16_t* __restrict__ WT, const float* __restrict__ qn, const float* __restrict__ kn, const float* __restrict__ tab, bf16_t* __restrict__ P) {
    const int wave = threadIdx.x >> 6, lane = threadIdx.x & 63, fr = lane & 15, fq = lane >> 4;
    const int row0 = blockIdx.x * 32, col0 = (blockIdx.y * 4 + wave) * 64;
    f32x4 acc[2][4];
    wave_gemm_32x64<DM>(HX, WT, row0, col0, lane, acc);
    int kind;
    if (col0 < C_KA) kind = 1; else if (col0 < C_VA) kind = 2; else if (col0 < C_QB) kind = 0; else if (col0 < C_KB) kind = 3; else if (col0 < C_QC) kind = 0;
    else if (col0 < C_KC) kind = 4; else if (col0 < C_VC) kind = 5; else if (col0 < C_G) kind = 0; else kind = 6;
#pragma unroll
    for (int m = 0; m < 2; ++m)
#pragma unroll
        for (int r = 0; r < 4; ++r) {
            const int row = row0 + 16 * m + 4 * fq + r;
            float v[4];
#pragma unroll
            for (int n = 0; n < 4; ++n) v[n] = acc[m][n][r];
            if (kind == 1 || kind == 2) {
                float ss = v[0] * v[0] + v[1] * v[1] + v[2] * v[2] + v[3] * v[3];
                ss += __shfl_xor(ss, 1); ss += __shfl_xor(ss, 2); ss += __shfl_xor(ss, 4); ss += __shfl_xor(ss, 8);
                const float rstd = rsqrtf(ss * (1.f / 64.f) + EPS);
                const float* w = kind == 1 ? qn : kn;
#pragma unroll
                for (int n = 0; n < 4; ++n) v[n] = v[n] * rstd * w[16 * n + fr];
            }
            if ((kind == 1 || kind == 2 || kind == 4 || kind == 5) && row < ML) {
                const int t = row % SEQ, pr = t >> 6, pc = t & 63;
                const float c0 = tab[(pr * 16 + fr) * 2], s0 = tab[(pr * 16 + fr) * 2 + 1];
                const float c1 = tab[(pc * 16 + fr) * 2], s1 = tab[(pc * 16 + fr) * 2 + 1];
                const float a0 = v[0], a1 = v[1], b0 = v[2], b1 = v[3];
                v[0] = a0 * c0 - b0 * s0; v[2] = a0 * s0 + b0 * c0;
                v[1] = a1 * c1 - b1 * s1; v[3] = a1 * s1 + b1 * c1;
            }
            if (kind == 1 || kind == 3 || kind == 4) {
#pragma unroll
                for (int n = 0; n < 4; ++n) v[n] *= QSCALE;
            }
            if (kind == 6) {
#pragma unroll
                for (int n = 0; n < 4; ++n) v[n] = silu_f(v[n]);
            }
#pragma unroll
            for (int n = 0; n < 4; ++n) P[(size_t)row * NIN + col0 + 16 * n + fr] = (bf16_t)f2bf(v[n]);
        }
}

#define ATT_KEY(KROW, VALID, BIAS) do { \
        const uint4* kp_ = (const uint4*)(P + (size_t)(KROW) * NIN + kcol); \
        float s_ = (BIAS); \
        _Pragma("unroll") for (int i_ = 0; i_ < 8; ++i_) { const uint4 w_ = kp_[i_]; \
            s_ += q[8 * i_ + 0] * bf2f(w_.x & 0xffffu) + q[8 * i_ + 1] * bf2f(w_.x >> 16) + q[8 * i_ + 2] * bf2f(w_.y & 0xffffu) + q[8 * i_ + 3] * bf2f(w_.y >> 16) \
                + q[8 * i_ + 4] * bf2f(w_.z & 0xffffu) + q[8 * i_ + 5] * bf2f(w_.z >> 16) + q[8 * i_ + 6] * bf2f(w_.w & 0xffffu) + q[8 * i_ + 7] * bf2f(w_.w >> 16); } \
        if (VALID) { \
            if (s_ > m) { const float f_ = exp2f(m - s_); l *= f_; _Pragma("unroll") for (int d_ = 0; d_ < 64; ++d_) o[d_] *= f_; m = s_; } \
            const float p_ = exp2f(s_ - m); l += p_; \
            const uint4* vp_ = (const uint4*)(P + (size_t)(KROW) * NIN + vcol); \
            _Pragma("unroll") for (int i_ = 0; i_ < 8; ++i_) { const uint4 w_ = vp_[i_]; \
                o[8 * i_ + 0] += p_ * bf2f(w_.x & 0xffffu); o[8 * i_ + 1] += p_ * bf2f(w_.x >> 16); o[8 * i_ + 2] += p_ * bf2f(w_.y & 0xffffu); o[8 * i_ + 3] += p_ * bf2f(w_.y >> 16); \
                o[8 * i_ + 4] += p_ * bf2f(w_.z & 0xffffu); o[8 * i_ + 5] += p_ * bf2f(w_.z >> 16); o[8 * i_ + 6] += p_ * bf2f(w_.w & 0xffffu); o[8 * i_ + 7] += p_ * bf2f(w_.w >> 16); } } \
    } while (0)

__global__ void __launch_bounds__(64) k_attn_naive(const bf16_t* __restrict__ P, bf16_t* __restrict__ U, const float* __restrict__ rpb  , const float* __restrict__ sink  , int need_ctx) {
    const int nqb = 128 + (need_ctx ? 4 : 0);
    int bid = blockIdx.x; const int qb = bid % nqb; bid /= nqb; const int h = bid % 8; bid /= 8; const int b = bid % 2; const int type = bid / 2;
    const int lane = threadIdx.x;
    const bool isctx = qb >= 128;
    const int tq = isctx ? (qb - 128) * 64 + lane : qb * 64 + lane;
    const size_t qrow = isctx ? (size_t)(ML + b * CTX + tq) : (size_t)(b * SEQ + tq);
    const int qcol = (type == 0 ? C_QA : type == 1 ? C_QB : C_QC) + h * 64;
    const int kvh = type == 1 ? h : h / 4;
    const int kcol = (type == 0 ? C_KA : type == 1 ? C_KB : C_KC) + kvh * 64;
    const int vcol = (type == 0 ? C_VA : type == 1 ? C_VB : C_VC) + kvh * 64;
    float q[64], o[64];
    {
        const uint4* qp = (const uint4*)(P + qrow * NIN + qcol);
#pragma unroll
        for (int i = 0; i < 8; ++i) { const uint4 w = qp[i];
            q[8 * i + 0] = bf2f(w.x & 0xffffu); q[8 * i + 1] = bf2f(w.x >> 16); q[8 * i + 2] = bf2f(w.y & 0xffffu); q[8 * i + 3] = bf2f(w.y >> 16);
            q[8 * i + 4] = bf2f(w.z & 0xffffu); q[8 * i + 5] = bf2f(w.z >> 16); q[8 * i + 6] = bf2f(w.w & 0xffffu); q[8 * i + 7] = bf2f(w.w >> 16); }
    }
#pragma unroll
    for (int d = 0; d < 64; ++d) o[d] = 0.f;
    float m = -INFINITY, l = 0.f;
    if (!isctx) {
        if (type == 0) {
            for (int tk = 0; tk < SEQ; ++tk) ATT_KEY(b * SEQ + tk, true, 0.f);
        } else if (type == 1) {
            const int r = qb, col = lane;
            int rs = r - 4; rs = rs < 0 ? 0 : (rs > 120 ? 120 : rs);
            int cs = col - 8; cs = cs < 0 ? 0 : (cs > 48 ? 48 : cs);
            for (int kr = rs; kr < rs + 8; ++kr)
                for (int kc = 0; kc < 64; ++kc) {
                    const bool valid = kc >= cs && kc < cs + 16;
                    int rel = (kr - r + 7) * 31 + (kc - col + 15); rel = valid ? rel : 0;
                    const float bias = rpb[h * 465 + rel] * LOG2E;
                    ATT_KEY(b * SEQ + kr * 64 + kc, valid, bias);
                }
        } else {
            const int q0 = qb * 64;
            const int lo = q0 - 128 < 0 ? 0 : q0 - 128, hi = q0 + 64 + 128 > SEQ ? SEQ : q0 + 64 + 128;
            for (int tk = lo; tk < hi; ++tk) { const int dd = tq - tk; const bool valid = dd <= 128 && dd >= -128; ATT_KEY(b * SEQ + tk, valid, 0.f); }
        }
    }
    for (int j = 0; j < CTX; ++j) ATT_KEY(ML + b * CTX + j, true, 0.f);
    if (type == 2) {
        const float s = sink[h] * LOG2E;
        if (s > m) { const float f = exp2f(m - s); l *= f;
#pragma unroll
            for (int d = 0; d < 64; ++d) o[d] *= f;
            m = s; }
        l += exp2f(s - m);
    }
    const float rl = 1.f / l;
    const int ucol = type * 512 + h * 64;
    const uint4* gp = (const uint4*)(P + qrow * NIN + C_G + ucol);
    uint4* up = (uint4*)(U + qrow * MIX + ucol);
#pragma unroll
    for (int i = 0; i < 8; ++i) {
        const uint4 g = gp[i]; uint4 w;
        w.x = f2bf(o[8 * i + 0] * rl * bf2f(g.x & 0xffffu)) | (f2bf(o[8 * i + 1] * rl * bf2f(g.x >> 16)) << 16);
        w.y = f2bf(o[8 * i + 2] * rl * bf2f(g.y & 0xffffu)) | (f2bf(o[8 * i + 3] * rl * bf2f(g.y >> 16)) << 16);
        w.z = f2bf(o[8 * i + 4] * rl * bf2f(g.z & 0xffffu)) | (f2bf(o[8 * i + 5] * rl * bf2f(g.z >> 16)) << 16);
        w.w = f2bf(o[8 * i + 6] * rl * bf2f(g.w & 0xffffu)) | (f2bf(o[8 * i + 7] * rl * bf2f(g.w >> 16)) << 16);
        up[i] = w;
    }
}

__global__ void __launch_bounds__(256) k_gemm_out(const bf16_t* __restrict__ U, const bf16_t* __restrict__ WT, const float* __restrict__ mod  ,
                                                  const float* xlat_in, const float* xctx_in, float* xlat_out, float* xctx_out) {
    const int wave = threadIdx.x >> 6, lane = threadIdx.x & 63, fr = lane & 15, fq = lane >> 4;
    const int row0 = blockIdx.x * 32, col0 = (blockIdx.y * 4 + wave) * 64;
    f32x4 acc[2][4];
    wave_gemm_32x64<MIX>(U, WT, row0, col0, lane, acc);
#pragma unroll
    for (int m = 0; m < 2; ++m)
#pragma unroll
        for (int r = 0; r < 4; ++r) {
            const int row = row0 + 16 * m + 4 * fq + r;
            const int v = row < ML ? row / SEQ : 2;
            const float* gate = mod + (size_t)v * 3072 + 2048;
            const float* xin = row < ML ? xlat_in + (size_t)row * DM : xctx_in + (size_t)(row - ML) * DM;
            float* xout = row < ML ? xlat_out + (size_t)row * DM : xctx_out + (size_t)(row - ML) * DM;
#pragma unroll
            for (int n = 0; n < 4; ++n) { const int c = col0 + 16 * n + fr; xout[c] = xin[c] + gate[c] * acc[m][n][r]; }
        }
}

__global__ void __launch_bounds__(256) k_final_norm(float* __restrict__ x, const float* __restrict__ w) {
    const int row = blockIdx.x * 4 + (threadIdx.x >> 6), lane = threadIdx.x & 63;
    float* xr = x + (size_t)row * DM;
    f32x4 xv[4]; float ss = 0.f;
#pragma unroll
    for (int j = 0; j < 4; ++j) { xv[j] = *(const f32x4*)(xr + 256 * j + 4 * lane); ss += xv[j][0] * xv[j][0] + xv[j][1] * xv[j][1] + xv[j][2] * xv[j][2] + xv[j][3] * xv[j][3]; }
    const float rstd = rsqrtf(wave_sum(ss) * (1.f / DM) + EPS);
#pragma unroll
    for (int j = 0; j < 4; ++j) { const f32x4 wv = *(const f32x4*)(w + 256 * j + 4 * lane); f32x4 y = xv[j] * rstd * wv; *(f32x4*)(xr + 256 * j + 4 * lane) = y; }
}

extern "C" void kernel_launch(void* const* d_in, const int* in_sizes, int n_in, void* d_out, int out_size, void* d_ws, size_t ws_size, hipStream_t stream) {
    const float* x = (const float*)d_in[0]; const float* c = (const float*)d_in[1]; const float* ctx = (const float*)d_in[2]; const float* c_ctx = (const float*)d_in[3];
    const float* norm_w = (const float*)d_in[4]; const float* ada_w = (const float*)d_in[5]; const float* ada_b = (const float*)d_in[6];
    const float* w_in = (const float*)d_in[7]; const float* w_out = (const float*)d_in[8]; const float* qn = (const float*)d_in[9]; const float* kn = (const float*)d_in[10];
    const float* rpb = (const float*)d_in[11]; const float* sink = (const float*)d_in[12]; const float* fnw = (const float*)d_in[13];
    unsigned char* ws = (unsigned char*)d_ws; float* out = (float*)d_out;
    float* tab = (float*)(ws + WS_TAB); float* mod = (float*)(ws + WS_MOD); float* modp = (float*)(ws + WS_MODP);
    bf16_t* wtin = (bf16_t*)(ws + WS_WTIN); bf16_t* wtout = (bf16_t*)(ws + WS_WTOUT); float* xctx = (float*)(ws + WS_XCTX);
    bf16_t* HX = (bf16_t*)(ws + WS_HXU); bf16_t* U = (bf16_t*)(ws + WS_HXU); bf16_t* P = (bf16_t*)(ws + WS_P);
    for (int l = 0; l < 2; ++l) {
        hipLaunchKernelGGL(k_transpose, dim3(NIN / 32, DM / 32), dim3(256), 0, stream, w_in + (size_t)l * DM * NIN, wtin + (size_t)l * NIN * DM, DM, NIN);
        hipLaunchKernelGGL(k_transpose, dim3(DM / 32, MIX / 32), dim3(256), 0, stream, w_out + (size_t)l * MIX * DM, wtout + (size_t)l * DM * MIX, MIX, DM);
    }
    hipLaunchKernelGGL(k_tables, dim3(8), dim3(256), 0, stream, tab);
    hipLaunchKernelGGL(k_mod_partial, dim3(2 * 16 * 12), dim3(256), 0, stream, c, c_ctx, ada_w, modp);
    hipLaunchKernelGGL(k_mod_final, dim3(72), dim3(256), 0, stream, modp, ada_b, mod);
    for (int l = 0; l < 2; ++l) {
        const float* xl = l == 0 ? x : out; const float* xc = l == 0 ? ctx : xctx;
        hipLaunchKernelGGL(k_norm_mod, dim3(MT / 4), dim3(256), 0, stream, xl, xc, norm_w + l * DM, mod + (size_t)l * 3 * 3072, HX);
        hipLaunchKernelGGL(k_gemm_in, dim3(MT / 32, NIN / 256), dim3(256), 0, stream, HX, wtin + (size_t)l * NIN * DM, qn + l * 64, kn + l * 64, tab, P);
        const int need_ctx = l == 0;
        hipLaunchKernelGGL(k_attn_naive, dim3(3 * 2 * 8 * (128 + (need_ctx ? 4 : 0))), dim3(64), 0, stream, P, U, rpb + (size_t)l * 8 * 465, sink + l * 8, need_ctx);
        const int mrows = need_ctx ? MT : ML;
        hipLaunchKernelGGL(k_gemm_out, dim3(mrows / 32, DM / 256), dim3(256), 0, stream, U, wtout + (size_t)l * DM * MIX, mod + (size_t)l * 3 * 3072, xl, xc, out, xctx);
    }
    hipLaunchKernelGGL(k_final_norm, dim3(ML / 4), dim3(256), 0, stream, out, fnw);
}
```

```cpp
#include <hip/hip_runtime.h>
#include <cstdint>
#include <cstdio>

typedef unsigned short bf16_t;
typedef short bf16x8 __attribute__((ext_vector_type(8)));
typedef float f32x4 __attribute__((ext_vector_type(4)));
typedef unsigned u32x4 __attribute__((ext_vector_type(4)));
#define GAS __attribute__((address_space(1)))
#define LAS __attribute__((address_space(3)))

constexpr int DM = 1024, NB = 2, SEQ = 8192, CTX = 256;
constexpr int ML = NB * SEQ;
constexpr int MT = ML + NB * CTX;
constexpr int NIN = 4608, MIX = 1536;
constexpr int C_QA = 0, C_KA = 512, C_VA = 640, C_QB = 768, C_KB = 1280, C_VB = 1792, C_QC = 2304, C_KC = 2816, C_VC = 2944, C_G = 3072;
constexpr float LOG2E = 1.4426950408889634f;
constexpr float QSCALE = 0.125f * LOG2E;
constexpr float EPS = 1e-6f;
constexpr int NWAVES = 8, NTHREADS = 512;
#ifndef MK_PER_PHASE
#define MK_PER_PHASE 0
#endif
constexpr int NPHASES = 10;

constexpr size_t MiB = 1u << 20;
constexpr size_t WS_CTL = 0, CTL_ZERO_BYTES = 1 * MiB;
constexpr size_t WS_MOD = 65536;
constexpr size_t WS_TAB = 1 * MiB;
constexpr size_t WS_WTIN = 4 * MiB;
constexpr size_t WS_WTOUT = 22 * MiB;
constexpr size_t WS_XCTX = 28 * MiB;
constexpr size_t WS_HXU = 32 * MiB;
constexpr size_t WS_P = 82 * MiB;
constexpr size_t WS_END = WS_P + (size_t)MT * NIN * 2;
static_assert(WS_END <= 256 * MiB, "ws map");
constexpr int CW_BAR = 4096;
constexpr int RING_BYTES = 131072, LDSCTL_OFF = RING_BYTES, MISC_OFF = LDSCTL_OFF + 320, LDS_BYTES = 147456;

__device__ __forceinline__ unsigned f2bf(float f) { unsigned u = __builtin_bit_cast(unsigned, f); return (u + 0x7fffu + ((u >> 16) & 1u)) >> 16; }
__device__ __forceinline__ float bf2f(unsigned h) { return __builtin_bit_cast(float, h << 16); }
__device__ __forceinline__ unsigned pk2(float lo, float hi) { return f2bf(lo) | (f2bf(hi) << 16); }
__device__ __forceinline__ float silu_f(float v) { return v / (1.f + __expf(-v)); }
__device__ __forceinline__ float wave_sum(float v) {
#pragma unroll
    for (int o = 1; o < 64; o <<= 1) v += __shfl_xor(v, o);
    return v;
}
#define LDS_WAIT() asm volatile("s_waitcnt lgkmcnt(0)" ::: "memory")

#define XB_TMO      128
#define XB_XCNT(j)  (256  + 64 * (j))
#define XB_XSUB(j)  (1280 + 64 * (j))
#define XB_XGEN(j)  (2304 + 64 * (j))
#define XB_TOP      3328
#define XB_TOPGEN   3392
#define XCD_BAR_WORDS 3456
#define XB_SPIN_CAP (1u << 18)
__device__ __forceinline__ unsigned xb_ld(unsigned* p)              { return __hip_atomic_load(p, __ATOMIC_RELAXED, __HIP_MEMORY_SCOPE_AGENT); }
__device__ __forceinline__ unsigned xb_add(unsigned* p, unsigned v) { return __hip_atomic_fetch_add(p, v, __ATOMIC_RELAXED, __HIP_MEMORY_SCOPE_AGENT); }
__device__ __forceinline__ unsigned xb_xcc_id() { return (unsigned)__builtin_amdgcn_s_getreg((3 << 11) | 20) & 0xFu; }
#define XB_SPIN(cond, bar) do { unsigned _sp = 0; while (cond) { __builtin_amdgcn_s_sleep(1); \
    if ((++_sp & 255u) == 0u) { if (xb_ld(&(bar)[XB_TMO])) break; if (_sp > XB_SPIN_CAP) { atomicAdd(&(bar)[XB_TMO], 1u); break; } } } } while (0)
struct XcdBarrier { unsigned* bar; unsigned x; volatile LAS unsigned* st; };
__device__ __forceinline__ XcdBarrier xcd_barrier_post(unsigned* bar, volatile LAS unsigned* st) {
    XcdBarrier b; b.bar = bar; b.x = xb_xcc_id(); b.st = st;
    if (threadIdx.x == 0) (void)xb_add(&bar[XB_XCNT(b.x)], 1u);
    return b;
}
__device__ __forceinline__ void xcd_barrier_complete(unsigned* bar, unsigned x, unsigned& nloc, unsigned& nx) {
    const unsigned G = gridDim.x * gridDim.y * gridDim.z;
    unsigned sum, cnt, mine, sp = 0u;
    for (;;) {
        sum = 0u; cnt = 0u; mine = 0u;
#pragma unroll
        for (unsigned j = 0; j < 16; ++j) { const unsigned c = xb_ld(&bar[XB_XCNT(j)]); sum += c; cnt += (c > 0u) ? 1u : 0u; mine = (j == x) ? c : mine; }
        if (sum == G) break;
        __builtin_amdgcn_s_sleep(1);
        if ((++sp & 255u) == 0u) { if (xb_ld(&bar[XB_TMO])) break; if (sp > XB_SPIN_CAP) { atomicAdd(&bar[XB_TMO], 1u); break; } }
    }
    nloc = mine > 0u ? mine : 1u; nx = cnt > 0u ? cnt : 1u;
}
__device__ __forceinline__ void xcd_barrier(const XcdBarrier& b) {
    asm volatile("s_waitcnt vmcnt(0)" ::: "memory");
    __syncthreads();
    if (threadIdx.x == 0) {
        unsigned* bar = b.bar;
        __builtin_amdgcn_s_waitcnt(0);
        unsigned nloc = b.st[0], nx = b.st[1];
        if (nloc == 0u) { xcd_barrier_complete(bar, b.x, nloc, nx); b.st[0] = nloc; b.st[1] = nx; }
        const unsigned old = xb_add(&bar[XB_XSUB(b.x)], 1u);
        const unsigned gen = old / nloc;
        if (old + 1u == (gen + 1u) * nloc) {
            __builtin_amdgcn_fence(__ATOMIC_RELEASE, "agent");
            asm volatile("s_waitcnt vmcnt(0)" ::: "memory");
            const unsigned og = xb_add(&bar[XB_TOP], 1u);
            const unsigned tg = og / nx;
            if (og + 1u == (tg + 1u) * nx) xb_add(&bar[XB_TOPGEN], 1u);
            else XB_SPIN(xb_ld(&bar[XB_TOPGEN]) == tg, bar);
            __builtin_amdgcn_fence(__ATOMIC_ACQUIRE, "agent");
            xb_add(&bar[XB_XGEN(b.x)], 1u);
            asm volatile("s_waitcnt vmcnt(0)" ::: "memory");
        } else {
            XB_SPIN(xb_ld(&bar[XB_XGEN(b.x)]) == gen, bar);
            __builtin_amdgcn_fence(__ATOMIC_ACQUIRE, "agent");
            asm volatile("s_waitcnt vmcnt(0)" ::: "memory");
        }
    }
    __syncthreads();
}

struct Ctx {
    LAS unsigned char* lds; int tid, lane, wave, vcu, G;
};

__device__ __forceinline__ void p0_transpose_item(const float* W, int K, int N, bf16_t* WT, LAS float* scr, int item, int lane) {
    const int nblk = N / 32, kb = item / nblk, nb = item % nblk, k0 = 64 * kb, n0 = 32 * nb;
#pragma unroll 8
    for (int i = 0; i < 32; ++i) { const int kk = 2 * i + (lane >> 5); scr[kk * 33 + (lane & 31)] = W[(size_t)(k0 + kk) * N + n0 + (lane & 31)]; }
    LDS_WAIT(); asm volatile("" ::: "memory");
    const int c = lane & 7;
#pragma unroll
    for (int j = 0; j < 4; ++j) { const int n = (lane >> 3) + 8 * j; const LAS float* s = scr + (8 * c) * 33 + n;
        u32x4 o; o.x = pk2(s[0 * 33], s[1 * 33]); o.y = pk2(s[2 * 33], s[3 * 33]); o.z = pk2(s[4 * 33], s[5 * 33]); o.w = pk2(s[6 * 33], s[7 * 33]);
        *(u32x4*)(WT + (size_t)(n0 + n) * K + k0 + 8 * c) = o; }
    LDS_WAIT(); asm volatile("" ::: "memory");
}

__device__ __forceinline__ void phase_prologue(const Ctx& F, const float* w_in, const float* w_out, const float* c, const float* c_ctx, const float* ada_w, const float* ada_b,
                                               bf16_t* wtin, bf16_t* wtout, float* tab, float* mod) {
    LAS float* scr = (LAS float*)(F.lds + F.wave * 16384);
    const int gw = F.vcu * NWAVES + F.wave, NGW = F.G * NWAVES;
    constexpr int I_IN = (DM / 64) * (NIN / 32), I_OUT = (MIX / 64) * (DM / 32), NITEMS = 2 * (I_IN + I_OUT);
    for (int it = gw; it < NITEMS; it += NGW) {
        int r = it;
        if (r < I_IN) { p0_transpose_item(w_in, DM, NIN, wtin, scr, r, F.lane); continue; } r -= I_IN;
        if (r < I_IN) { p0_transpose_item(w_in + (size_t)DM * NIN, DM, NIN, wtin + (size_t)NIN * DM, scr, r, F.lane); continue; } r -= I_IN;
        if (r < I_OUT) { p0_transpose_item(w_out, MIX, DM, wtout, scr, r, F.lane); continue; } r -= I_OUT;
        p0_transpose_item(w_out + (size_t)MIX * DM, MIX, DM, wtout + (size_t)DM * MIX, scr, r, F.lane);
    }
    { const int idx = F.vcu * NTHREADS + F.tid;
      if (idx < 128 * 16) { const int pos = idx >> 4, i = idx & 15; const float freq = powf(10000.f, -(float)i / 16.f); const float ang = (float)pos * freq; tab[idx * 2] = cosf(ang); tab[idx * 2 + 1] = sinf(ang); } }
    { const int wk = F.vcu * 2 + (F.tid >> 8), NWK = F.G * 2, t = F.tid & 255;
      for (int it = wk; it < 2 * 16 * 12; it += NWK) {
          const int nb = it % 12, kc = (it / 12) % 16, l = it / 192; const int n = nb * 256 + t;
          float a0 = 0.f, a1 = 0.f, a2 = 0.f;
          const float* w = ada_w + ((size_t)l * DM + kc * 64) * 3072 + n;
#pragma unroll 8
          for (int k = 0; k < 64; ++k) { const float wv = w[(size_t)k * 3072]; const int kk = kc * 64 + k;
              a0 += silu_f(c[kk]) * wv; a1 += silu_f(c[DM + kk]) * wv; a2 += silu_f(c_ctx[kk]) * wv; }
          if (kc == 0) { const float bb = ada_b[l * 3072 + n]; a0 += bb; a1 += bb; a2 += bb; }
          float* p = mod + (size_t)l * 3 * 3072 + n;
          atomicAdd(p, a0); atomicAdd(p + 3072, a1); atomicAdd(p + 2 * 3072, a2);
      } }
}

__device__ __forceinline__ void phase_norm_mod(const Ctx& F, const float* xlat, const float* xctx, const float* nw, const float* mod, bf16_t* HX) {
    const int gw = F.vcu * NWAVES + F.wave, NGW = F.G * NWAVES, lane = F.lane;
    for (int row = gw; row < MT; row += NGW) {
        const int v = row < ML ? row / SEQ : 2;
        const float* xr = row < ML ? xlat + (size_t)row * DM : xctx + (size_t)(row - ML) * DM;
        f32x4 xv[4]; float ss = 0.f;
#pragma unroll
        for (int j = 0; j < 4; ++j) { xv[j] = *(const f32x4*)(xr + 256 * j + 4 * lane); ss += xv[j][0] * xv[j][0] + xv[j][1] * xv[j][1] + xv[j][2] * xv[j][2] + xv[j][3] * xv[j][3]; }
        const float rstd = rsqrtf(wave_sum(ss) * (1.f / DM) + EPS);
        const float* shift = mod + (size_t)v * 3072; const float* scale = shift + 1024;
#pragma unroll
        for (int j = 0; j < 4; ++j) {
            const int k = 256 * j + 4 * lane;
            const f32x4 w = *(const f32x4*)(nw + k), sc = *(const f32x4*)(scale + k), sh = *(const f32x4*)(shift + k);
            float y[4];
#pragma unroll
            for (int e = 0; e < 4; ++e) y[e] = xv[j][e] * rstd * w[e] * (1.f + sc[e]) + sh[e];
            uint2 o; o.x = pk2(y[0], y[1]); o.y = pk2(y[2], y[3]);
            *(uint2*)(HX + (size_t)row * DM + k) = o;
        }
    }
}

template <int K>
__device__ __forceinline__ void wave_gemm_32x64(const bf16_t* A, const bf16_t* Bt, int row0, int col0, int lane, f32x4 (&acc)[2][4]) {
    const int fr = lane & 15, fq = lane >> 4;
#pragma unroll
    for (int m = 0; m < 2; ++m)
#pragma unroll
        for (int n = 0; n < 4; ++n) acc[m][n] = (f32x4){0.f, 0.f, 0.f, 0.f};
    const bf16_t* ap = A + (size_t)(row0 + fr) * K + 8 * fq;
    const bf16_t* bp = Bt + (size_t)(col0 + fr) * K + 8 * fq;
#pragma unroll 2
    for (int k0 = 0; k0 < K; k0 += 32) {
        bf16x8 a[2], b[4];
#pragma unroll
        for (int m = 0; m < 2; ++m) a[m] = *(const bf16x8*)(ap + (size_t)(16 * m) * K + k0);
#pragma unroll
        for (int n = 0; n < 4; ++n) b[n] = *(const bf16x8*)(bp + (size_t)(16 * n) * K + k0);
#pragma unroll
        for (int m = 0; m < 2; ++m)
#pragma unroll
            for (int n = 0; n < 4; ++n) acc[m][n] = __builtin_amdgcn_mfma_f32_16x16x32_bf16(a[m], b[n], acc[m][n], 0, 0, 0);
    }
}

__device__ __forceinline__ void phase_gemm_in(const Ctx& F, const bf16_t* HX, const bf16_t* WT, const float* qn, const float* kn, const float* tab, bf16_t* P) {
    const int gw = F.vcu * NWAVES + F.wave, NGW = F.G * NWAVES, lane = F.lane, fr = lane & 15, fq = lane >> 4;
    for (int it = gw; it < (MT / 32) * (NIN / 64); it += NGW) {
        const int row0 = (it / (NIN / 64)) * 32, col0 = (it % (NIN / 64)) * 64;
        f32x4 acc[2][4];
        wave_gemm_32x64<DM>(HX, WT, row0, col0, lane, acc);
        int kind;
        if (col0 < C_KA) kind = 1; else if (col0 < C_VA) kind = 2; else if (col0 < C_QB) kind = 0; else if (col0 < C_KB) kind = 3; else if (col0 < C_QC) kind = 0;
        else if (col0 < C_KC) kind = 4; else if (col0 < C_VC) kind = 5; else if (col0 < C_G) kind = 0; else kind = 6;
#pragma unroll
        for (int m = 0; m < 2; ++m)
#pragma unroll
            for (int r = 0; r < 4; ++r) {
                const int row = row0 + 16 * m + 4 * fq + r;
                float v[4];
#pragma unroll
                for (int n = 0; n < 4; ++n) v[n] = acc[m][n][r];
                if (kind == 1 || kind == 2) {
                    float ss = v[0] * v[0] + v[1] * v[1] + v[2] * v[2] + v[3] * v[3];
                    ss += __shfl_xor(ss, 1); ss += __shfl_xor(ss, 2); ss += __shfl_xor(ss, 4); ss += __shfl_xor(ss, 8);
                    const float rstd = rsqrtf(ss * (1.f / 64.f) + EPS);
                    const float* w = kind == 1 ? qn : kn;
#pragma unroll
                    for (int n = 0; n < 4; ++n) v[n] = v[n] * rstd * w[16 * n + fr];
                }
                if ((kind == 1 || kind == 2 || kind == 4 || kind == 5) && row < ML) {
                    const int t = row % SEQ, pr = t >> 6, pc = t & 63;
                    const float c0 = tab[(pr * 16 + fr) * 2], s0 = tab[(pr * 16 + fr) * 2 + 1];
                    const float c1 = tab[(pc * 16 + fr) * 2], s1 = tab[(pc * 16 + fr) * 2 + 1];
                    const float a0 = v[0], a1 = v[1], b0 = v[2], b1 = v[3];
                    v[0] = a0 * c0 - b0 * s0; v[2] = a0 * s0 + b0 * c0;
                    v[1] = a1 * c1 - b1 * s1; v[3] = a1 * s1 + b1 * c1;
                }
                if (kind == 1 || kind == 3 || kind == 4) {
#pragma unroll
                    for (int n = 0; n < 4; ++n) v[n] *= QSCALE;
                }
                if (kind == 6) {
#pragma unroll
                    for (int n = 0; n < 4; ++n) v[n] = silu_f(v[n]);
                }
#pragma unroll
                for (int n = 0; n < 4; ++n) P[(size_t)row * NIN + col0 + 16 * n + fr] = (bf16_t)f2bf(v[n]);
            }
    }
}

#define ATT_KEY(KROW, VALID, BIAS) do { \
        const uint4* kp_ = (const uint4*)(P + (size_t)(KROW) * NIN + kcol); \
        float s_ = (BIAS); \
        _Pragma("unroll") for (int i_ = 0; i_ < 8; ++i_) { const uint4 w_ = kp_[i_]; \
            s_ += q[8 * i_ + 0] * bf2f(w_.x & 0xffffu) + q[8 * i_ + 1] * bf2f(w_.x >> 16) + q[8 * i_ + 2] * bf2f(w_.y & 0xffffu) + q[8 * i_ + 3] * bf2f(w_.y >> 16) \
                + q[8 * i_ + 4] * bf2f(w_.z & 0xffffu) + q[8 * i_ + 5] * bf2f(w_.z >> 16) + q[8 * i_ + 6] * bf2f(w_.w & 0xffffu) + q[8 * i_ + 7] * bf2f(w_.w >> 16); } \
        if (VALID) { \
            if (s_ > m) { const float f_ = exp2f(m - s_); l *= f_; _Pragma("unroll") for (int d_ = 0; d_ < 64; ++d_) o[d_] *= f_; m = s_; } \
            const float p_ = exp2f(s_ - m); l += p_; \
            const uint4* vp_ = (const uint4*)(P + (size_t)(KROW) * NIN + vcol); \
            _Pragma("unroll") for (int i_ = 0; i_ < 8; ++i_) { const uint4 w_ = vp_[i_]; \
                o[8 * i_ + 0] += p_ * bf2f(w_.x & 0xffffu); o[8 * i_ + 1] += p_ * bf2f(w_.x >> 16); o[8 * i_ + 2] += p_ * bf2f(w_.y & 0xffffu); o[8 * i_ + 3] += p_ * bf2f(w_.y >> 16); \
                o[8 * i_ + 4] += p_ * bf2f(w_.z & 0xffffu); o[8 * i_ + 5] += p_ * bf2f(w_.z >> 16); o[8 * i_ + 6] += p_ * bf2f(w_.w & 0xffffu); o[8 * i_ + 7] += p_ * bf2f(w_.w >> 16); } } \
    } while (0)

__device__ __forceinline__ void phase_attn_naive(const Ctx& F, const bf16_t* P, bf16_t* U, const float* rpb  , const float* sink  , int need_ctx) {
    const int gw = F.vcu * NWAVES + F.wave, NGW = F.G * NWAVES, lane = F.lane;
    const int nqb = 128 + (need_ctx ? 4 : 0);
    for (int it = gw; it < 3 * 2 * 8 * nqb; it += NGW) {
        int bid = it; const int qb = bid % nqb; bid /= nqb; const int h = bid % 8; bid /= 8; const int b = bid % 2; const int type = bid / 2;
        const bool isctx = qb >= 128;
        const int tq = isctx ? (qb - 128) * 64 + lane : qb * 64 + lane;
        const size_t qrow = isctx ? (size_t)(ML + b * CTX + tq) : (size_t)(b * SEQ + tq);
        const int qcol = (type == 0 ? C_QA : type == 1 ? C_QB : C_QC) + h * 64;
        const int kvh = type == 1 ? h : h / 4;
        const int kcol = (type == 0 ? C_KA : type == 1 ? C_KB : C_KC) + kvh * 64;
        const int vcol = (type == 0 ? C_VA : type == 1 ? C_VB : C_VC) + kvh * 64;
        float q[64], o[64];
        {
            const uint4* qp = (const uint4*)(P + qrow * NIN + qcol);
#pragma unroll
            for (int i = 0; i < 8; ++i) { const uint4 w = qp[i];
                q[8 * i + 0] = bf2f(w.x & 0xffffu); q[8 * i + 1] = bf2f(w.x >> 16); q[8 * i + 2] = bf2f(w.y & 0xffffu); q[8 * i + 3] = bf2f(w.y >> 16);
                q[8 * i + 4] = bf2f(w.z & 0xffffu); q[8 * i + 5] = bf2f(w.z >> 16); q[8 * i + 6] = bf2f(w.w & 0xffffu); q[8 * i + 7] = bf2f(w.w >> 16); }
        }
#pragma unroll
        for (int d = 0; d < 64; ++d) o[d] = 0.f;
        float m = -INFINITY, l = 0.f;
        if (!isctx) {
            if (type == 0) {
                for (int tk = 0; tk < SEQ; ++tk) ATT_KEY(b * SEQ + tk, true, 0.f);
            } else if (type == 1) {
                const int r = qb, col = lane;
                int rs = r - 4; rs = rs < 0 ? 0 : (rs > 120 ? 120 : rs);
                int cs = col - 8; cs = cs < 0 ? 0 : (cs > 48 ? 48 : cs);
                for (int kr = rs; kr < rs + 8; ++kr)
                    for (int kc = 0; kc < 64; ++kc) {
                        const bool valid = kc >= cs && kc < cs + 16;
                        int rel = (kr - r + 7) * 31 + (kc - col + 15); rel = valid ? rel : 0;
                        const float bias = rpb[h * 465 + rel] * LOG2E;
                        ATT_KEY(b * SEQ + kr * 64 + kc, valid, bias);
                    }
            } else {
                const int q0 = qb * 64;
                const int lo = q0 - 128 < 0 ? 0 : q0 - 128, hi = q0 + 64 + 128 > SEQ ? SEQ : q0 + 64 + 128;
                for (int tk = lo; tk < hi; ++tk) { const int dd = tq - tk; const bool valid = dd <= 128 && dd >= -128; ATT_KEY(b * SEQ + tk, valid, 0.f); }
            }
        }
        for (int j = 0; j < CTX; ++j) ATT_KEY(ML + b * CTX + j, true, 0.f);
        if (type == 2) {
            const float s = sink[h] * LOG2E;
            if (s > m) { const float f = exp2f(m - s); l *= f;
#pragma unroll
                for (int d = 0; d < 64; ++d) o[d] *= f;
                m = s; }
            l += exp2f(s - m);
        }
        const float rl = 1.f / l;
        const int ucol = type * 512 + h * 64;
        const uint4* gp = (const uint4*)(P + qrow * NIN + C_G + ucol);
        uint4* up = (uint4*)(U + qrow * MIX + ucol);
#pragma unroll
        for (int i = 0; i < 8; ++i) {
            const uint4 g = gp[i]; uint4 w;
            w.x = pk2(o[8 * i + 0] * rl * bf2f(g.x & 0xffffu), o[8 * i + 1] * rl * bf2f(g.x >> 16));
            w.y = pk2(o[8 * i + 2] * rl * bf2f(g.y & 0xffffu), o[8 * i + 3] * rl * bf2f(g.y >> 16));
            w.z = pk2(o[8 * i + 4] * rl * bf2f(g.z & 0xffffu), o[8 * i + 5] * rl * bf2f(g.z >> 16));
            w.w = pk2(o[8 * i + 6] * rl * bf2f(g.w & 0xffffu), o[8 * i + 7] * rl * bf2f(g.w >> 16));
            up[i] = w;
        }
    }
}

__device__ __forceinline__ void phase_gemm_out(const Ctx& F, const bf16_t* U, const bf16_t* WT, const float* mod, const float* xlat_in, const float* xctx_in, float* xlat_out, float* xctx_out, int mrows) {
    const int gw = F.vcu * NWAVES + F.wave, NGW = F.G * NWAVES, lane = F.lane, fr = lane & 15, fq = lane >> 4;
    for (int it = gw; it < (mrows / 32) * (DM / 64); it += NGW) {
        const int row0 = (it / (DM / 64)) * 32, col0 = (it % (DM / 64)) * 64;
        f32x4 acc[2][4];
        wave_gemm_32x64<MIX>(U, WT, row0, col0, lane, acc);
#pragma unroll
        for (int m = 0; m < 2; ++m)
#pragma unroll
            for (int r = 0; r < 4; ++r) {
                const int row = row0 + 16 * m + 4 * fq + r;
                const int v = row < ML ? row / SEQ : 2;
                const float* gate = mod + (size_t)v * 3072 + 2048;
                const float* xin = row < ML ? xlat_in + (size_t)row * DM : xctx_in + (size_t)(row - ML) * DM;
                float* xout = row < ML ? xlat_out + (size_t)row * DM : xctx_out + (size_t)(row - ML) * DM;
#pragma unroll
                for (int n = 0; n < 4; ++n) { const int c = col0 + 16 * n + fr; xout[c] = xin[c] + gate[c] * acc[m][n][r]; }
            }
    }
}

__device__ __forceinline__ void phase_final_norm(const Ctx& F, float* x, const float* w) {
    const int gw = F.vcu * NWAVES + F.wave, NGW = F.G * NWAVES, lane = F.lane;
    for (int row = gw; row < ML; row += NGW) {
        float* xr = x + (size_t)row * DM;
        f32x4 xv[4]; float ss = 0.f;
#pragma unroll
        for (int j = 0; j < 4; ++j) { xv[j] = *(const f32x4*)(xr + 256 * j + 4 * lane); ss += xv[j][0] * xv[j][0] + xv[j][1] * xv[j][1] + xv[j][2] * xv[j][2] + xv[j][3] * xv[j][3]; }
        const float rstd = rsqrtf(wave_sum(ss) * (1.f / DM) + EPS);
#pragma unroll
        for (int j = 0; j < 4; ++j) { const f32x4 wv = *(const f32x4*)(w + 256 * j + 4 * lane); f32x4 y = xv[j] * rstd * wv; *(f32x4*)(xr + 256 * j + 4 * lane) = y; }
    }
}

struct Args { const float* in[14]; float* out; unsigned char* ws; int ph_lo, ph_hi; };
__global__ void __launch_bounds__(NTHREADS, 2) fwd_kernel(Args args) {
    extern __shared__ __attribute__((aligned(16))) unsigned char lds[];
    Ctx F;
    F.lds = (LAS unsigned char*)lds;
    F.tid = threadIdx.x; F.lane = F.tid & 63; F.wave = __builtin_amdgcn_readfirstlane(F.tid >> 6);
    F.G = gridDim.x; { const int bx = blockIdx.x; F.vcu = (F.G % 8 == 0) ? (bx % 8) * (F.G / 8) + bx / 8 : bx; }
    volatile LAS unsigned* MISC = (volatile LAS unsigned*)(F.lds + MISC_OFF);
    for (int u = F.tid; u < (LDS_BYTES - LDSCTL_OFF) / 4; u += NTHREADS) ((LAS unsigned*)(F.lds + LDSCTL_OFF))[u] = 0u;
    __syncthreads();
    unsigned char* ws = args.ws;
    unsigned* ctl = (unsigned*)(ws + WS_CTL);
    XcdBarrier bar; bar.bar = ctl + CW_BAR; bar.x = 0; bar.st = nullptr;
    if (!MK_PER_PHASE) bar = xcd_barrier_post(ctl + CW_BAR, MISC + 8);
    const float* x = args.in[0]; const float* c = args.in[1]; const float* ctxin = args.in[2]; const float* c_ctx = args.in[3];
    const float* norm_w = args.in[4]; const float* ada_w = args.in[5]; const float* ada_b = args.in[6];
    const float* w_in = args.in[7]; const float* w_out = args.in[8]; const float* qn = args.in[9]; const float* kn = args.in[10];
    const float* rpb = args.in[11]; const float* sink = args.in[12]; const float* fnw = args.in[13];
    float* out = args.out;
    float* tab = (float*)(ws + WS_TAB); float* mod = (float*)(ws + WS_MOD);
    bf16_t* wtin = (bf16_t*)(ws + WS_WTIN); bf16_t* wtout = (bf16_t*)(ws + WS_WTOUT); float* xctx = (float*)(ws + WS_XCTX);
    bf16_t* HX = (bf16_t*)(ws + WS_HXU); bf16_t* U = (bf16_t*)(ws + WS_HXU); bf16_t* P = (bf16_t*)(ws + WS_P);
    const int lo = args.ph_lo, hi = args.ph_hi;
#define IN(k) (lo <= (k) && (k) < hi)
#define SEAM(k) do { if (IN(k) && IN((k) + 1)) xcd_barrier(bar); } while (0)
    if (IN(0)) { phase_prologue(F, w_in, w_out, c, c_ctx, ada_w, ada_b, wtin, wtout, tab, mod); }
    SEAM(0);
#pragma unroll 1
    for (int l = 0; l < 2; ++l) {
        const float* xl = l == 0 ? x : out; const float* xc = l == 0 ? ctxin : xctx;
        const float* modl = mod + (size_t)l * 3 * 3072;
        const int pb = 1 + 4 * l;
        if (IN(pb)) phase_norm_mod(F, xl, xc, norm_w + l * DM, modl, HX);
        SEAM(pb);
        if (IN(pb + 1)) phase_gemm_in(F, HX, wtin + (size_t)l * NIN * DM, qn + l * 64, kn + l * 64, tab, P);
        SEAM(pb + 1);
        if (IN(pb + 2)) phase_attn_naive(F, P, U, rpb + (size_t)l * 8 * 465, sink + l * 8, l == 0);
        SEAM(pb + 2);
        if (IN(pb + 3)) phase_gemm_out(F, U, wtout + (size_t)l * DM * MIX, modl, xl, xc, out, xctx, l == 0 ? MT : ML);
        SEAM(pb + 3);
    }
    if (IN(9)) phase_final_norm(F, out, fnw);
#undef IN
#undef SEAM
}

extern "C" void kernel_launch(void* const* d_in, const int* in_sizes, int n_in, void* d_out, int out_size, void* d_ws, size_t ws_size, hipStream_t stream) {
    static int grid = 0;
    if (grid == 0) {
        int dev = 0, cus = 0, per_cu = 0;
        if (n_in != 14 || ws_size < WS_END) { fprintf(stderr, "kernel_launch: unexpected inputs / workspace\n"); grid = -1; return; }
        if (hipGetDevice(&dev) != hipSuccess || hipDeviceGetAttribute(&cus, hipDeviceAttributeMultiprocessorCount, dev) != hipSuccess) { grid = -1; return; }
        if (hipFuncSetAttribute((const void*)fwd_kernel, hipFuncAttributeMaxDynamicSharedMemorySize, LDS_BYTES) != hipSuccess) { fprintf(stderr, "kernel_launch: hipFuncSetAttribute failed\n"); grid = -1; return; }
        if (hipOccupancyMaxActiveBlocksPerMultiprocessor(&per_cu, (const void*)fwd_kernel, NTHREADS, LDS_BYTES) != hipSuccess || per_cu < 1) { fprintf(stderr, "kernel_launch: occupancy query says %d\n", per_cu); }
        (void)hipGetLastError();
        grid = cus;
    }
    if (grid < 0) return;
    (void)hipMemsetAsync((char*)d_ws + WS_CTL, 0, CTL_ZERO_BYTES, stream);
    Args a{};
    for (int i = 0; i < 14; ++i) a.in[i] = (const float*)d_in[i];
    a.out = (float*)d_out; a.ws = (unsigned char*)d_ws;
#if MK_PER_PHASE
    for (int p = 0; p < NPHASES; ++p) { a.ph_lo = p; a.ph_hi = p + 1; hipLaunchKernelGGL(fwd_kernel, dim3(grid), dim3(NTHREADS), LDS_BYTES, stream, a); }
#else
    a.ph_lo = 0; a.ph_hi = NPHASES;
    hipLaunchKernelGGL(fwd_kernel, dim3(grid), dim3(NTHREADS), LDS_BYTES, stream, a);
#endif
}
```

```cpp
#include <hip/hip_runtime.h>
#include <cstdint>
#include <cstdio>

typedef unsigned short bf16_t;
typedef short bf16x8 __attribute__((ext_vector_type(8)));
typedef float f32x4 __attribute__((ext_vector_type(4)));
typedef unsigned u32x4 __attribute__((ext_vector_type(4)));
#define GAS __attribute__((address_space(1)))
#define LAS __attribute__((address_space(3)))

constexpr int DM = 1024, NB = 2, SEQ = 8192, CTX = 256;
constexpr int ML = NB * SEQ;
constexpr int MT = ML + NB * CTX;
constexpr int NIN = 4608, MIX = 1536;
constexpr int C_QA = 0, C_KA = 512, C_VA = 640, C_QB = 768, C_KB = 1280, C_VB = 1792, C_QC = 2304, C_KC = 2816, C_VC = 2944, C_G = 3072;
constexpr float LOG2E = 1.4426950408889634f;
constexpr float QSCALE = 0.125f * LOG2E;
constexpr float EPS = 1e-6f;
constexpr int NWAVES = 8, NTHREADS = 512;
#ifndef MK_PER_PHASE
#define MK_PER_PHASE 0
#endif
constexpr int NPHASES = 10;

constexpr size_t MiB = 1u << 20;
constexpr size_t WS_CTL = 0, CTL_ZERO_BYTES = 1 * MiB;
constexpr size_t WS_MOD = 65536;
constexpr size_t WS_TAB = 1 * MiB;
constexpr size_t WS_WTIN = 4 * MiB;
constexpr size_t WS_WTOUT = 22 * MiB;
constexpr size_t WS_XCTX = 28 * MiB;
constexpr size_t WS_HXU = 32 * MiB;
constexpr size_t WS_P = 82 * MiB;
constexpr size_t WS_END = WS_P + (size_t)MT * NIN * 2;
static_assert(WS_END <= 256 * MiB, "ws map");
constexpr int CW_BAR = 4096;
constexpr int RING_BYTES = 131072, LDSCTL_OFF = RING_BYTES, MISC_OFF = LDSCTL_OFF + 320, LDS_BYTES = 147456;

__device__ __forceinline__ unsigned f2bf(float f) { unsigned u = __builtin_bit_cast(unsigned, f); return (u + 0x7fffu + ((u >> 16) & 1u)) >> 16; }
__device__ __forceinline__ float bf2f(unsigned h) { return __builtin_bit_cast(float, h << 16); }
__device__ __forceinline__ unsigned pk2(float lo, float hi) { return f2bf(lo) | (f2bf(hi) << 16); }
__device__ __forceinline__ float silu_f(float v) { return v / (1.f + __expf(-v)); }
__device__ __forceinline__ float wave_sum(float v) {
#pragma unroll
    for (int o = 1; o < 64; o <<= 1) v += __shfl_xor(v, o);
    return v;
}
#define LDS_WAIT() asm volatile("s_waitcnt lgkmcnt(0)" ::: "memory")

#define XB_TMO      128
#define XB_XCNT(j)  (256  + 64 * (j))
#define XB_XSUB(j)  (1280 + 64 * (j))
#define XB_XGEN(j)  (2304 + 64 * (j))
#define XB_TOP      3328
#define XB_TOPGEN   3392
#define XCD_BAR_WORDS 3456
#define XB_SPIN_CAP (1u << 18)
__device__ __forceinline__ unsigned xb_ld(unsigned* p)              { return __hip_atomic_load(p, __ATOMIC_RELAXED, __HIP_MEMORY_SCOPE_AGENT); }
__device__ __forceinline__ unsigned xb_add(unsigned* p, unsigned v) { return __hip_atomic_fetch_add(p, v, __ATOMIC_RELAXED, __HIP_MEMORY_SCOPE_AGENT); }
__device__ __forceinline__ unsigned xb_xcc_id() { return (unsigned)__builtin_amdgcn_s_getreg((3 << 11) | 20) & 0xFu; }
#define XB_SPIN(cond, bar) do { unsigned _sp = 0; while (cond) { __builtin_amdgcn_s_sleep(1); \
    if ((++_sp & 255u) == 0u) { if (xb_ld(&(bar)[XB_TMO])) break; if (_sp > XB_SPIN_CAP) { atomicAdd(&(bar)[XB_TMO], 1u); break; } } } } while (0)
struct XcdBarrier { unsigned* bar; unsigned x; volatile LAS unsigned* st; };
__device__ __forceinline__ XcdBarrier xcd_barrier_post(unsigned* bar, volatile LAS unsigned* st) {
    XcdBarrier b; b.bar = bar; b.x = xb_xcc_id(); b.st = st;
    if (threadIdx.x == 0) (void)xb_add(&bar[XB_XCNT(b.x)], 1u);
    return b;
}
__device__ __forceinline__ void xcd_barrier_complete(unsigned* bar, unsigned x, unsigned& nloc, unsigned& nx) {
    const unsigned G = gridDim.x * gridDim.y * gridDim.z;
    unsigned sum, cnt, mine, sp = 0u;
    for (;;) {
        sum = 0u; cnt = 0u; mine = 0u;
#pragma unroll
        for (unsigned j = 0; j < 16; ++j) { const unsigned c = xb_ld(&bar[XB_XCNT(j)]); sum += c; cnt += (c > 0u) ? 1u : 0u; mine = (j == x) ? c : mine; }
        if (sum == G) break;
        __builtin_amdgcn_s_sleep(1);
        if ((++sp & 255u) == 0u) { if (xb_ld(&bar[XB_TMO])) break; if (sp > XB_SPIN_CAP) { atomicAdd(&bar[XB_TMO], 1u); break; } }
    }
    nloc = mine > 0u ? mine : 1u; nx = cnt > 0u ? cnt : 1u;
}
__device__ __forceinline__ void xcd_barrier(const XcdBarrier& b) {
    asm volatile("s_waitcnt vmcnt(0)" ::: "memory");
    __syncthreads();
    if (threadIdx.x == 0) {
        unsigned* bar = b.bar;
        __builtin_amdgcn_s_waitcnt(0);
        unsigned nloc = b.st[0], nx = b.st[1];
        if (nloc == 0u) { xcd_barrier_complete(bar, b.x, nloc, nx); b.st[0] = nloc; b.st[1] = nx; }
        const unsigned old = xb_add(&bar[XB_XSUB(b.x)], 1u);
        const unsigned gen = old / nloc;
        if (old + 1u == (gen + 1u) * nloc) {
            __builtin_amdgcn_fence(__ATOMIC_RELEASE, "agent");
            asm volatile("s_waitcnt vmcnt(0)" ::: "memory");
            const unsigned og = xb_add(&bar[XB_TOP], 1u);
            const unsigned tg = og / nx;
            if (og + 1u == (tg + 1u) * nx) xb_add(&bar[XB_TOPGEN], 1u);
            else XB_SPIN(xb_ld(&bar[XB_TOPGEN]) == tg, bar);
            __builtin_amdgcn_fence(__ATOMIC_ACQUIRE, "agent");
            xb_add(&bar[XB_XGEN(b.x)], 1u);
            asm volatile("s_waitcnt vmcnt(0)" ::: "memory");
        } else {
            XB_SPIN(xb_ld(&bar[XB_XGEN(b.x)]) == gen, bar);
            __builtin_amdgcn_fence(__ATOMIC_ACQUIRE, "agent");
            asm volatile("s_waitcnt vmcnt(0)" ::: "memory");
        }
    }
    __syncthreads();
}

namespace pg8 {
#define PG8_LAS __attribute__((address_space(3)))
typedef unsigned short bf16_t;
typedef short bf16x8 __attribute__((ext_vector_type(8)));
typedef float f32x4 __attribute__((ext_vector_type(4)));
typedef unsigned u32x4 __attribute__((ext_vector_type(4)));
constexpr int BM = 256, BK = 64, HALF = 128, HTB = HALF * BK * 2  , STAGE_BYTES = 8 * HTB, NXCD = 8, WGM = 8;

__host__ __device__ __forceinline__ int lds_byte(int r, int c) { const int st = (r >> 4) * 2 + (c >> 5), rr = r & 15, cc = c & 31, ob = rr * 64 + cc * 2; return st * 1024 + (ob ^ (((ob >> 9) & 1) << 5)); }
__host__ __device__ __forceinline__ void stage_rc(int b, int& R, int& C) { const int st = b / 1024, sb = b % 1024, swz = sb ^ (((sb >> 9) & 1) << 5); R = (st >> 1) * 16 + swz / 64; C = (st & 1) * 32 + (swz % 64) / 2; }
__host__ __device__ __forceinline__ int perm32(int rho) { const int n = rho >> 4, i = rho & 15; return 8 * (i >> 2) + 4 * n + (i & 3); }

struct Unit { int pm, pn; };
struct Gemm { const bf16_t* A; const bf16_t* Bt; int M, N, K; };

struct StaticOrder {
    int nM, nN, nwg, G, c;
    __host__ __device__ void init(int M, int N, int G_, int c_) { nM = M / BM; nN = N / BM; nwg = nM * nN; G = G_; c = c_; }
    __host__ __device__ bool next(int i, Unit& u) const {
        const long L = (long)i * G + c; if (L >= nwg) return false;
        int wgid = (int)L; { const int q = nwg / NXCD, r = nwg % NXCD, xcd = wgid % NXCD, off = wgid / NXCD; wgid = (xcd < r ? xcd * (q + 1) : r * (q + 1) + (xcd - r) * q) + off; }
        const int nig = WGM * nN, gid = wgid / nig, fm = gid * WGM, gsz = (nM - fm) < WGM ? (nM - fm) : WGM;
        u.pm = fm + ((wgid % nig) % gsz); u.pn = (wgid % nig) / gsz; return true;
    }
    __device__ __forceinline__ void a_ready(const Unit&) const {}
    __device__ __forceinline__ void done(const Unit&) const {}
};
__device__ __forceinline__ unsigned cvt_pk_bf16(float lo, float hi) { unsigned r; asm volatile("v_cvt_pk_bf16_f32 %0, %1, %2" : "=v"(r) : "v"(lo), "v"(hi)); return r; }
typedef float f32x2 __attribute__((ext_vector_type(2)));
struct EpiIn {
    static constexpr bool PERM = true, AFTER_DRAIN = false;
    bf16_t* P; const float* qn; const float* kn; const float* tab;
    __device__ __forceinline__ void operator()(const f32x4 (&acc)[2][2][4][2], const Unit& u, int wr, int wc, int fr, int fq) const {
        const int col0 = u.pn * BM + wc * 64;
        int kind;
        if (col0 < 512) kind = 1; else if (col0 < 640) kind = 2; else if (col0 < 768) kind = 0; else if (col0 < 1280) kind = 3; else if (col0 < 2304) kind = 0;
        else if (col0 < 2816) kind = 4; else if (col0 < 2944) kind = 5; else if (col0 < 3072) kind = 0; else kind = 6;
        kind = __builtin_amdgcn_readfirstlane(kind);
        const bool latent = u.pm < 64;
        const bool do_norm = kind == 1 || kind == 2, do_rope = (kind == 1 || kind == 2 || kind == 4 || kind == 5) && latent, do_scale = kind == 1 || kind == 3 || kind == 4;
        f32x4 wlo[2], whi[2];
        if (do_norm) { const float* w = kind == 1 ? qn : kn;
#pragma unroll
            for (int n = 0; n < 2; ++n) { wlo[n] = *(const f32x4*)(w + 8 * fq + 4 * n); whi[n] = *(const f32x4*)(w + 32 + 8 * fq + 4 * n); } }
#pragma unroll
        for (int ai = 0; ai < 2; ++ai)
#pragma unroll
            for (int m = 0; m < 4; ++m) {
                const int row = u.pm * BM + ai * HALF + wr * 64 + m * 16 + fr;
                f32x4 lo[2], hi[2];
#pragma unroll
                for (int n = 0; n < 2; ++n) { lo[n] = acc[ai][0][m][n]; hi[n] = acc[ai][1][m][n]; }
                if (do_norm) {
                    float ss = 0.f;
#pragma unroll
                    for (int n = 0; n < 2; ++n)
#pragma unroll
                        for (int j = 0; j < 4; ++j) ss += lo[n][j] * lo[n][j] + hi[n][j] * hi[n][j];
                    ss += __shfl_xor(ss, 16); ss += __shfl_xor(ss, 32);
                    const float rstd = rsqrtf(ss * (1.f / 64.f) + 1e-6f);
#pragma unroll
                    for (int n = 0; n < 2; ++n) { lo[n] = lo[n] * rstd * wlo[n]; hi[n] = hi[n] * rstd * whi[n]; }
                }
                if (do_rope) {
                    const int pr = (4 * u.pm + 2 * ai + wr) & 127, pc = 16 * m + fr;
                    const int pos = fq < 2 ? pr : pc;
                    const float* tp = tab + (pos * 16 + 8 * (fq & 1)) * 2;
#pragma unroll
                    for (int n = 0; n < 2; ++n) {
                        const f32x4 t0 = *(const f32x4*)(tp + 8 * n), t1 = *(const f32x4*)(tp + 8 * n + 4);
                        const float cs[4] = {t0[0], t0[2], t1[0], t1[2]}, sn[4] = {t0[1], t0[3], t1[1], t1[3]};
#pragma unroll
                        for (int j = 0; j < 4; ++j) { const float a = lo[n][j], b = hi[n][j]; lo[n][j] = a * cs[j] - b * sn[j]; hi[n][j] = a * sn[j] + b * cs[j]; }
                    }
                }
                if (do_scale) {
#pragma unroll
                    for (int n = 0; n < 2; ++n) { lo[n] = lo[n] * (0.125f * 1.4426950408889634f); hi[n] = hi[n] * (0.125f * 1.4426950408889634f); }
                }
                if (kind == 6) {
#pragma unroll
                    for (int n = 0; n < 2; ++n)
#pragma unroll
                        for (int j = 0; j < 4; ++j) { lo[n][j] = lo[n][j] / (1.f + __expf(-lo[n][j])); hi[n][j] = hi[n][j] / (1.f + __expf(-hi[n][j])); }
                }
                bf16_t* rowp = P + (size_t)row * 4608 + col0 + 8 * fq;
                u32x4 w0, w1;
                w0.x = cvt_pk_bf16(lo[0][0], lo[0][1]); w0.y = cvt_pk_bf16(lo[0][2], lo[0][3]); w0.z = cvt_pk_bf16(lo[1][0], lo[1][1]); w0.w = cvt_pk_bf16(lo[1][2], lo[1][3]);
                w1.x = cvt_pk_bf16(hi[0][0], hi[0][1]); w1.y = cvt_pk_bf16(hi[0][2], hi[0][3]); w1.z = cvt_pk_bf16(hi[1][0], hi[1][1]); w1.w = cvt_pk_bf16(hi[1][2], hi[1][3]);
                *(u32x4*)rowp = w0; *(u32x4*)(rowp + 32) = w1;
            }
    }
};
struct EpiOut {
    static constexpr bool PERM = false, AFTER_DRAIN = false;
    const float* mod; const float* xlat_in; const float* xctx_in; float* xlat_out; float* xctx_out;
    __device__ __forceinline__ void operator()(const f32x4 (&acc)[2][2][4][2], const Unit& u, int wr, int wc, int fr, int fq) const {
        const bool latent = u.pm < 64;
        const int v = latent ? (u.pm >> 5) : 2;
        const float* gate = mod + (size_t)v * 3072 + 2048;
        const float* xin = latent ? xlat_in : xctx_in - (size_t)16384 * 1024;
        float* xout = latent ? xlat_out : xctx_out - (size_t)16384 * 1024;
        const int col0 = u.pn * BM + wc * 32 + 4 * fq;
        f32x4 g[2][2];
#pragma unroll
        for (int bj = 0; bj < 2; ++bj)
#pragma unroll
            for (int n = 0; n < 2; ++n) g[bj][n] = *(const f32x4*)(gate + col0 + bj * HALF + n * 16);
#pragma unroll
        for (int ai = 0; ai < 2; ++ai)
#pragma unroll
            for (int m = 0; m < 4; ++m) { const size_t off = (size_t)(u.pm * BM + ai * HALF + wr * 64 + m * 16 + fr) * 1024 + col0;
#pragma unroll
                for (int bj = 0; bj < 2; ++bj)
#pragma unroll
                    for (int n = 0; n < 2; ++n) { const f32x4 xo = *(const f32x4*)(xin + off + bj * HALF + n * 16); *(f32x4*)(xout + off + bj * HALF + n * 16) = xo + g[bj][n] * acc[ai][bj][m][n]; }
            }
    }
};
template <class Epi, class Sched, bool ALIGN_EPI = false, bool SP2 = false>
__device__ __forceinline__ void gemm_phase(PG8_LAS unsigned char* lds, const Gemm g, const Sched& S, const Epi& E) {
    int tid = threadIdx.x; asm volatile("" : "+v"(tid));
    const int wid = __builtin_amdgcn_readfirstlane(tid >> 6), lane = tid & 63, wr = wid >> 2, wc = wid & 3, fr = lane & 15, fq = lane >> 4;
    const int K = g.K, nt = K / BK;
    unsigned voffA[2], voffB[2];
#pragma unroll
    for (int i = 0; i < 2; ++i) { int R, C; stage_rc(tid * 16 + i * 8192, R, C); const int Rb = Epi::PERM ? ((R & ~31) + perm32(R & 31)) : R;
        voffA[i] = (unsigned)(R * K + C) * 2u; voffB[i] = (unsigned)(Rb * K + C) * 2u; }
    const size_t kstep = (size_t)(BK * 2);
    const size_t hstep = (size_t)HALF * K * 2;
    const size_t tstep = 2 * hstep;
    const unsigned ldsw = (unsigned)wid * 1024u;
    const int aoff = lds_byte(wr * 64 + fr, fq * 8), boff = lds_byte(wc * 32 + fr, fq * 8);
#define PG8_SA(b, h) (((b) * 2 + (h)) * HTB)
#define PG8_SB(b, h) ((4 + (b) * 2 + (h)) * HTB)
#define PG8_STAGE(bufoff, gbase, voff) do { _Pragma("unroll") for (int _i = 0; _i < 2; ++_i) \
        __builtin_amdgcn_global_load_lds((const unsigned*)((const char*)(gbase) + (voff)[_i]), (PG8_LAS unsigned*)(lds + (bufoff) + ldsw + _i * 8192), 16, 0, 0); } while (0)
#define PG8_LDA(dst, b, h) do { _Pragma("unroll") for (int m = 0; m < 4; ++m) _Pragma("unroll") for (int k = 0; k < 2; ++k) dst[m][k] = *(const PG8_LAS bf16x8*)(lds + PG8_SA(b, h) + aoff + m * 2048 + k * 1024); } while (0)
#define PG8_LDB(dst, b, h) do { _Pragma("unroll") for (int n = 0; n < 2; ++n) _Pragma("unroll") for (int k = 0; k < 2; ++k) dst[n][k] = *(const PG8_LAS bf16x8*)(lds + PG8_SB(b, h) + boff + n * 2048 + k * 1024); } while (0)
#define PG8_MMA(ai, bj, At, Bt) do { __builtin_amdgcn_s_setprio(1); _Pragma("unroll") for (int m = 0; m < 4; ++m) _Pragma("unroll") for (int n = 0; n < 2; ++n) _Pragma("unroll") for (int k = 0; k < 2; ++k) \
        acc[ai][bj][m][n] = __builtin_amdgcn_mfma_f32_16x16x32_bf16(Bt[n][k], At[m][k], acc[ai][bj][m][n], 0, 0, 0); __builtin_amdgcn_s_setprio(0); } while (0)
#define PG8_WAIT_V(n) asm volatile("s_waitcnt vmcnt(" #n ")" ::: "memory")
#define PG8_WAIT_L(n) asm volatile("s_waitcnt lgkmcnt(" #n ")" ::: "memory")
#define PG8_BAR __builtin_amdgcn_s_barrier()
#define PG8_SCHED __builtin_amdgcn_sched_barrier(0)
    Unit cur, nxt; int ui = 0;
    if (!S.next(0, cur)) return;
    f32x4 acc[2][2][4][2];
#pragma unroll
    for (int a = 0; a < 2; ++a)
#pragma unroll
        for (int b = 0; b < 2; ++b)
#pragma unroll
            for (int m = 0; m < 4; ++m)
#pragma unroll
                for (int n = 0; n < 2; ++n) acc[a][b][m][n] = (f32x4){0.f, 0.f, 0.f, 0.f};
    bf16x8 At[4][2], B0[2][2], B1[2][2];
    const char* cA = (const char*)g.A + (size_t)cur.pm * tstep; const char* cB = (const char*)g.Bt + (size_t)cur.pn * tstep;
    S.a_ready(cur);
    if constexpr (SP2) {
        PG8_STAGE(PG8_SB(0, 0), cB, voffB); PG8_STAGE(PG8_SB(0, 1), cB + hstep, voffB); PG8_STAGE(PG8_SA(0, 0), cA, voffA); PG8_STAGE(PG8_SA(0, 1), cA + hstep, voffA);
        if (wr == 1) PG8_BAR;
        PG8_WAIT_V(2); PG8_BAR;
        PG8_STAGE(PG8_SB(1, 0), cB + kstep, voffB); PG8_STAGE(PG8_SA(1, 0), cA + kstep, voffA); PG8_STAGE(PG8_SB(1, 1), cB + hstep + kstep, voffB);
        PG8_WAIT_V(6); PG8_BAR;
    } else {
        PG8_STAGE(PG8_SB(0, 0), cB, voffB); PG8_STAGE(PG8_SA(0, 0), cA, voffA); PG8_STAGE(PG8_SB(0, 1), cB + hstep, voffB); PG8_STAGE(PG8_SA(0, 1), cA + hstep, voffA);
        if (wr == 1) PG8_BAR;
        PG8_WAIT_V(4); PG8_BAR;
        PG8_STAGE(PG8_SB(1, 0), cB + kstep, voffB); PG8_STAGE(PG8_SA(1, 0), cA + kstep, voffA); PG8_STAGE(PG8_SB(1, 1), cB + hstep + kstep, voffB);
        PG8_WAIT_V(6); PG8_BAR;
    }
    for (;;) {
        const bool has_next = S.next(ui + 1, nxt);
        const char* nA = has_next ? (const char*)g.A + (size_t)nxt.pm * tstep : cA; const char* nB = has_next ? (const char*)g.Bt + (size_t)nxt.pn * tstep : cB;
        for (int t = 0; t < nt; t += 2) {
            const bool last = (t == nt - 2);
            const char* a1 = cA + (size_t)(t + 1) * kstep;
            const char* a2 = last ? nA : cA + (size_t)(t + 2) * kstep; const char* b2 = last ? nB : cB + (size_t)(t + 2) * kstep;
            const char* a3 = a2 + kstep; const char* b3 = b2 + kstep;
            if (last && has_next) S.a_ready(nxt);
            if constexpr (SP2) {
            PG8_LDB(B0, 0, 0); PG8_LDB(B1, 0, 1); PG8_SCHED; PG8_LDA(At, 0, 0); PG8_STAGE(PG8_SA(1, 1), a1 + hstep, voffA);
            PG8_WAIT_V(8); PG8_WAIT_L(0); PG8_BAR; PG8_MMA(0, 0, At, B0); PG8_MMA(0, 1, At, B1); PG8_BAR; PG8_SCHED;
            PG8_LDA(At, 0, 1); PG8_STAGE(PG8_SB(0, 0), b2, voffB); PG8_STAGE(PG8_SB(0, 1), b2 + hstep, voffB); PG8_STAGE(PG8_SA(0, 0), a2, voffA);
            PG8_WAIT_V(8); PG8_WAIT_L(0); PG8_BAR; PG8_MMA(1, 0, At, B0); PG8_MMA(1, 1, At, B1); PG8_BAR; PG8_SCHED;
            PG8_LDB(B0, 1, 0); PG8_LDB(B1, 1, 1); PG8_SCHED; PG8_LDA(At, 1, 0); PG8_STAGE(PG8_SA(0, 1), a2 + hstep, voffA);
            PG8_WAIT_V(8); PG8_WAIT_L(0); PG8_BAR; PG8_MMA(0, 0, At, B0); PG8_MMA(0, 1, At, B1); PG8_BAR; PG8_SCHED;
            PG8_LDA(At, 1, 1); PG8_STAGE(PG8_SB(1, 0), b3, voffB); PG8_STAGE(PG8_SB(1, 1), b3 + hstep, voffB); PG8_STAGE(PG8_SA(1, 0), a3, voffA);
            PG8_WAIT_V(8); PG8_WAIT_L(0); PG8_BAR; PG8_MMA(1, 0, At, B0); PG8_MMA(1, 1, At, B1); PG8_BAR; PG8_SCHED;
            } else {
            PG8_LDB(B0, 0, 0); PG8_SCHED; PG8_LDA(At, 0, 0); PG8_STAGE(PG8_SA(1, 1), a1 + hstep, voffA);
            PG8_WAIT_L(8); PG8_BAR; PG8_WAIT_L(0); PG8_MMA(0, 0, At, B0); PG8_BAR; PG8_SCHED;
            PG8_LDB(B1, 0, 1); PG8_STAGE(PG8_SB(0, 0), b2, voffB);
            PG8_BAR; PG8_WAIT_L(0); PG8_MMA(0, 1, At, B1); PG8_BAR;
            PG8_LDA(At, 0, 1); PG8_STAGE(PG8_SA(0, 0), a2, voffA);
            PG8_BAR; PG8_WAIT_L(0); PG8_MMA(1, 0, At, B0); PG8_BAR; PG8_SCHED;
            PG8_STAGE(PG8_SB(0, 1), b2 + hstep, voffB);
            PG8_WAIT_V(6); PG8_BAR; PG8_MMA(1, 1, At, B1); PG8_BAR;
            PG8_LDB(B0, 1, 0); PG8_SCHED; PG8_LDA(At, 1, 0); PG8_STAGE(PG8_SA(0, 1), a2 + hstep, voffA);
            PG8_WAIT_L(8); PG8_BAR; PG8_WAIT_L(0); PG8_MMA(0, 0, At, B0); PG8_BAR; PG8_SCHED;
            PG8_LDB(B1, 1, 1); PG8_STAGE(PG8_SB(1, 0), b3, voffB);
            PG8_BAR; PG8_WAIT_L(0); PG8_MMA(0, 1, At, B1); PG8_BAR;
            PG8_LDA(At, 1, 1); PG8_STAGE(PG8_SA(1, 0), a3, voffA);
            PG8_BAR; PG8_WAIT_L(0); PG8_MMA(1, 0, At, B0); PG8_BAR; PG8_SCHED;
            PG8_STAGE(PG8_SB(1, 1), b3 + hstep, voffB);
            PG8_WAIT_V(6); PG8_BAR; PG8_MMA(1, 1, At, B1); PG8_BAR;
            }
        }
        if constexpr (ALIGN_EPI) { if (wr == 0) PG8_BAR; }
        if constexpr (!Epi::AFTER_DRAIN) { E(acc, cur, wr, wc, fr, fq); S.done(cur); }
        if (!has_next) break;
#pragma unroll
        for (int a = 0; a < 2; ++a)
#pragma unroll
            for (int b = 0; b < 2; ++b)
#pragma unroll
                for (int m = 0; m < 4; ++m)
#pragma unroll
                    for (int n = 0; n < 2; ++n) acc[a][b][m][n] = (f32x4){0.f, 0.f, 0.f, 0.f};
        cur = nxt; cA = nA; cB = nB; ++ui;
        if constexpr (ALIGN_EPI) { if (wr == 1) PG8_BAR; }
    }
    PG8_WAIT_V(0);
    if constexpr (!ALIGN_EPI) { if (wr == 0) PG8_BAR; }
    PG8_BAR;
    if constexpr (Epi::AFTER_DRAIN) { E.fused(acc, cur, wr, wc, fr, fq, lds, wid, lane); S.done(cur); }
#undef PG8_SA
#undef PG8_SB
#undef PG8_STAGE
#undef PG8_LDA
#undef PG8_LDB
#undef PG8_MMA
#undef PG8_WAIT_V
#undef PG8_WAIT_L
#undef PG8_BAR
#undef PG8_SCHED
}
}

struct Ctx {
    LAS unsigned char* lds; int tid, lane, wave, vcu, G;
};
__device__ __forceinline__ Ctx fresh(const Ctx& F0) { Ctx F = F0; int t = threadIdx.x; asm volatile("" : "+v"(t)); F.tid = t; F.lane = t & 63; F.wave = __builtin_amdgcn_readfirstlane(t >> 6); return F; }

template <bool PERMUTE>
__device__ __forceinline__ void p0_transpose_item(const float* W, int K, int N, bf16_t* WT, LAS float* scr, int item, int lane) {
    const int nblk = N / 32, kb = item / nblk, nb = item % nblk, k0 = 64 * kb, n0 = 32 * nb;
    const int r0 = PERMUTE ? ((n0 & ~255) + 128 * ((n0 >> 5) & 1) + 32 * ((n0 >> 6) & 3)) : n0;
#pragma unroll 8
    for (int i = 0; i < 32; ++i) { const int kk = 2 * i + (lane >> 5); scr[kk * 33 + (lane & 31)] = W[(size_t)(k0 + kk) * N + n0 + (lane & 31)]; }
    LDS_WAIT(); asm volatile("" ::: "memory");
    const int c = lane & 7;
#pragma unroll
    for (int j = 0; j < 4; ++j) { const int n = (lane >> 3) + 8 * j; const LAS float* s = scr + (8 * c) * 33 + n;
        u32x4 o; o.x = pk2(s[0 * 33], s[1 * 33]); o.y = pk2(s[2 * 33], s[3 * 33]); o.z = pk2(s[4 * 33], s[5 * 33]); o.w = pk2(s[6 * 33], s[7 * 33]);
        *(u32x4*)(WT + (size_t)(r0 + n) * K + k0 + 8 * c) = o; }
    LDS_WAIT(); asm volatile("" ::: "memory");
}

__device__ __forceinline__ void phase_prologue(const Ctx& F0, const float* w_in, const float* w_out, const float* c, const float* c_ctx, const float* ada_w, const float* ada_b,
                                               bf16_t* wtin, bf16_t* wtout, float* tab, float* mod) {
    const Ctx F = fresh(F0);
    LAS float* scr = (LAS float*)(F.lds + F.wave * 16384);
    const int gw = F.vcu * NWAVES + F.wave, NGW = F.G * NWAVES;
    constexpr int I_IN = (DM / 64) * (NIN / 32), I_OUT = (MIX / 64) * (DM / 32), NITEMS = 2 * (I_IN + I_OUT);
    for (int it = gw; it < NITEMS; it += NGW) {
        int r = it;
        if (r < I_IN) { p0_transpose_item<true>(w_in, DM, NIN, wtin, scr, r, F.lane); continue; } r -= I_IN;
        if (r < I_IN) { p0_transpose_item<true>(w_in + (size_t)DM * NIN, DM, NIN, wtin + (size_t)NIN * DM, scr, r, F.lane); continue; } r -= I_IN;
        if (r < I_OUT) { p0_transpose_item<false>(w_out, MIX, DM, wtout, scr, r, F.lane); continue; } r -= I_OUT;
        p0_transpose_item<false>(w_out + (size_t)MIX * DM, MIX, DM, wtout + (size_t)DM * MIX, scr, r, F.lane);
    }
    { const int idx = F.vcu * NTHREADS + F.tid;
      if (idx < 128 * 16) { const int pos = idx >> 4, i = idx & 15; const float freq = powf(10000.f, -(float)i / 16.f); const float ang = (float)pos * freq; tab[idx * 2] = cosf(ang); tab[idx * 2 + 1] = sinf(ang); } }
    { const int wk = F.vcu * 2 + (F.tid >> 8), NWK = F.G * 2, t = F.tid & 255;
      for (int it = wk; it < 2 * 16 * 12; it += NWK) {
          const int nb = it % 12, kc = (it / 12) % 16, l = it / 192; const int n = nb * 256 + t;
          float a0 = 0.f, a1 = 0.f, a2 = 0.f;
          const float* w = ada_w + ((size_t)l * DM + kc * 64) * 3072 + n;
#pragma unroll 8
          for (int k = 0; k < 64; ++k) { const float wv = w[(size_t)k * 3072]; const int kk = kc * 64 + k;
              a0 += silu_f(c[kk]) * wv; a1 += silu_f(c[DM + kk]) * wv; a2 += silu_f(c_ctx[kk]) * wv; }
          if (kc == 0) { const float bb = ada_b[l * 3072 + n]; a0 += bb; a1 += bb; a2 += bb; }
          float* p = mod + (size_t)l * 3 * 3072 + n;
          atomicAdd(p, a0); atomicAdd(p + 3072, a1); atomicAdd(p + 2 * 3072, a2);
      } }
}

__device__ __forceinline__ void phase_norm_mod(const Ctx& F0, const float* xlat, const float* xctx, const float* nw, const float* mod, bf16_t* HX) {
    const Ctx F = fresh(F0);
    const int gw = F.vcu * NWAVES + F.wave, NGW = F.G * NWAVES, lane = F.lane;
    for (int row = gw; row < MT; row += NGW) {
        const int v = row < ML ? row / SEQ : 2;
        const float* xr = row < ML ? xlat + (size_t)row * DM : xctx + (size_t)(row - ML) * DM;
        f32x4 xv[4]; float ss = 0.f;
#pragma unroll
        for (int j = 0; j < 4; ++j) { xv[j] = *(const f32x4*)(xr + 256 * j + 4 * lane); ss += xv[j][0] * xv[j][0] + xv[j][1] * xv[j][1] + xv[j][2] * xv[j][2] + xv[j][3] * xv[j][3]; }
        const float rstd = rsqrtf(wave_sum(ss) * (1.f / DM) + EPS);
        const float* shift = mod + (size_t)v * 3072; const float* scale = shift + 1024;
#pragma unroll
        for (int j = 0; j < 4; ++j) {
            const int k = 256 * j + 4 * lane;
            const f32x4 w = *(const f32x4*)(nw + k), sc = *(const f32x4*)(scale + k), sh = *(const f32x4*)(shift + k);
            float y[4];
#pragma unroll
            for (int e = 0; e < 4; ++e) y[e] = xv[j][e] * rstd * w[e] * (1.f + sc[e]) + sh[e];
            uint2 o; o.x = pk2(y[0], y[1]); o.y = pk2(y[2], y[3]);
            *(uint2*)(HX + (size_t)row * DM + k) = o;
        }
    }
}

#define ATT_KEY(KROW, VALID, BIAS) do { \
        const uint4* kp_ = (const uint4*)(P + (size_t)(KROW) * NIN + kcol); \
        float s_ = (BIAS); \
        _Pragma("unroll") for (int i_ = 0; i_ < 8; ++i_) { const uint4 w_ = kp_[i_]; \
            s_ += q[8 * i_ + 0] * bf2f(w_.x & 0xffffu) + q[8 * i_ + 1] * bf2f(w_.x >> 16) + q[8 * i_ + 2] * bf2f(w_.y & 0xffffu) + q[8 * i_ + 3] * bf2f(w_.y >> 16) \
                + q[8 * i_ + 4] * bf2f(w_.z & 0xffffu) + q[8 * i_ + 5] * bf2f(w_.z >> 16) + q[8 * i_ + 6] * bf2f(w_.w & 0xffffu) + q[8 * i_ + 7] * bf2f(w_.w >> 16); } \
        if (VALID) { \
            if (s_ > m) { const float f_ = exp2f(m - s_); l *= f_; _Pragma("unroll") for (int d_ = 0; d_ < 64; ++d_) o[d_] *= f_; m = s_; } \
            const float p_ = exp2f(s_ - m); l += p_; \
            const uint4* vp_ = (const uint4*)(P + (size_t)(KROW) * NIN + vcol); \
            _Pragma("unroll") for (int i_ = 0; i_ < 8; ++i_) { const uint4 w_ = vp_[i_]; \
                o[8 * i_ + 0] += p_ * bf2f(w_.x & 0xffffu); o[8 * i_ + 1] += p_ * bf2f(w_.x >> 16); o[8 * i_ + 2] += p_ * bf2f(w_.y & 0xffffu); o[8 * i_ + 3] += p_ * bf2f(w_.y >> 16); \
                o[8 * i_ + 4] += p_ * bf2f(w_.z & 0xffffu); o[8 * i_ + 5] += p_ * bf2f(w_.z >> 16); o[8 * i_ + 6] += p_ * bf2f(w_.w & 0xffffu); o[8 * i_ + 7] += p_ * bf2f(w_.w >> 16); } } \
    } while (0)

__device__ __forceinline__ void phase_attn_naive(const Ctx& F0, const bf16_t* P, bf16_t* U, const float* rpb  , const float* sink  , int need_ctx) {
    const Ctx F = fresh(F0);
    const int gw = F.vcu * NWAVES + F.wave, NGW = F.G * NWAVES, lane = F.lane;
    const int nqb = 128 + (need_ctx ? 4 : 0);
    for (int it = gw; it < 3 * 2 * 8 * nqb; it += NGW) {
        int bid = it; const int qb = bid % nqb; bid /= nqb; const int h = bid % 8; bid /= 8; const int b = bid % 2; const int type = bid / 2;
        const bool isctx = qb >= 128;
        const int tq = isctx ? (qb - 128) * 64 + lane : qb * 64 + lane;
        const size_t qrow = isctx ? (size_t)(ML + b * CTX + tq) : (size_t)(b * SEQ + tq);
        const int qcol = (type == 0 ? C_QA : type == 1 ? C_QB : C_QC) + h * 64;
        const int kvh = type == 1 ? h : h / 4;
        const int kcol = (type == 0 ? C_KA : type == 1 ? C_KB : C_KC) + kvh * 64;
        const int vcol = (type == 0 ? C_VA : type == 1 ? C_VB : C_VC) + kvh * 64;
        float q[64], o[64];
        {
            const uint4* qp = (const uint4*)(P + qrow * NIN + qcol);
#pragma unroll
            for (int i = 0; i < 8; ++i) { const uint4 w = qp[i];
                q[8 * i + 0] = bf2f(w.x & 0xffffu); q[8 * i + 1] = bf2f(w.x >> 16); q[8 * i + 2] = bf2f(w.y & 0xffffu); q[8 * i + 3] = bf2f(w.y >> 16);
                q[8 * i + 4] = bf2f(w.z & 0xffffu); q[8 * i + 5] = bf2f(w.z >> 16); q[8 * i + 6] = bf2f(w.w & 0xffffu); q[8 * i + 7] = bf2f(w.w >> 16); }
        }
#pragma unroll
        for (int d = 0; d < 64; ++d) o[d] = 0.f;
        float m = -INFINITY, l = 0.f;
        if (!isctx) {
            if (type == 0) {
                for (int tk = 0; tk < SEQ; ++tk) ATT_KEY(b * SEQ + tk, true, 0.f);
            } else if (type == 1) {
                const int r = qb, col = lane;
                int rs = r - 4; rs = rs < 0 ? 0 : (rs > 120 ? 120 : rs);
                int cs = col - 8; cs = cs < 0 ? 0 : (cs > 48 ? 48 : cs);
                for (int kr = rs; kr < rs + 8; ++kr)
                    for (int kc = 0; kc < 64; ++kc) {
                        const bool valid = kc >= cs && kc < cs + 16;
                        int rel = (kr - r + 7) * 31 + (kc - col + 15); rel = valid ? rel : 0;
                        const float bias = rpb[h * 465 + rel] * LOG2E;
                        ATT_KEY(b * SEQ + kr * 64 + kc, valid, bias);
                    }
            } else {
                const int q0 = qb * 64;
                const int lo = q0 - 128 < 0 ? 0 : q0 - 128, hi = q0 + 64 + 128 > SEQ ? SEQ : q0 + 64 + 128;
                for (int tk = lo; tk < hi; ++tk) { const int dd = tq - tk; const bool valid = dd <= 128 && dd >= -128; ATT_KEY(b * SEQ + tk, valid, 0.f); }
            }
        }
        for (int j = 0; j < CTX; ++j) ATT_KEY(ML + b * CTX + j, true, 0.f);
        if (type == 2) {
            const float s = sink[h] * LOG2E;
            if (s > m) { const float f = exp2f(m - s); l *= f;
#pragma unroll
                for (int d = 0; d < 64; ++d) o[d] *= f;
                m = s; }
            l += exp2f(s - m);
        }
        const float rl = 1.f / l;
        const int ucol = type * 512 + h * 64;
        const uint4* gp = (const uint4*)(P + qrow * NIN + C_G + ucol);
        uint4* up = (uint4*)(U + qrow * MIX + ucol);
#pragma unroll
        for (int i = 0; i < 8; ++i) {
            const uint4 g = gp[i]; uint4 w;
            w.x = pk2(o[8 * i + 0] * rl * bf2f(g.x & 0xffffu), o[8 * i + 1] * rl * bf2f(g.x >> 16));
            w.y = pk2(o[8 * i + 2] * rl * bf2f(g.y & 0xffffu), o[8 * i + 3] * rl * bf2f(g.y >> 16));
            w.z = pk2(o[8 * i + 4] * rl * bf2f(g.z & 0xffffu), o[8 * i + 5] * rl * bf2f(g.z >> 16));
            w.w = pk2(o[8 * i + 6] * rl * bf2f(g.w & 0xffffu), o[8 * i + 7] * rl * bf2f(g.w >> 16));
            up[i] = w;
        }
    }
}

__device__ __forceinline__ void phase_final_norm(const Ctx& F0, float* x, const float* w) {
    const Ctx F = fresh(F0);
    const int gw = F.vcu * NWAVES + F.wave, NGW = F.G * NWAVES, lane = F.lane;
    for (int row = gw; row < ML; row += NGW) {
        float* xr = x + (size_t)row * DM;
        f32x4 xv[4]; float ss = 0.f;
#pragma unroll
        for (int j = 0; j < 4; ++j) { xv[j] = *(const f32x4*)(xr + 256 * j + 4 * lane); ss += xv[j][0] * xv[j][0] + xv[j][1] * xv[j][1] + xv[j][2] * xv[j][2] + xv[j][3] * xv[j][3]; }
        const float rstd = rsqrtf(wave_sum(ss) * (1.f / DM) + EPS);
#pragma unroll
        for (int j = 0; j < 4; ++j) { const f32x4 wv = *(const f32x4*)(w + 256 * j + 4 * lane); f32x4 y = xv[j] * rstd * wv; *(f32x4*)(xr + 256 * j + 4 * lane) = y; }
    }
}

struct Args { const float* in[14]; float* out; unsigned char* ws; int ph_lo, ph_hi; };
__global__ void __launch_bounds__(NTHREADS, 2) fwd_kernel(Args args) {
    extern __shared__ __attribute__((aligned(16))) unsigned char lds[];
    Ctx F;
    F.lds = (LAS unsigned char*)lds;
    F.tid = threadIdx.x; F.lane = F.tid & 63; F.wave = __builtin_amdgcn_readfirstlane(F.tid >> 6);
    F.G = gridDim.x; { const int bx = blockIdx.x; F.vcu = (F.G % 8 == 0) ? (bx % 8) * (F.G / 8) + bx / 8 : bx; }
    volatile LAS unsigned* MISC = (volatile LAS unsigned*)(F.lds + MISC_OFF);
    for (int u = F.tid; u < (LDS_BYTES - LDSCTL_OFF) / 4; u += NTHREADS) ((LAS unsigned*)(F.lds + LDSCTL_OFF))[u] = 0u;
    __syncthreads();
    unsigned char* ws = args.ws;
    unsigned* ctl = (unsigned*)(ws + WS_CTL);
    XcdBarrier bar; bar.bar = ctl + CW_BAR; bar.x = 0; bar.st = nullptr;
    if (!MK_PER_PHASE) bar = xcd_barrier_post(ctl + CW_BAR, MISC + 8);
    const float* x = args.in[0]; const float* c = args.in[1]; const float* ctxin = args.in[2]; const float* c_ctx = args.in[3];
    const float* norm_w = args.in[4]; const float* ada_w = args.in[5]; const float* ada_b = args.in[6];
    const float* w_in = args.in[7]; const float* w_out = args.in[8]; const float* qn = args.in[9]; const float* kn = args.in[10];
    const float* rpb = args.in[11]; const float* sink = args.in[12]; const float* fnw = args.in[13];
    float* out = args.out;
    float* tab = (float*)(ws + WS_TAB); float* mod = (float*)(ws + WS_MOD);
    bf16_t* wtin = (bf16_t*)(ws + WS_WTIN); bf16_t* wtout = (bf16_t*)(ws + WS_WTOUT); float* xctx = (float*)(ws + WS_XCTX);
    bf16_t* HX = (bf16_t*)(ws + WS_HXU); bf16_t* U = (bf16_t*)(ws + WS_HXU); bf16_t* P = (bf16_t*)(ws + WS_P);
    const int lo = args.ph_lo, hi = args.ph_hi;
#define IN(k) (lo <= (k) && (k) < hi)
#define SEAM(k) do { if (IN(k) && IN((k) + 1)) xcd_barrier(bar); } while (0)
    if (IN(0)) { phase_prologue(F, w_in, w_out, c, c_ctx, ada_w, ada_b, wtin, wtout, tab, mod); }
    SEAM(0);
#pragma unroll 1
    for (int l = 0; l < 2; ++l) {
        const float* xl = l == 0 ? x : out; const float* xc = l == 0 ? ctxin : xctx;
        const float* modl = mod + (size_t)l * 3 * 3072;
        const int pb = 1 + 4 * l;
        if (IN(pb)) phase_norm_mod(F, xl, xc, norm_w + l * DM, modl, HX);
        SEAM(pb);
        if (IN(pb + 1)) { pg8::Gemm g{HX, wtin + (size_t)l * NIN * DM, MT, NIN, DM}; pg8::StaticOrder S; S.init(MT, NIN, F.G, (int)blockIdx.x);
            pg8::EpiIn E{P, qn + l * 64, kn + l * 64, tab};
            pg8::gemm_phase<pg8::EpiIn, pg8::StaticOrder, true, true>(F.lds, g, S, E); }
        SEAM(pb + 1);
        if (IN(pb + 2)) phase_attn_naive(F, P, U, rpb + (size_t)l * 8 * 465, sink + l * 8, l == 0);
        SEAM(pb + 2);
        if (IN(pb + 3)) { const int mrows = l == 0 ? MT : ML; pg8::Gemm g{U, wtout + (size_t)l * DM * MIX, mrows, DM, MIX}; pg8::StaticOrder S; S.init(mrows, DM, F.G, (int)blockIdx.x);
            pg8::EpiOut E{modl, xl, xc, out, xctx};
            pg8::gemm_phase<pg8::EpiOut, pg8::StaticOrder, true, true>(F.lds, g, S, E); }
        SEAM(pb + 3);
    }
    if (IN(9)) phase_final_norm(F, out, fnw);
#undef IN
#undef SEAM
}

extern "C" void kernel_launch(void* const* d_in, const int* in_sizes, int n_in, void* d_out, int out_size, void* d_ws, size_t ws_size, hipStream_t stream) {
    static int grid = 0;
    if (grid == 0) {
        int dev = 0, cus = 0, per_cu = 0;
        if (n_in != 14 || ws_size < WS_END) { fprintf(stderr, "kernel_launch: unexpected inputs / workspace\n"); grid = -1; return; }
        if (hipGetDevice(&dev) != hipSuccess || hipDeviceGetAttribute(&cus, hipDeviceAttributeMultiprocessorCount, dev) != hipSuccess) { grid = -1; return; }
        if (hipFuncSetAttribute((const void*)fwd_kernel, hipFuncAttributeMaxDynamicSharedMemorySize, LDS_BYTES) != hipSuccess) { fprintf(stderr, "kernel_launch: hipFuncSetAttribute failed\n"); grid = -1; return; }
        if (hipOccupancyMaxActiveBlocksPerMultiprocessor(&per_cu, (const void*)fwd_kernel, NTHREADS, LDS_BYTES) != hipSuccess || per_cu < 1) { fprintf(stderr, "kernel_launch: occupancy query says %d\n", per_cu); }
        (void)hipGetLastError();
        grid = cus;
    }
    if (grid < 0) return;
    (void)hipMemsetAsync((char*)d_ws + WS_CTL, 0, CTL_ZERO_BYTES, stream);
    Args a{};
    for (int i = 0; i < 14; ++i) a.in[i] = (const float*)d_in[i];
    a.out = (float*)d_out; a.ws = (unsigned char*)d_ws;
#if MK_PER_PHASE
    for (int p = 0; p < NPHASES; ++p) { a.ph_lo = p; a.ph_hi = p + 1; hipLaunchKernelGGL(fwd_kernel, dim3(grid), dim3(NTHREADS), LDS_BYTES, stream, a); }
#else
    a.ph_lo = 0; a.ph_hi = NPHASES;
    hipLaunchKernelGGL(fwd_kernel, dim3(grid), dim3(NTHREADS), LDS_BYTES, stream, a);
#endif
}
```

```cpp
#include <hip/hip_runtime.h>
#include <cstdint>
#include <cstdio>

typedef unsigned short bf16_t;
typedef short bf16x8 __attribute__((ext_vector_type(8)));
typedef float f32x4 __attribute__((ext_vector_type(4)));
typedef unsigned u32x4 __attribute__((ext_vector_type(4)));
#define GAS __attribute__((address_space(1)))
#define LAS __attribute__((address_space(3)))

constexpr int DM = 1024, NB = 2, SEQ = 8192, CTX = 256;
constexpr int ML = NB * SEQ;
constexpr int MT = ML + NB * CTX;
constexpr int NIN = 4608, MIX = 1536;
constexpr int C_QA = 0, C_KA = 512, C_VA = 640, C_QB = 768, C_KB = 1280, C_VB = 1792, C_QC = 2304, C_KC = 2816, C_VC = 2944, C_G = 3072;
constexpr float LOG2E = 1.4426950408889634f;
constexpr float QSCALE = 0.125f * LOG2E;
constexpr float EPS = 1e-6f;
constexpr int NWAVES = 8, NTHREADS = 512;
#ifndef MK_PER_PHASE
#define MK_PER_PHASE 0
#endif
constexpr int NPHASES = 10;

constexpr size_t MiB = 1u << 20;
constexpr size_t WS_CTL = 0, CTL_ZERO_BYTES = 1 * MiB;
constexpr size_t WS_MOD = 65536;
constexpr size_t WS_TAB = 1 * MiB;
constexpr size_t WS_WTIN = 4 * MiB;
constexpr size_t WS_WTOUT = 22 * MiB;
constexpr size_t WS_XCTX = 28 * MiB;
constexpr size_t WS_HXU = 32 * MiB;
constexpr size_t WS_P = 82 * MiB;
constexpr size_t WS_END = WS_P + (size_t)MT * NIN * 2;
static_assert(WS_END <= 256 * MiB, "ws map");
constexpr int CW_BAR = 4096;
constexpr int RING_BYTES = 131072, LDSCTL_OFF = RING_BYTES, MISC_OFF = LDSCTL_OFF + 320, LDS_BYTES = 147456;

__device__ __forceinline__ unsigned f2bf(float f) { unsigned u = __builtin_bit_cast(unsigned, f); return (u + 0x7fffu + ((u >> 16) & 1u)) >> 16; }
__device__ __forceinline__ float bf2f(unsigned h) { return __builtin_bit_cast(float, h << 16); }
__device__ __forceinline__ unsigned pk2(float lo, float hi) { return f2bf(lo) | (f2bf(hi) << 16); }
__device__ __forceinline__ float silu_f(float v) { return v / (1.f + __expf(-v)); }
__device__ __forceinline__ float wave_sum(float v) {
#pragma unroll
    for (int o = 1; o < 64; o <<= 1) v += __shfl_xor(v, o);
    return v;
}
#define LDS_WAIT() asm volatile("s_waitcnt lgkmcnt(0)" ::: "memory")
__device__ __forceinline__ int lane_id_fresh() { int l; asm volatile("v_mbcnt_lo_u32_b32 %0, -1, 0\n\tv_mbcnt_hi_u32_b32 %0, -1, %0" : "=v"(l)); return l; }

#define XB_TMO      128
#define XB_XCNT(j)  (256  + 64 * (j))
#define XB_XSUB(j)  (1280 + 64 * (j))
#define XB_XGEN(j)  (2304 + 64 * (j))
#define XB_TOP      3328
#define XB_TOPGEN   3392
#define XCD_BAR_WORDS 3456
#define XB_SPIN_CAP (1u << 18)
__device__ __forceinline__ unsigned xb_ld(unsigned* p)              { return __hip_atomic_load(p, __ATOMIC_RELAXED, __HIP_MEMORY_SCOPE_AGENT); }
__device__ __forceinline__ unsigned xb_add(unsigned* p, unsigned v) { return __hip_atomic_fetch_add(p, v, __ATOMIC_RELAXED, __HIP_MEMORY_SCOPE_AGENT); }
__device__ __forceinline__ unsigned xb_xcc_id() { return (unsigned)__builtin_amdgcn_s_getreg((3 << 11) | 20) & 0xFu; }
#define XB_SPIN(cond, bar) do { unsigned _sp = 0; while (cond) { __builtin_amdgcn_s_sleep(1); \
    if ((++_sp & 255u) == 0u) { if (xb_ld(&(bar)[XB_TMO])) break; if (_sp > XB_SPIN_CAP) { atomicAdd(&(bar)[XB_TMO], 1u); break; } } } } while (0)
struct XcdBarrier { unsigned* bar; unsigned x; volatile LAS unsigned* st; };
__device__ __forceinline__ XcdBarrier xcd_barrier_post(unsigned* bar, volatile LAS unsigned* st) {
    XcdBarrier b; b.bar = bar; b.x = xb_xcc_id(); b.st = st;
    if (threadIdx.x == 0) (void)xb_add(&bar[XB_XCNT(b.x)], 1u);
    return b;
}
__device__ __forceinline__ void xcd_barrier_complete(unsigned* bar, unsigned x, unsigned& nloc, unsigned& nx) {
    const unsigned G = gridDim.x * gridDim.y * gridDim.z;
    unsigned sum, cnt, mine, sp = 0u;
    for (;;) {
        sum = 0u; cnt = 0u; mine = 0u;
#pragma unroll
        for (unsigned j = 0; j < 16; ++j) { const unsigned c = xb_ld(&bar[XB_XCNT(j)]); sum += c; cnt += (c > 0u) ? 1u : 0u; mine = (j == x) ? c : mine; }
        if (sum == G) break;
        __builtin_amdgcn_s_sleep(1);
        if ((++sp & 255u) == 0u) { if (xb_ld(&bar[XB_TMO])) break; if (sp > XB_SPIN_CAP) { atomicAdd(&bar[XB_TMO], 1u); break; } }
    }
    nloc = mine > 0u ? mine : 1u; nx = cnt > 0u ? cnt : 1u;
}
__device__ __forceinline__ void xcd_barrier(const XcdBarrier& b, const int wave) {
    asm volatile("s_waitcnt vmcnt(0)" ::: "memory");
    __syncthreads();
    if (wave == 0 && lane_id_fresh() == 0) {
        unsigned* bar = b.bar; asm volatile("" : "+s"(bar));
        __builtin_amdgcn_s_waitcnt(0);
        unsigned nloc = b.st[0], nx = b.st[1];
        if (nloc == 0u) { xcd_barrier_complete(bar, b.x, nloc, nx); b.st[0] = nloc; b.st[1] = nx; }
        const unsigned old = xb_add(&bar[XB_XSUB(b.x)], 1u);
        const unsigned gen = old / nloc;
        if (old + 1u == (gen + 1u) * nloc) {
            __builtin_amdgcn_fence(__ATOMIC_RELEASE, "agent");
            asm volatile("s_waitcnt vmcnt(0)" ::: "memory");
            const unsigned og = xb_add(&bar[XB_TOP], 1u);
            const unsigned tg = og / nx;
            if (og + 1u == (tg + 1u) * nx) xb_add(&bar[XB_TOPGEN], 1u);
            else XB_SPIN(xb_ld(&bar[XB_TOPGEN]) == tg, bar);
            __builtin_amdgcn_fence(__ATOMIC_ACQUIRE, "agent");
            xb_add(&bar[XB_XGEN(b.x)], 1u);
            asm volatile("s_waitcnt vmcnt(0)" ::: "memory");
        } else {
            XB_SPIN(xb_ld(&bar[XB_XGEN(b.x)]) == gen, bar);
            __builtin_amdgcn_fence(__ATOMIC_ACQUIRE, "agent");
            asm volatile("s_waitcnt vmcnt(0)" ::: "memory");
        }
    }
    __syncthreads();
}

namespace pg8 {
#define PG8_LAS __attribute__((address_space(3)))
typedef unsigned short bf16_t;
typedef short bf16x8 __attribute__((ext_vector_type(8)));
typedef float f32x4 __attribute__((ext_vector_type(4)));
typedef unsigned u32x4 __attribute__((ext_vector_type(4)));
constexpr int BM = 256, BK = 64, HALF = 128, HTB = HALF * BK * 2  , STAGE_BYTES = 8 * HTB, NXCD = 8, WGM = 8;

__host__ __device__ __forceinline__ int lds_byte(int r, int c) { const int st = (r >> 4) * 2 + (c >> 5), rr = r & 15, cc = c & 31, ob = rr * 64 + cc * 2; return st * 1024 + (ob ^ (((ob >> 9) & 1) << 5)); }
__host__ __device__ __forceinline__ void stage_rc(int b, int& R, int& C) { const int st = b / 1024, sb = b % 1024, swz = sb ^ (((sb >> 9) & 1) << 5); R = (st >> 1) * 16 + swz / 64; C = (st & 1) * 32 + (swz % 64) / 2; }
__host__ __device__ __forceinline__ int perm32(int rho) { const int n = rho >> 4, i = rho & 15; return 8 * (i >> 2) + 4 * n + (i & 3); }

struct Unit { int pm, pn; };
struct Gemm { const bf16_t* A; const bf16_t* Bt; int M, N, K; };

struct StaticOrder {
    int nM, nN, nwg, G, c;
    __host__ __device__ void init(int M, int N, int G_, int c_) { nM = M / BM; nN = N / BM; nwg = nM * nN; G = G_; c = c_; }
    __host__ __device__ bool next(int i, Unit& u) const {
        const long L = (long)i * G + c; if (L >= nwg) return false;
        int wgid = (int)L; { const int q = nwg / NXCD, r = nwg % NXCD, xcd = wgid % NXCD, off = wgid / NXCD; wgid = (xcd < r ? xcd * (q + 1) : r * (q + 1) + (xcd - r) * q) + off; }
        const int nig = WGM * nN, gid = wgid / nig, fm = gid * WGM, gsz = (nM - fm) < WGM ? (nM - fm) : WGM;
        u.pm = fm + ((wgid % nig) % gsz); u.pn = (wgid % nig) / gsz; return true;
    }
    __device__ __forceinline__ void a_ready(const Unit&) const {}
    __device__ __forceinline__ void done(const Unit&) const {}
};
__device__ __forceinline__ unsigned cvt_pk_bf16(float lo, float hi) { unsigned r; asm volatile("v_cvt_pk_bf16_f32 %0, %1, %2" : "=v"(r) : "v"(lo), "v"(hi)); return r; }
typedef float f32x2 __attribute__((ext_vector_type(2)));
struct EpiIn {
    static constexpr bool PERM = true, AFTER_DRAIN = false;
    bf16_t* P; const float* qn; const float* kn; const float* tab;
    __device__ __forceinline__ void operator()(const f32x4 (&acc)[2][2][4][2], const Unit& u, int wr, int wc, int fr, int fq) const {
        const int col0 = u.pn * BM + wc * 64;
        int kind;
        if (col0 < 512) kind = 1; else if (col0 < 640) kind = 2; else if (col0 < 768) kind = 0; else if (col0 < 1280) kind = 3; else if (col0 < 2304) kind = 0;
        else if (col0 < 2816) kind = 4; else if (col0 < 2944) kind = 5; else if (col0 < 3072) kind = 0; else kind = 6;
        kind = __builtin_amdgcn_readfirstlane(kind);
        const bool latent = u.pm < 64;
        const bool do_norm = kind == 1 || kind == 2, do_rope = (kind == 1 || kind == 2 || kind == 4 || kind == 5) && latent, do_scale = kind == 1 || kind == 3 || kind == 4;
        f32x4 wlo[2], whi[2];
        if (do_norm) { const float* w = kind == 1 ? qn : kn;
#pragma unroll
            for (int n = 0; n < 2; ++n) { wlo[n] = *(const f32x4*)(w + 8 * fq + 4 * n); whi[n] = *(const f32x4*)(w + 32 + 8 * fq + 4 * n); } }
#pragma unroll
        for (int ai = 0; ai < 2; ++ai)
#pragma unroll
            for (int m = 0; m < 4; ++m) {
                const int row = u.pm * BM + ai * HALF + wr * 64 + m * 16 + fr;
                f32x4 lo[2], hi[2];
#pragma unroll
                for (int n = 0; n < 2; ++n) { lo[n] = acc[ai][0][m][n]; hi[n] = acc[ai][1][m][n]; }
                if (do_norm) {
                    float ss = 0.f;
#pragma unroll
                    for (int n = 0; n < 2; ++n)
#pragma unroll
                        for (int j = 0; j < 4; ++j) ss += lo[n][j] * lo[n][j] + hi[n][j] * hi[n][j];
                    ss += __shfl_xor(ss, 16); ss += __shfl_xor(ss, 32);
                    const float rstd = rsqrtf(ss * (1.f / 64.f) + 1e-6f);
#pragma unroll
                    for (int n = 0; n < 2; ++n) { lo[n] = lo[n] * rstd * wlo[n]; hi[n] = hi[n] * rstd * whi[n]; }
                }
                if (do_rope) {
                    const int pr = (4 * u.pm + 2 * ai + wr) & 127, pc = 16 * m + fr;
                    const int pos = fq < 2 ? pr : pc;
                    const float* tp = tab + (pos * 16 + 8 * (fq & 1)) * 2;
#pragma unroll
                    for (int n = 0; n < 2; ++n) {
                        const f32x4 t0 = *(const f32x4*)(tp + 8 * n), t1 = *(const f32x4*)(tp + 8 * n + 4);
                        const float cs[4] = {t0[0], t0[2], t1[0], t1[2]}, sn[4] = {t0[1], t0[3], t1[1], t1[3]};
#pragma unroll
                        for (int j = 0; j < 4; ++j) { const float a = lo[n][j], b = hi[n][j]; lo[n][j] = a * cs[j] - b * sn[j]; hi[n][j] = a * sn[j] + b * cs[j]; }
                    }
                }
                if (do_scale) {
#pragma unroll
                    for (int n = 0; n < 2; ++n) { lo[n] = lo[n] * (0.125f * 1.4426950408889634f); hi[n] = hi[n] * (0.125f * 1.4426950408889634f); }
                }
                if (kind == 6) {
#pragma unroll
                    for (int n = 0; n < 2; ++n)
#pragma unroll
                        for (int j = 0; j < 4; ++j) { lo[n][j] = lo[n][j] / (1.f + __expf(-lo[n][j])); hi[n][j] = hi[n][j] / (1.f + __expf(-hi[n][j])); }
                }
                bf16_t* rowp = P + (size_t)row * 4608 + col0 + 8 * fq;
                u32x4 w0, w1;
                w0.x = cvt_pk_bf16(lo[0][0], lo[0][1]); w0.y = cvt_pk_bf16(lo[0][2], lo[0][3]); w0.z = cvt_pk_bf16(lo[1][0], lo[1][1]); w0.w = cvt_pk_bf16(lo[1][2], lo[1][3]);
                w1.x = cvt_pk_bf16(hi[0][0], hi[0][1]); w1.y = cvt_pk_bf16(hi[0][2], hi[0][3]); w1.z = cvt_pk_bf16(hi[1][0], hi[1][1]); w1.w = cvt_pk_bf16(hi[1][2], hi[1][3]);
                *(u32x4*)rowp = w0; *(u32x4*)(rowp + 32) = w1;
            }
    }
};
struct EpiOut {
    static constexpr bool PERM = false, AFTER_DRAIN = false;
    const float* mod; const float* xlat_in; const float* xctx_in; float* xlat_out; float* xctx_out;
    __device__ __forceinline__ void operator()(const f32x4 (&acc)[2][2][4][2], const Unit& u, int wr, int wc, int fr, int fq) const {
        const bool latent = u.pm < 64;
        const int v = latent ? (u.pm >> 5) : 2;
        const float* gate = mod + (size_t)v * 3072 + 2048;
        const float* xin = latent ? xlat_in : xctx_in - (size_t)16384 * 1024;
        float* xout = latent ? xlat_out : xctx_out - (size_t)16384 * 1024;
        const int col0 = u.pn * BM + wc * 32 + 4 * fq;
        f32x4 g[2][2];
#pragma unroll
        for (int bj = 0; bj < 2; ++bj)
#pragma unroll
            for (int n = 0; n < 2; ++n) g[bj][n] = *(const f32x4*)(gate + col0 + bj * HALF + n * 16);
#pragma unroll
        for (int ai = 0; ai < 2; ++ai)
#pragma unroll
            for (int m = 0; m < 4; ++m) { const size_t off = (size_t)(u.pm * BM + ai * HALF + wr * 64 + m * 16 + fr) * 1024 + col0;
#pragma unroll
                for (int bj = 0; bj < 2; ++bj)
#pragma unroll
                    for (int n = 0; n < 2; ++n) { const f32x4 xo = *(const f32x4*)(xin + off + bj * HALF + n * 16); *(f32x4*)(xout + off + bj * HALF + n * 16) = xo + g[bj][n] * acc[ai][bj][m][n]; }
            }
    }
};
template <class Epi, class Sched, bool ALIGN_EPI = false, bool SP2 = false>
__device__ __forceinline__ void gemm_phase(PG8_LAS unsigned char* lds, const Gemm g, const Sched& S, const Epi& E, const int wid  ) {
    int lane; asm volatile("v_mbcnt_lo_u32_b32 %0, -1, 0\n\tv_mbcnt_hi_u32_b32 %0, -1, %0" : "=v"(lane));
    const int tid = wid * 64 + lane, wr = wid >> 2, wc = wid & 3, fr = lane & 15, fq = lane >> 4;
    const int K = g.K, nt = K / BK;
    unsigned voffA[2], voffB[2];
#pragma unroll
    for (int i = 0; i < 2; ++i) { int R, C; stage_rc(tid * 16 + i * 8192, R, C); const int Rb = Epi::PERM ? ((R & ~31) + perm32(R & 31)) : R;
        voffA[i] = (unsigned)(R * K + C) * 2u; voffB[i] = (unsigned)(Rb * K + C) * 2u; }
    const size_t kstep = (size_t)(BK * 2);
    const size_t hstep = (size_t)HALF * K * 2;
    const size_t tstep = 2 * hstep;
    const unsigned ldsw = (unsigned)wid * 1024u;
    const int aoff = lds_byte(wr * 64 + fr, fq * 8), boff = lds_byte(wc * 32 + fr, fq * 8);
#define PG8_SA(b, h) (((b) * 2 + (h)) * HTB)
#define PG8_SB(b, h) ((4 + (b) * 2 + (h)) * HTB)
#define PG8_STAGE(bufoff, gbase, voff) do { _Pragma("unroll") for (int _i = 0; _i < 2; ++_i) \
        __builtin_amdgcn_global_load_lds((const unsigned*)((const char*)(gbase) + (voff)[_i]), (PG8_LAS unsigned*)(lds + (bufoff) + ldsw + _i * 8192), 16, 0, 0); } while (0)
#define PG8_LDA(dst, b, h) do { _Pragma("unroll") for (int m = 0; m < 4; ++m) _Pragma("unroll") for (int k = 0; k < 2; ++k) dst[m][k] = *(const PG8_LAS bf16x8*)(lds + PG8_SA(b, h) + aoff + m * 2048 + k * 1024); } while (0)
#define PG8_LDB(dst, b, h) do { _Pragma("unroll") for (int n = 0; n < 2; ++n) _Pragma("unroll") for (int k = 0; k < 2; ++k) dst[n][k] = *(const PG8_LAS bf16x8*)(lds + PG8_SB(b, h) + boff + n * 2048 + k * 1024); } while (0)
#define PG8_MMA(ai, bj, At, Bt) do { __builtin_amdgcn_s_setprio(1); _Pragma("unroll") for (int m = 0; m < 4; ++m) _Pragma("unroll") for (int n = 0; n < 2; ++n) _Pragma("unroll") for (int k = 0; k < 2; ++k) \
        acc[ai][bj][m][n] = __builtin_amdgcn_mfma_f32_16x16x32_bf16(Bt[n][k], At[m][k], acc[ai][bj][m][n], 0, 0, 0); __builtin_amdgcn_s_setprio(0); } while (0)
#define PG8_WAIT_V(n) asm volatile("s_waitcnt vmcnt(" #n ")" ::: "memory")
#define PG8_WAIT_L(n) asm volatile("s_waitcnt lgkmcnt(" #n ")" ::: "memory")
#define PG8_BAR __builtin_amdgcn_s_barrier()
#define PG8_SCHED __builtin_amdgcn_sched_barrier(0)
    Unit cur, nxt; int ui = 0;
    if (!S.next(0, cur)) return;
    f32x4 acc[2][2][4][2];
#pragma unroll
    for (int a = 0; a < 2; ++a)
#pragma unroll
        for (int b = 0; b < 2; ++b)
#pragma unroll
            for (int m = 0; m < 4; ++m)
#pragma unroll
                for (int n = 0; n < 2; ++n) acc[a][b][m][n] = (f32x4){0.f, 0.f, 0.f, 0.f};
    bf16x8 At[4][2], B0[2][2], B1[2][2];
    const char* cA = (const char*)g.A + (size_t)cur.pm * tstep; const char* cB = (const char*)g.Bt + (size_t)cur.pn * tstep;
    S.a_ready(cur);
    if constexpr (SP2) {
        PG8_STAGE(PG8_SB(0, 0), cB, voffB); PG8_STAGE(PG8_SB(0, 1), cB + hstep, voffB); PG8_STAGE(PG8_SA(0, 0), cA, voffA); PG8_STAGE(PG8_SA(0, 1), cA + hstep, voffA);
        if (wr == 1) PG8_BAR;
        PG8_WAIT_V(2); PG8_BAR;
        PG8_STAGE(PG8_SB(1, 0), cB + kstep, voffB); PG8_STAGE(PG8_SA(1, 0), cA + kstep, voffA); PG8_STAGE(PG8_SB(1, 1), cB + hstep + kstep, voffB);
        PG8_WAIT_V(6); PG8_BAR;
    } else {
        PG8_STAGE(PG8_SB(0, 0), cB, voffB); PG8_STAGE(PG8_SA(0, 0), cA, voffA); PG8_STAGE(PG8_SB(0, 1), cB + hstep, voffB); PG8_STAGE(PG8_SA(0, 1), cA + hstep, voffA);
        if (wr == 1) PG8_BAR;
        PG8_WAIT_V(4); PG8_BAR;
        PG8_STAGE(PG8_SB(1, 0), cB + kstep, voffB); PG8_STAGE(PG8_SA(1, 0), cA + kstep, voffA); PG8_STAGE(PG8_SB(1, 1), cB + hstep + kstep, voffB);
        PG8_WAIT_V(6); PG8_BAR;
    }
    for (;;) {
        const bool has_next = S.next(ui + 1, nxt);
        const char* nA = has_next ? (const char*)g.A + (size_t)nxt.pm * tstep : cA; const char* nB = has_next ? (const char*)g.Bt + (size_t)nxt.pn * tstep : cB;
        for (int t = 0; t < nt; t += 2) {
            const bool last = (t == nt - 2);
            const char* a1 = cA + (size_t)(t + 1) * kstep;
            const char* a2 = last ? nA : cA + (size_t)(t + 2) * kstep; const char* b2 = last ? nB : cB + (size_t)(t + 2) * kstep;
            const char* a3 = a2 + kstep; const char* b3 = b2 + kstep;
            if (last && has_next) S.a_ready(nxt);
            if constexpr (SP2) {
            PG8_LDB(B0, 0, 0); PG8_LDB(B1, 0, 1); PG8_SCHED; PG8_LDA(At, 0, 0); PG8_STAGE(PG8_SA(1, 1), a1 + hstep, voffA);
            PG8_WAIT_V(8); PG8_WAIT_L(0); PG8_BAR; PG8_MMA(0, 0, At, B0); PG8_MMA(0, 1, At, B1); PG8_BAR; PG8_SCHED;
            PG8_LDA(At, 0, 1); PG8_STAGE(PG8_SB(0, 0), b2, voffB); PG8_STAGE(PG8_SB(0, 1), b2 + hstep, voffB); PG8_STAGE(PG8_SA(0, 0), a2, voffA);
            PG8_WAIT_V(8); PG8_WAIT_L(0); PG8_BAR; PG8_MMA(1, 0, At, B0); PG8_MMA(1, 1, At, B1); PG8_BAR; PG8_SCHED;
            PG8_LDB(B0, 1, 0); PG8_LDB(B1, 1, 1); PG8_SCHED; PG8_LDA(At, 1, 0); PG8_STAGE(PG8_SA(0, 1), a2 + hstep, voffA);
            PG8_WAIT_V(8); PG8_WAIT_L(0); PG8_BAR; PG8_MMA(0, 0, At, B0); PG8_MMA(0, 1, At, B1); PG8_BAR; PG8_SCHED;
            PG8_LDA(At, 1, 1); PG8_STAGE(PG8_SB(1, 0), b3, voffB); PG8_STAGE(PG8_SB(1, 1), b3 + hstep, voffB); PG8_STAGE(PG8_SA(1, 0), a3, voffA);
            PG8_WAIT_V(8); PG8_WAIT_L(0); PG8_BAR; PG8_MMA(1, 0, At, B0); PG8_MMA(1, 1, At, B1); PG8_BAR; PG8_SCHED;
            } else {
            PG8_LDB(B0, 0, 0); PG8_SCHED; PG8_LDA(At, 0, 0); PG8_STAGE(PG8_SA(1, 1), a1 + hstep, voffA);
            PG8_WAIT_L(8); PG8_BAR; PG8_WAIT_L(0); PG8_MMA(0, 0, At, B0); PG8_BAR; PG8_SCHED;
            PG8_LDB(B1, 0, 1); PG8_STAGE(PG8_SB(0, 0), b2, voffB);
            PG8_BAR; PG8_WAIT_L(0); PG8_MMA(0, 1, At, B1); PG8_BAR;
            PG8_LDA(At, 0, 1); PG8_STAGE(PG8_SA(0, 0), a2, voffA);
            PG8_BAR; PG8_WAIT_L(0); PG8_MMA(1, 0, At, B0); PG8_BAR; PG8_SCHED;
            PG8_STAGE(PG8_SB(0, 1), b2 + hstep, voffB);
            PG8_WAIT_V(6); PG8_BAR; PG8_MMA(1, 1, At, B1); PG8_BAR;
            PG8_LDB(B0, 1, 0); PG8_SCHED; PG8_LDA(At, 1, 0); PG8_STAGE(PG8_SA(0, 1), a2 + hstep, voffA);
            PG8_WAIT_L(8); PG8_BAR; PG8_WAIT_L(0); PG8_MMA(0, 0, At, B0); PG8_BAR; PG8_SCHED;
            PG8_LDB(B1, 1, 1); PG8_STAGE(PG8_SB(1, 0), b3, voffB);
            PG8_BAR; PG8_WAIT_L(0); PG8_MMA(0, 1, At, B1); PG8_BAR;
            PG8_LDA(At, 1, 1); PG8_STAGE(PG8_SA(1, 0), a3, voffA);
            PG8_BAR; PG8_WAIT_L(0); PG8_MMA(1, 0, At, B0); PG8_BAR; PG8_SCHED;
            PG8_STAGE(PG8_SB(1, 1), b3 + hstep, voffB);
            PG8_WAIT_V(6); PG8_BAR; PG8_MMA(1, 1, At, B1); PG8_BAR;
            }
        }
        if constexpr (ALIGN_EPI) { if (wr == 0) PG8_BAR; }
        if constexpr (!Epi::AFTER_DRAIN) { E(acc, cur, wr, wc, fr, fq); S.done(cur); }
        if (!has_next) break;
#pragma unroll
        for (int a = 0; a < 2; ++a)
#pragma unroll
            for (int b = 0; b < 2; ++b)
#pragma unroll
                for (int m = 0; m < 4; ++m)
#pragma unroll
                    for (int n = 0; n < 2; ++n) acc[a][b][m][n] = (f32x4){0.f, 0.f, 0.f, 0.f};
        cur = nxt; cA = nA; cB = nB; ++ui;
        if constexpr (ALIGN_EPI) { if (wr == 1) PG8_BAR; }
    }
    PG8_WAIT_V(0);
    if constexpr (!ALIGN_EPI) { if (wr == 0) PG8_BAR; }
    PG8_BAR;
    if constexpr (Epi::AFTER_DRAIN) { E.fused(acc, cur, wr, wc, fr, fq, lds, wid, lane); S.done(cur); }
#undef PG8_SA
#undef PG8_SB
#undef PG8_STAGE
#undef PG8_LDA
#undef PG8_LDB
#undef PG8_MMA
#undef PG8_WAIT_V
#undef PG8_WAIT_L
#undef PG8_BAR
#undef PG8_SCHED
}
}

struct Ctx {
    LAS unsigned char* lds; int tid, lane, wave, vcu, G;
};
__device__ __forceinline__ Ctx fresh(const Ctx& F0) { Ctx F = F0; const int l = lane_id_fresh(); F.lane = l; F.tid = F0.wave * 64 + l; return F; }

template <bool PERMUTE>
__device__ __forceinline__ void p0_transpose_item(const float* W, int K, int N, bf16_t* WT, LAS float* scr, int item, int lane) {
    const int nblk = N / 32, kb = item / nblk, nb = item % nblk, k0 = 64 * kb, n0 = 32 * nb;
    const int r0 = PERMUTE ? ((n0 & ~255) + 128 * ((n0 >> 5) & 1) + 32 * ((n0 >> 6) & 3)) : n0;
#pragma unroll 8
    for (int i = 0; i < 32; ++i) { const int kk = 2 * i + (lane >> 5); scr[kk * 33 + (lane & 31)] = W[(size_t)(k0 + kk) * N + n0 + (lane & 31)]; }
    LDS_WAIT(); asm volatile("" ::: "memory");
    const int c = lane & 7;
#pragma unroll
    for (int j = 0; j < 4; ++j) { const int n = (lane >> 3) + 8 * j; const LAS float* s = scr + (8 * c) * 33 + n;
        u32x4 o; o.x = pk2(s[0 * 33], s[1 * 33]); o.y = pk2(s[2 * 33], s[3 * 33]); o.z = pk2(s[4 * 33], s[5 * 33]); o.w = pk2(s[6 * 33], s[7 * 33]);
        *(u32x4*)(WT + (size_t)(r0 + n) * K + k0 + 8 * c) = o; }
    LDS_WAIT(); asm volatile("" ::: "memory");
}

__device__ __forceinline__ void phase_prologue(const Ctx& F0, const float* w_in, const float* w_out, const float* c, const float* c_ctx, const float* ada_w, const float* ada_b,
                                               bf16_t* wtin, bf16_t* wtout, float* tab, float* mod) {
    const Ctx F = fresh(F0);
    LAS float* scr = (LAS float*)(F.lds + F.wave * 16384);
    const int gw = F.vcu * NWAVES + F.wave, NGW = F.G * NWAVES;
    constexpr int I_IN = (DM / 64) * (NIN / 32), I_OUT = (MIX / 64) * (DM / 32), NITEMS = 2 * (I_IN + I_OUT);
    for (int it = gw; it < NITEMS; it += NGW) {
        int r = it;
        if (r < I_IN) { p0_transpose_item<true>(w_in, DM, NIN, wtin, scr, r, F.lane); continue; } r -= I_IN;
        if (r < I_IN) { p0_transpose_item<true>(w_in + (size_t)DM * NIN, DM, NIN, wtin + (size_t)NIN * DM, scr, r, F.lane); continue; } r -= I_IN;
        if (r < I_OUT) { p0_transpose_item<false>(w_out, MIX, DM, wtout, scr, r, F.lane); continue; } r -= I_OUT;
        p0_transpose_item<false>(w_out + (size_t)MIX * DM, MIX, DM, wtout + (size_t)DM * MIX, scr, r, F.lane);
    }
    { const int idx = F.vcu * NTHREADS + F.tid;
      if (idx < 128 * 16) { const int pos = idx >> 4, i = idx & 15; const float freq = powf(10000.f, -(float)i / 16.f); const float ang = (float)pos * freq; tab[idx * 2] = cosf(ang); tab[idx * 2 + 1] = sinf(ang); } }
    { const int wk = F.vcu * 2 + (F.tid >> 8), NWK = F.G * 2, t = F.tid & 255;
      for (int it = wk; it < 2 * 16 * 12; it += NWK) {
          const int nb = it % 12, kc = (it / 12) % 16, l = it / 192; const int n = nb * 256 + t;
          float a0 = 0.f, a1 = 0.f, a2 = 0.f;
          const float* w = ada_w + ((size_t)l * DM + kc * 64) * 3072 + n;
#pragma unroll 8
          for (int k = 0; k < 64; ++k) { const float wv = w[(size_t)k * 3072]; const int kk = kc * 64 + k;
              a0 += silu_f(c[kk]) * wv; a1 += silu_f(c[DM + kk]) * wv; a2 += silu_f(c_ctx[kk]) * wv; }
          if (kc == 0) { const float bb = ada_b[l * 3072 + n]; a0 += bb; a1 += bb; a2 += bb; }
          float* p = mod + (size_t)l * 3 * 3072 + n;
          atomicAdd(p, a0); atomicAdd(p + 3072, a1); atomicAdd(p + 2 * 3072, a2);
      } }
}

__device__ __forceinline__ void phase_norm_mod(const Ctx& F0, const float* xlat, const float* xctx, const float* nw, const float* mod, bf16_t* HX) {
    const Ctx F = fresh(F0);
    const int gw = F.vcu * NWAVES + F.wave, NGW = F.G * NWAVES, lane = F.lane;
    for (int row = gw; row < MT; row += NGW) {
        const int v = row < ML ? row / SEQ : 2;
        const float* xr = row < ML ? xlat + (size_t)row * DM : xctx + (size_t)(row - ML) * DM;
        f32x4 xv[4]; float ss = 0.f;
#pragma unroll
        for (int j = 0; j < 4; ++j) { xv[j] = *(const f32x4*)(xr + 256 * j + 4 * lane); ss += xv[j][0] * xv[j][0] + xv[j][1] * xv[j][1] + xv[j][2] * xv[j][2] + xv[j][3] * xv[j][3]; }
        const float rstd = rsqrtf(wave_sum(ss) * (1.f / DM) + EPS);
        const float* shift = mod + (size_t)v * 3072; const float* scale = shift + 1024;
#pragma unroll
        for (int j = 0; j < 4; ++j) {
            const int k = 256 * j + 4 * lane;
            const f32x4 w = *(const f32x4*)(nw + k), sc = *(const f32x4*)(scale + k), sh = *(const f32x4*)(shift + k);
            float y[4];
#pragma unroll
            for (int e = 0; e < 4; ++e) y[e] = xv[j][e] * rstd * w[e] * (1.f + sc[e]) + sh[e];
            uint2 o; o.x = pk2(y[0], y[1]); o.y = pk2(y[2], y[3]);
            *(uint2*)(HX + (size_t)row * DM + k) = o;
        }
    }
}

namespace att {
typedef unsigned short bf16;
using bf16x8=__attribute__((ext_vector_type(8)))short;
using s16x4=__attribute__((ext_vector_type(4)))short;
using f32x16=__attribute__((ext_vector_type(16)))float;
using f32x4=__attribute__((ext_vector_type(4)))float;
using u32x4=__attribute__((ext_vector_type(4)))unsigned;
constexpr int PITCH=4608, UPITCH=1536, GCOL=3072;
constexpr int NW=8,QBLK=32,KVBLK=64;
constexpr int NSLOT=3, SLOTB=8192, OSTR=68  ;
constexpr int LDS_K=0, LDS_V=NSLOT*SLOTB, LDS_WS=2*NSLOT*SLOTB, LDS_OST=LDS_WS+NW*64*4, LDS_BIAS=LDS_OST+NW*32*OSTR*4, LDS_BYTES=LDS_BIAS+2048;
constexpr float L2E=1.4426950408889634f;
struct Unit {
  int type;
  int nt;
  int nlat;
  int ctx0, lat0;
  int first;
  int kcol, vcol;
  int qrow0, tq0;
  int h0, gqa;
};
__device__ __forceinline__ int crow(int r,int hi){return (r&3)+8*(r>>2)+4*hi;}
#define SBAR() __builtin_amdgcn_sched_barrier(0)
__device__ __forceinline__ void glds16(const void*gsrc,unsigned lds_dst){unsigned keep;
  asm volatile("s_mov_b32 %0, m0\n\ts_mov_b32 m0, %2\n\ts_nop 0\n\tglobal_load_lds_dwordx4 %1, off\n\ts_mov_b32 m0, %0":"=&s"(keep):"v"(gsrc),"s"(lds_dst):"memory");}
__device__ __forceinline__ float max3f(float a,float b,float c){float r;asm("v_max3_f32 %0, %1, %2, %3":"=v"(r):"v"(a),"v"(b),"v"(c));return r;}
__device__ __forceinline__ float max2f(float a,float b){float r;asm("v_max_f32_e32 %0, %1, %2":"=v"(r):"v"(a),"v"(b));return r;}
__device__ __forceinline__ float fadd_s(float a,float b){float r;asm("v_add_f32_e32 %0, %1, %2":"=v"(r):"v"(a),"v"(b));return r;}
__device__ __forceinline__ float fsub_s(float a,float b){float r;asm("v_sub_f32_e32 %0, %1, %2":"=v"(r):"v"(a),"v"(b));return r;}
typedef float f32x2_t __attribute__((ext_vector_type(2))); typedef __bf16 bf16x2_t __attribute__((ext_vector_type(2)));
__device__ __forceinline__ unsigned cvtpk_s(float lo,float hi){f32x2_t v={lo,hi};bf16x2_t b=__builtin_convertvector(v,bf16x2_t);return __builtin_bit_cast(unsigned,b);}
#define WAIT_BAR(N) asm volatile("s_waitcnt vmcnt(" #N ") lgkmcnt(0)\n\ts_barrier":::"memory")
__device__ __forceinline__ void qkt(f32x16&p0,f32x16&p1,const char*Kslot,const bf16x8*qr,const f32x16&negm,int r32,int hi){
  const char*kb=Kslot+hi*1024+r32*16;
  #pragma unroll
  for(int d0=0;d0<4;++d0){
    const bf16x8 b0=*reinterpret_cast<const bf16x8*>(kb+d0*2048);
    const bf16x8 b1=*reinterpret_cast<const bf16x8*>(kb+d0*2048+512);
    if(d0==0){p0=__builtin_amdgcn_mfma_f32_32x32x16_bf16(b0,qr[0],negm,0,0,0);p1=__builtin_amdgcn_mfma_f32_32x32x16_bf16(b1,qr[0],negm,0,0,0);}
    else{p0=__builtin_amdgcn_mfma_f32_32x32x16_bf16(b0,qr[d0],p0,0,0,0);p1=__builtin_amdgcn_mfma_f32_32x32x16_bf16(b1,qr[d0],p1,0,0,0);}}
}
typedef __attribute__((address_space(3))) const char* lds_cptr;
typedef short v4i16_t __attribute__((ext_vector_type(4)));
__device__ __forceinline__ void kload8(bf16x8*kf,lds_cptr kp){
  kf[0]=*(const __attribute__((address_space(3))) bf16x8*)(kp);      kf[1]=*(const __attribute__((address_space(3))) bf16x8*)(kp+512);
  kf[2]=*(const __attribute__((address_space(3))) bf16x8*)(kp+2048); kf[3]=*(const __attribute__((address_space(3))) bf16x8*)(kp+2560);
  kf[4]=*(const __attribute__((address_space(3))) bf16x8*)(kp+4096); kf[5]=*(const __attribute__((address_space(3))) bf16x8*)(kp+4608);
  kf[6]=*(const __attribute__((address_space(3))) bf16x8*)(kp+6144); kf[7]=*(const __attribute__((address_space(3))) bf16x8*)(kp+6656);
}
__device__ __forceinline__ void kload2(bf16x8*kf,lds_cptr kp,int j){ kf[2*j]=*(const __attribute__((address_space(3))) bf16x8*)(kp+j*2048); kf[2*j+1]=*(const __attribute__((address_space(3))) bf16x8*)(kp+j*2048+512); }
__device__ __forceinline__ s16x4 vtr(lds_cptr p){ return __builtin_bit_cast(s16x4,__builtin_amdgcn_ds_read_tr16_b64_v4i16((__attribute__((address_space(3))) v4i16_t*)p)); }
__device__ __forceinline__ float rowmax(const f32x16&p0,const f32x16&p1){
  float a=max3f(p0[0],p0[1],p1[0]),b=max3f(p0[2],p0[3],p1[1]);a=max3f(a,p1[2],p1[3]);
  #pragma unroll
  for(int r=4;r<16;r+=4){a=max3f(a,p0[r],p0[r+1]);b=max3f(b,p0[r+2],p0[r+3]);a=max3f(a,p1[r],p1[r+1]);b=max3f(b,p1[r+2],p1[r+3]);}
  const float m=max2f(a,b);
  auto rr=__builtin_amdgcn_permlane32_swap(__float_as_uint(m),__float_as_uint(m),false,false);
  return max2f(__uint_as_float(rr[0]),__uint_as_float(rr[1]));
}
__device__ __forceinline__ void pv(f32x16*o,int vb,bf16x8 pa0,bf16x8 pa1,bf16x8 pa2,bf16x8 pa3){
  #pragma unroll
  for(int d0=0;d0<2;++d0){s16x4 lo[4],hi[4];
    #pragma unroll
    for(int ks=0;ks<4;++ks){
      asm volatile("ds_read_b64_tr_b16 %0,%1 offset:%c2":"=&v"(lo[ks]):"v"(vb),"i"(d0*4096+ks*1024):"memory");
      asm volatile("ds_read_b64_tr_b16 %0,%1 offset:%c2":"=&v"(hi[ks]):"v"(vb),"i"(d0*4096+ks*1024+512):"memory");}
    asm volatile("s_waitcnt lgkmcnt(0)":::"memory");SBAR();
    #define PK(k) (bf16x8){lo[k][0],lo[k][1],lo[k][2],lo[k][3],hi[k][0],hi[k][1],hi[k][2],hi[k][3]}
    o[d0]=__builtin_amdgcn_mfma_f32_32x32x16_bf16(pa0,PK(0),o[d0],0,0,0);
    o[d0]=__builtin_amdgcn_mfma_f32_32x32x16_bf16(pa1,PK(1),o[d0],0,0,0);
    o[d0]=__builtin_amdgcn_mfma_f32_32x32x16_bf16(pa2,PK(2),o[d0],0,0,0);
    o[d0]=__builtin_amdgcn_mfma_f32_32x32x16_bf16(pa3,PK(3),o[d0],0,0,0);
    #undef PK
  }
}
template<int TYPE> __device__ __forceinline__ void amask(f32x16&c0,f32x16&c1,int li,int nlat,int mA,int mB,int u0,int u1,const float*bt){
  const float NEG=-INFINITY;
  bool dead = li>=nlat;
  if(TYPE==1) dead = dead || (unsigned)(li-u0)>=8u;
  if(dead){
    #pragma unroll
    for(int r=0;r<16;++r){c0[r]=NEG;c1[r]=NEG;}
    return; }
  if(TYPE==1){
    const float*row=bt+(li-u1+7)*31;
    #pragma unroll
    for(int r=0;r<16;++r){ const int kk0=(r&3)+8*(r>>2);
      int i0=kk0+mB; i0=i0<0?0:(i0>30?30:i0); int i1=kk0+32+mB; i1=i1<0?0:(i1>30?30:i1);
      const float b0=row[i0], b1=row[i1];
      c0[r]=((unsigned)(kk0+mA)<16u)?c0[r]+b0:NEG; c1[r]=((unsigned)(kk0+32+mA)<16u)?c1[r]+b1:NEG; }
  } else {
    const int base=mA+64*li;
    #pragma unroll
    for(int r=0;r<16;++r){ const int kk0=(r&3)+8*(r>>2);
      if((unsigned)(kk0+base)>256u)c0[r]=NEG; if((unsigned)(kk0+32+base)>256u)c1[r]=NEG; }
  }
}

template<int TYPE,int THRL> __device__ __forceinline__ void attn_unit(const Unit&ud,const bf16*__restrict__ P,bf16*__restrict__ U,const float*rpbl,const float*sinkl,char*shm,const int wid){
  int lane; asm volatile("v_mbcnt_lo_u32_b32 %0, -1, 0\n\tv_mbcnt_hi_u32_b32 %0, -1, %0":"=v"(lane));
  const int tid=wid*64+lane,r32=lane&31,hi=lane>>5;
  const int hq=ud.gqa?ud.h0+(wid&3):ud.h0, qoff=ud.gqa?32*(wid>>2):32*wid;
  const int qcol=(TYPE==0?0:TYPE==1?768:2304)+hq*64, ucol=TYPE*512+hq*64;
  const long qrow=ud.qrow0+qoff;
  const bf16*Qw=P+qrow*PITCH+qcol;
  const unsigned lds0=(unsigned)(uintptr_t)shm;
  float*wsf=(float*)(shm+LDS_WS)+wid*64;
  const bf16*ksrc=P+(long)lane*PITCH+ud.kcol+wid*8;
  const bf16*vsrc=P+(long)(16*(wid&3)+(lane>>2))*PITCH+ud.vcol+(wid>>2)*32+(lane&3)*8;
  const unsigned kdst=lds0+LDS_K+wid*1024, vdst=lds0+LDS_V+wid*1024;
  const int NT=ud.nt, nlat=ud.nlat;
  #define TROW(t) ((long)(((t)<4)?(ud.ctx0+64*(t)):(ud.lat0+64*((((t)-4)<nlat)?((t)-4):(nlat-1)))))
  #define DMA_K(t,slot) glds16(ksrc+TROW(t)*PITCH,(unsigned)__builtin_amdgcn_readfirstlane(kdst+(slot)))
  #define DMA_V(t,slot) glds16(vsrc+TROW(t)*PITCH,(unsigned)__builtin_amdgcn_readfirstlane(vdst+(slot)))
  const int vb0=(int)(lds0+LDS_V)+((lane>>4)&1)*32+(lane&3)*8+(4*hi+((lane&15)>>2))*64;
  const char*Kbase=shm+LDS_K; bf16x8 kf[8];
  const lds_cptr shm3=(lds_cptr)shm; const lds_cptr kp0=shm3+LDS_K+hi*1024+r32*16; const lds_cptr vp0=shm3+LDS_V+((lane>>4)&1)*32+(lane&3)*8+(4*hi+((lane&15)>>2))*64;
  int mA=0,mB=0,u0=0,u1=0; const float*bt=(const float*)(shm+LDS_BIAS);
  if(TYPE==1){ const int tqw=ud.tq0+qoff, qg=tqw>>6, qc=(tqw&63)+r32; int rs=qg-4; rs=rs<0?0:(rs>120?120:rs); int cs=qc-8; cs=cs<0?0:(cs>48?48:cs);
    mA=4*hi-cs; mB=4*hi-qc+15; u0=rs-ud.first; u1=qg-ud.first;
    float*btw=(float*)(shm+LDS_BIAS); for(int i=tid;i<465;i+=512)btw[i]=rpbl[hq*465+i]*L2E; }
  if(TYPE==2){ const int tq=ud.tq0+qoff+r32; mA=4*hi-(tq-64*ud.first)+128; }
  DMA_K(0,0);DMA_V(0,0);DMA_K(1,SLOTB);
  bf16x8 qr[4];
  #pragma unroll
  for(int d0=0;d0<4;++d0)qr[d0]=*reinterpret_cast<const bf16x8*>(&Qw[(long)r32*PITCH+d0*16+hi*8]);
  float mhat=0.f,l_reg=0.f;f32x16 o[2];o[0]=f32x16{};o[1]=f32x16{};f32x16 negm=f32x16{};asm volatile("":"+v"(negm));
  #define AMASK(P0,P1,t) do{ if(TYPE!=0){ if((t)>=4) amask<TYPE>(P0,P1,(t)-4,nlat,mA,mB,u0,u1,bt); } }while(0)
  bool resc=false;
  #define START(P0,P1) do{ const float rm=rowmax(P0,P1); resc=false; \
    { const float dl=rm; mhat=fadd_s(mhat,dl); \
      _Pragma("unroll") for(int r=0;r<16;++r){P0[r]=fsub_s(P0[r],dl);P1[r]=fsub_s(P1[r],dl);} \
      _Pragma("unroll") for(int r=0;r<16;++r)negm[r]=-mhat; asm volatile("":"+v"(negm)); } \
    _Pragma("unroll") for(int r=0;r<16;++r)P0[r]=__builtin_amdgcn_exp2f(P0[r]); }while(0)
  #define RESC() do{ if(resc){ asm volatile("s_waitcnt lgkmcnt(0)":::"memory"); \
      _Pragma("unroll") for(int d_=0;d_<2;++d_) _Pragma("unroll") for(int r=0;r<16;++r)o[d_][r]*=wsf[crow(r,hi)]; } }while(0)
  f32x16 pA0,pA1,pB0,pB1;
  int sl_prev=0,sl_cur=0,sl_next=SLOTB;
  #define ROT() do{sl_prev=sl_cur;sl_cur=sl_next;sl_next=(sl_next==(NSLOT-1)*SLOTB)?0:sl_next+SLOTB;}while(0)
  DMA_K(2,2*SLOTB);
  WAIT_BAR(3);
  qkt(pA0,pA1,Kbase,qr,negm,r32,hi);asm volatile("s_nop 15\n\ts_nop 7":"+v"(pA0),"+v"(pA1));
  START(pA0,pA1);
  _Pragma("unroll") for(int r=0;r<16;++r)pA1[r]=__builtin_amdgcn_exp2f(pA1[r]);
  WAIT_BAR(0);
  DMA_K(3,0);DMA_V(1,SLOTB);
  ROT();
  kload8(kf,kp0+sl_cur);
  WAIT_BAR(2);
  s16x4 vlo[8],vhi[8]; u32x4 pw0,pw1,pw2,pw3;
  #define PKW(P,B) cvtpk_s(P[B],P[B+1])
  #define PAF(k) __builtin_bit_cast(bf16x8,pw##k)
  #define VFR(i) (bf16x8){vlo[i][0],vlo[i][1],vlo[i][2],vlo[i][3],vhi[i][0],vhi[i][1],vhi[i][2],vhi[i][3]}
  #define PIN(x) asm volatile("":"+v"(x))
  #define MX3(a,b,c) __builtin_fmaxf(__builtin_fmaxf((a),(b)),(c))
  #define GAPA(MF,A0,A1,A2,A3,W0,W1,PW) do{ MF; sacc+=A0; sacc+=A1; sacc+=A2; sacc+=A3; PIN(sacc); W0; W1; PIN(PW); SBAR(); }while(0)
  #define EX(v) __builtin_amdgcn_exp2f(v)
  #define GAPB(MF,X,B) do{ MF; X[B]=EX(X[B]); X[B+1]=EX(X[B+1]); X[B+2]=EX(X[B+2]); X[B+3]=EX(X[B+3]); PIN(X); SBAR(); }while(0)
  #define VRD(i) do{ vlo[i]=vtr(vp_+(((i)>>2)*4096+((i)&3)*1024)); vhi[i]=vtr(vp_+(((i)>>2)*4096+((i)&3)*1024+512)); }while(0)
  #define KRD(G,j) do{ if(G){ kload2(kf,kp0+sl_next,j); SBAR(); } }while(0)
  #define STEP(C0,C1,P0,P1,t,GK,GV,GL) do{ SBAR(); \
    const lds_cptr vp_=vp0+sl_prev; \
    VRD(0); SBAR(); float sacc=(P0[0]+P0[1]); \
    GAPA(C0=__builtin_amdgcn_mfma_f32_32x32x16_bf16(kf[0],qr[0],negm,0,0,0), P0[2],P0[3],P0[4],P0[5],     pw0[0]=PKW(P0,0), pw0[1]=PKW(P0,2), pw0); \
    VRD(4); SBAR(); GAPA(C1=__builtin_amdgcn_mfma_f32_32x32x16_bf16(kf[1],qr[0],negm,0,0,0), P0[6],P0[7],P0[8],P0[9],     pw0[2]=PKW(P0,4), pw0[3]=PKW(P0,6), pw0); \
    VRD(1); SBAR(); GAPA(C0=__builtin_amdgcn_mfma_f32_32x32x16_bf16(kf[2],qr[1],C0,0,0,0),   P0[10],P0[11],P0[12],P0[13], pw1[0]=PKW(P0,8), pw1[1]=PKW(P0,10), pw1); \
    VRD(5); SBAR(); GAPA(C1=__builtin_amdgcn_mfma_f32_32x32x16_bf16(kf[3],qr[1],C1,0,0,0),   P0[14],P0[15],P1[0],P1[1],   pw1[2]=PKW(P0,12),pw1[3]=PKW(P0,14), pw1); \
    VRD(2); SBAR(); GAPA(C0=__builtin_amdgcn_mfma_f32_32x32x16_bf16(kf[4],qr[2],C0,0,0,0),   P1[2],P1[3],P1[4],P1[5],     pw2[0]=PKW(P1,0), pw2[1]=PKW(P1,2), pw2); \
    VRD(6); SBAR(); GAPA(C1=__builtin_amdgcn_mfma_f32_32x32x16_bf16(kf[5],qr[2],C1,0,0,0),   P1[6],P1[7],P1[8],P1[9],     pw2[2]=PKW(P1,4), pw2[3]=PKW(P1,6), pw2); \
    VRD(3); SBAR(); GAPA(C0=__builtin_amdgcn_mfma_f32_32x32x16_bf16(kf[6],qr[3],C0,0,0,0),   P1[10],P1[11],P1[12],P1[13], pw3[0]=PKW(P1,8), pw3[1]=PKW(P1,10), pw3); \
    VRD(7); SBAR(); GAPA(C1=__builtin_amdgcn_mfma_f32_32x32x16_bf16(kf[7],qr[3],C1,0,0,0),   P1[14],P1[15],0.f,0.f,       pw3[2]=PKW(P1,12),pw3[3]=PKW(P1,14), pw3); \
    l_reg+=sacc; \
    if(GK){DMA_K((t)+3,sl_cur);} if(GV){DMA_V((t)+1,sl_next);} \
    AMASK(C0,C1,t); \
    { float a=MX3(C0[0],C0[1],C1[0]),b=MX3(C0[2],C0[3],C1[1]); a=MX3(a,C1[2],C1[3]); \
      _Pragma("unroll") for(int r=4;r<16;r+=4){a=MX3(a,C0[r],C0[r+1]);b=MX3(b,C0[r+2],C0[r+3]);a=MX3(a,C1[r],C1[r+1]);b=MX3(b,C1[r+2],C1[r+3]);} \
      float rm=__builtin_fmaxf(a,b); { auto rr=__builtin_amdgcn_permlane32_swap(__float_as_uint(rm),__float_as_uint(rm),false,false); rm=__builtin_fmaxf(__uint_as_float(rr[0]),__uint_as_float(rr[1])); } \
      resc=false; \
      if(__builtin_expect(__any(rm>(float)THRL),0)){ const float dl=__builtin_fmaxf(rm,0.f); mhat+=dl; \
        _Pragma("unroll") for(int r=0;r<16;++r){C0[r]-=dl;C1[r]-=dl;} \
        _Pragma("unroll") for(int r=0;r<16;++r)negm[r]=-mhat; asm volatile("":"+v"(negm)); \
        const float f=__builtin_amdgcn_exp2f(-dl); l_reg*=f; if(hi==0)wsf[r32]=f; resc=true; } } \
    SBAR(); \
    GAPB(o[0]=__builtin_amdgcn_mfma_f32_32x32x16_bf16(PAF(0),VFR(0),o[0],0,0,0), C0,0); \
    GAPB(o[1]=__builtin_amdgcn_mfma_f32_32x32x16_bf16(PAF(0),VFR(4),o[1],0,0,0), C0,4); \
    KRD(GL,0); GAPB(o[0]=__builtin_amdgcn_mfma_f32_32x32x16_bf16(PAF(1),VFR(1),o[0],0,0,0), C0,8); \
    KRD(GL,1); GAPB(o[1]=__builtin_amdgcn_mfma_f32_32x32x16_bf16(PAF(1),VFR(5),o[1],0,0,0), C0,12); \
    KRD(GL,2); GAPB(o[0]=__builtin_amdgcn_mfma_f32_32x32x16_bf16(PAF(2),VFR(2),o[0],0,0,0), C1,0); \
    KRD(GL,3); GAPB(o[1]=__builtin_amdgcn_mfma_f32_32x32x16_bf16(PAF(2),VFR(6),o[1],0,0,0), C1,4); \
    GAPB(o[0]=__builtin_amdgcn_mfma_f32_32x32x16_bf16(PAF(3),VFR(3),o[0],0,0,0), C1,8); \
    GAPB(o[1]=__builtin_amdgcn_mfma_f32_32x32x16_bf16(PAF(3),VFR(7),o[1],0,0,0), C1,12); \
    }while(0)
  int t=1;
  if(TYPE==0){
    for(;t+5<NT;t+=2){
      STEP(pB0,pB1,pA0,pA1,t,true,true,true);     WAIT_BAR(2); RESC(); ROT();
      STEP(pA0,pA1,pB0,pB1,t+1,true,true,true);   WAIT_BAR(2); RESC(); ROT();
    }
  }
  #define ENDW(tt) do{ if((tt)+3<NT){WAIT_BAR(2);} else if((tt)+2<NT){WAIT_BAR(1);} else {WAIT_BAR(0);} }while(0)
  for(;t+1<NT;t+=2){
    STEP(pB0,pB1,pA0,pA1,t,(t+3<NT),(t+1<NT),(t+1<NT));       ENDW(t);   RESC(); ROT();
    STEP(pA0,pA1,pB0,pB1,t+1,(t+4<NT),(t+2<NT),(t+2<NT));     ENDW(t+1); RESC(); ROT();
  }
  STEP(pB0,pB1,pA0,pA1,NT-1,false,false,false); RESC();
  { float sacc=pB0[0]+pB0[1]; _Pragma("unroll") for(int r=2;r<16;++r)sacc+=pB0[r]; _Pragma("unroll") for(int r=0;r<16;++r)sacc+=pB1[r]; l_reg+=sacc;
    pw0=(u32x4){PKW(pB0,0),PKW(pB0,2),PKW(pB0,4),PKW(pB0,6)};pw1=(u32x4){PKW(pB0,8),PKW(pB0,10),PKW(pB0,12),PKW(pB0,14)};pw2=(u32x4){PKW(pB1,0),PKW(pB1,2),PKW(pB1,4),PKW(pB1,6)};pw3=(u32x4){PKW(pB1,8),PKW(pB1,10),PKW(pB1,12),PKW(pB1,14)};
    SBAR(); pv(o,vb0+sl_cur,PAF(0),PAF(1),PAF(2),PAF(3)); }
  #undef PKW
  #undef PAF
  #undef VFR
  #undef PIN
  #undef MX3
  #undef GAPA
  #undef GAPB
  #undef EX
  #undef VRD
  #undef KRD
  #undef STEP
  #undef ENDW
  {auto rr=__builtin_amdgcn_permlane32_swap(__float_as_uint(l_reg),__float_as_uint(l_reg),false,false);l_reg=__uint_as_float(rr[0])+__uint_as_float(rr[1]);}
  if(TYPE==2) l_reg+=__builtin_amdgcn_exp2f(sinkl[hq]*L2E-mhat);
  if(hi==0)wsf[32+r32]=l_reg;asm volatile("s_waitcnt lgkmcnt(0)":::"memory");
  float rli[16];
  #pragma unroll
  for(int r=0;r<16;++r)rli[r]=__builtin_amdgcn_rcpf(wsf[32+crow(r,hi)]);
  { float*stg=(float*)(shm+LDS_OST)+wid*(32*OSTR);
    #pragma unroll
    for(int r=0;r<16;++r){const int orow=crow(r,hi);
      #pragma unroll
      for(int d0=0;d0<2;++d0)stg[orow*OSTR+d0*32+r32]=o[d0][r]*rli[r];}
    asm volatile("s_waitcnt lgkmcnt(0)":::"memory");
    #pragma unroll
    for(int i=0;i<4;++i){const int row=i*8+(lane>>3),ch=lane&7;
      const f32x4 a=*(const f32x4*)(stg+row*OSTR+ch*8), b=*(const f32x4*)(stg+row*OSTR+ch*8+4);
      const u32x4 g=*(const u32x4*)(P+(qrow+row)*PITCH+GCOL+ucol+ch*8);
      u32x4 w;
      w.x=cvtpk_s(a[0]*__uint_as_float(g.x<<16),a[1]*__uint_as_float(g.x&0xffff0000u)); w.y=cvtpk_s(a[2]*__uint_as_float(g.y<<16),a[3]*__uint_as_float(g.y&0xffff0000u));
      w.z=cvtpk_s(b[0]*__uint_as_float(g.z<<16),b[1]*__uint_as_float(g.z&0xffff0000u)); w.w=cvtpk_s(b[2]*__uint_as_float(g.w<<16),b[3]*__uint_as_float(g.w&0xffff0000u));
      *(u32x4*)(U+(qrow+row)*UPITCH+ucol+ch*8)=w; } }
  asm volatile("s_waitcnt lgkmcnt(0)\n\ts_barrier":::"memory");
  #undef TROW
  #undef DMA_K
  #undef DMA_V
  #undef AMASK
  #undef START
  #undef RESC
  #undef ROT
}
constexpr int THRL_DEFAULT=8;
__device__ __forceinline__ Unit unit_A(int ua){ Unit u; const int b=ua>>8,h=(ua>>5)&7,qb=ua&31; u.type=0; u.nt=132; u.nlat=128; u.ctx0=16384+256*b; u.lat0=8192*b; u.first=0;
  u.kcol=512+64*(h>>2); u.vcol=640+64*(h>>2); u.qrow0=8192*b+256*qb; u.tq0=256*qb; u.h0=h; u.gqa=0; return u; }
__device__ __forceinline__ Unit unit_B(int ub){ Unit u; const int b=ub>>8,h=(ub>>5)&7,qb=ub&31; u.type=1;
  int f=4*qb-4; f=f<0?0:(f>120?120:f); int l=4*qb+3-4; l=l<0?0:(l>120?120:l); l+=7;
  u.first=f; u.nlat=l-f+1; u.nt=(4+u.nlat+1)&~1; u.ctx0=16384+256*b; u.lat0=8192*b+64*f;
  u.kcol=1280+64*h; u.vcol=1792+64*h; u.qrow0=8192*b+256*qb; u.tq0=256*qb; u.h0=h; u.gqa=0; return u; }
__device__ __forceinline__ Unit unit_C(int uc){ Unit u; const int b=uc>>8,kvh=(uc>>7)&1,qb=uc&127; u.type=2;
  const int f=qb-2<0?0:qb-2, l=qb+2>127?127:qb+2;
  u.first=f; u.nlat=l-f+1; u.nt=(4+u.nlat+1)&~1; u.ctx0=16384+256*b; u.lat0=8192*b+64*f;
  u.kcol=2816+64*kvh; u.vcol=2944+64*kvh; u.qrow0=8192*b+64*qb; u.tq0=64*qb; u.h0=4*kvh; u.gqa=1; return u; }
__device__ __forceinline__ Unit unit_ctx(int ux){ Unit u; const int type=ux>>4,b=(ux>>3)&1,h=ux&7; u.type=type; u.nt=4; u.nlat=0; u.ctx0=16384+256*b; u.lat0=0; u.first=0;
  const int kvh=(type==1)?h:(h>>2); u.kcol=(type==0?512:type==1?1280:2816)+64*kvh; u.vcol=(type==0?640:type==1?1792:2944)+64*kvh;
  u.qrow0=16384+256*b; u.tq0=0; u.h0=h; u.gqa=0; return u; }
__device__ __forceinline__ void run_unit(const Unit&u,const bf16*P,bf16*U,const float*rpbl,const float*sinkl,char*lds,const int wid){
  if(u.type==0) attn_unit<0,THRL_DEFAULT>(u,P,U,rpbl,sinkl,lds,wid);
  else if(u.type==1) attn_unit<1,THRL_DEFAULT>(u,P,U,rpbl,sinkl,lds,wid);
  else attn_unit<2,THRL_DEFAULT>(u,P,U,rpbl,sinkl,lds,wid);
}
__device__ __forceinline__ void attn_phase(int vcu,int G,const bf16*P,bf16*U,const float*rpbl,const float*sinkl,bool need_ctx,char*lds,const int wid){
  for(int ua=2*vcu;ua<512;ua+=2*G){ run_unit(unit_A(ua),P,U,rpbl,sinkl,lds,wid); run_unit(unit_A(ua+1),P,U,rpbl,sinkl,lds,wid); }
  for(int ub=2*vcu;ub<512;ub+=2*G){ run_unit(unit_B(ub),P,U,rpbl,sinkl,lds,wid); run_unit(unit_B(ub+1),P,U,rpbl,sinkl,lds,wid); }
  for(int uc=2*vcu;uc<512;uc+=2*G){ run_unit(unit_C(uc),P,U,rpbl,sinkl,lds,wid); run_unit(unit_C(uc+1),P,U,rpbl,sinkl,lds,wid); }
  if(need_ctx) for(int ux=vcu;ux<48;ux+=G) run_unit(unit_ctx(ux),P,U,rpbl,sinkl,lds,wid);
}
#undef SBAR
#undef WAIT_BAR
}

__device__ __forceinline__ void phase_final_norm(const Ctx& F0, float* x, const float* w) {
    const Ctx F = fresh(F0);
    const int gw = F.vcu * NWAVES + F.wave, NGW = F.G * NWAVES, lane = F.lane;
    for (int row = gw; row < ML; row += NGW) {
        float* xr = x + (size_t)row * DM;
        f32x4 xv[4]; float ss = 0.f;
#pragma unroll
        for (int j = 0; j < 4; ++j) { xv[j] = *(const f32x4*)(xr + 256 * j + 4 * lane); ss += xv[j][0] * xv[j][0] + xv[j][1] * xv[j][1] + xv[j][2] * xv[j][2] + xv[j][3] * xv[j][3]; }
        const float rstd = rsqrtf(wave_sum(ss) * (1.f / DM) + EPS);
#pragma unroll
        for (int j = 0; j < 4; ++j) { const f32x4 wv = *(const f32x4*)(w + 256 * j + 4 * lane); f32x4 y = xv[j] * rstd * wv; *(f32x4*)(xr + 256 * j + 4 * lane) = y; }
    }
}

struct Args { const float* in[14]; float* out; unsigned char* ws; int ph_lo, ph_hi; };
__global__ void __launch_bounds__(NTHREADS, 2) fwd_kernel(Args args) {
    extern __shared__ __attribute__((aligned(16))) unsigned char lds[];
    Ctx F;
    F.lds = (LAS unsigned char*)lds;
    F.wave = __builtin_amdgcn_readfirstlane((int)threadIdx.x >> 6); F.lane = lane_id_fresh(); F.tid = F.wave * 64 + F.lane;
    F.G = gridDim.x; { const int bx = blockIdx.x; F.vcu = (F.G % 8 == 0) ? (bx % 8) * (F.G / 8) + bx / 8 : bx; }
    volatile LAS unsigned* MISC = (volatile LAS unsigned*)(F.lds + MISC_OFF);
    for (int u = F.tid; u < (LDS_BYTES - LDSCTL_OFF) / 4; u += NTHREADS) ((LAS unsigned*)(F.lds + LDSCTL_OFF))[u] = 0u;
    __syncthreads();
    unsigned char* ws = args.ws;
    unsigned* ctl = (unsigned*)(ws + WS_CTL);
    XcdBarrier bar; bar.bar = ctl + CW_BAR; bar.x = 0; bar.st = nullptr;
    if (!MK_PER_PHASE) bar = xcd_barrier_post(ctl + CW_BAR, MISC + 8);
    const float* x = args.in[0]; const float* c = args.in[1]; const float* ctxin = args.in[2]; const float* c_ctx = args.in[3];
    const float* norm_w = args.in[4]; const float* ada_w = args.in[5]; const float* ada_b = args.in[6];
    const float* w_in = args.in[7]; const float* w_out = args.in[8]; const float* qn = args.in[9]; const float* kn = args.in[10];
    const float* rpb = args.in[11]; const float* sink = args.in[12]; const float* fnw = args.in[13];
    float* out = args.out;
    float* tab = (float*)(ws + WS_TAB); float* mod = (float*)(ws + WS_MOD);
    bf16_t* wtin = (bf16_t*)(ws + WS_WTIN); bf16_t* wtout = (bf16_t*)(ws + WS_WTOUT); float* xctx = (float*)(ws + WS_XCTX);
    bf16_t* HX = (bf16_t*)(ws + WS_HXU); bf16_t* U = (bf16_t*)(ws + WS_HXU); bf16_t* P = (bf16_t*)(ws + WS_P);
    const int lo = args.ph_lo, hi = args.ph_hi;
#define IN(k) (lo <= (k) && (k) < hi)
#define SEAM(k) do { if (IN(k) && IN((k) + 1)) xcd_barrier(bar, F.wave); } while (0)
    if (IN(0)) { phase_prologue(F, w_in, w_out, c, c_ctx, ada_w, ada_b, wtin, wtout, tab, mod); }
    SEAM(0);
#pragma unroll 1
    for (int l = 0; l < 2; ++l) {
        const float* xl = l == 0 ? x : out; const float* xc = l == 0 ? ctxin : xctx;
        const float* modl = mod + (size_t)l * 3 * 3072;
        const int pb = 1 + 4 * l;
        if (IN(pb)) phase_norm_mod(F, xl, xc, norm_w + l * DM, modl, HX);
        SEAM(pb);
        if (IN(pb + 1)) { pg8::Gemm g{HX, wtin + (size_t)l * NIN * DM, MT, NIN, DM}; pg8::StaticOrder S; S.init(MT, NIN, F.G, (int)blockIdx.x);
            pg8::EpiIn E{P, qn + l * 64, kn + l * 64, tab};
            pg8::gemm_phase<pg8::EpiIn, pg8::StaticOrder, true, true>(F.lds, g, S, E, F.wave); }
        SEAM(pb + 1);
        if (IN(pb + 2)) att::attn_phase(F.vcu, F.G, P, U, rpb + (size_t)l * 8 * 465, sink + l * 8, l == 0, (char*)lds, F.wave);
        SEAM(pb + 2);
        if (IN(pb + 3)) { const int mrows = l == 0 ? MT : ML; pg8::Gemm g{U, wtout + (size_t)l * DM * MIX, mrows, DM, MIX}; pg8::StaticOrder S; S.init(mrows, DM, F.G, (int)blockIdx.x);
            pg8::EpiOut E{modl, xl, xc, out, xctx};
            pg8::gemm_phase<pg8::EpiOut, pg8::StaticOrder, true, true>(F.lds, g, S, E, F.wave); }
        SEAM(pb + 3);
    }
    if (IN(9)) phase_final_norm(F, out, fnw);
#undef IN
#undef SEAM
}

extern "C" void kernel_launch(void* const* d_in, const int* in_sizes, int n_in, void* d_out, int out_size, void* d_ws, size_t ws_size, hipStream_t stream) {
    static int grid = 0;
    if (grid == 0) {
        int dev = 0, cus = 0, per_cu = 0;
        if (n_in != 14 || ws_size < WS_END) { fprintf(stderr, "kernel_launch: unexpected inputs / workspace\n"); grid = -1; return; }
        if (hipGetDevice(&dev) != hipSuccess || hipDeviceGetAttribute(&cus, hipDeviceAttributeMultiprocessorCount, dev) != hipSuccess) { grid = -1; return; }
        if (hipFuncSetAttribute((const void*)fwd_kernel, hipFuncAttributeMaxDynamicSharedMemorySize, LDS_BYTES) != hipSuccess) { fprintf(stderr, "kernel_launch: hipFuncSetAttribute failed\n"); grid = -1; return; }
        if (hipOccupancyMaxActiveBlocksPerMultiprocessor(&per_cu, (const void*)fwd_kernel, NTHREADS, LDS_BYTES) != hipSuccess || per_cu < 1) { fprintf(stderr, "kernel_launch: occupancy query says %d\n", per_cu); }
        (void)hipGetLastError();
        grid = cus;
    }
    if (grid < 0) return;
    (void)hipMemsetAsync((char*)d_ws + WS_CTL, 0, CTL_ZERO_BYTES, stream);
    Args a{};
    for (int i = 0; i < 14; ++i) a.in[i] = (const float*)d_in[i];
    a.out = (float*)d_out; a.ws = (unsigned char*)d_ws;
#if MK_PER_PHASE
    for (int p = 0; p < NPHASES; ++p) { a.ph_lo = p; a.ph_hi = p + 1; hipLaunchKernelGGL(fwd_kernel, dim3(grid), dim3(NTHREADS), LDS_BYTES, stream, a); }
#else
    a.ph_lo = 0; a.ph_hi = NPHASES;
    hipLaunchKernelGGL(fwd_kernel, dim3(grid), dim3(NTHREADS), LDS_BYTES, stream, a);
#endif
}
```

```cpp
#include <hip/hip_runtime.h>
#include <cstdint>
#include <cstdio>

typedef unsigned short bf16_t;
typedef short bf16x8 __attribute__((ext_vector_type(8)));
typedef float f32x4 __attribute__((ext_vector_type(4)));
typedef unsigned u32x4 __attribute__((ext_vector_type(4)));
#define GAS __attribute__((address_space(1)))
#define LAS __attribute__((address_space(3)))

constexpr int DM = 1024, NB = 2, SEQ = 8192, CTX = 256;
constexpr int ML = NB * SEQ;
constexpr int MT = ML + NB * CTX;
constexpr int NIN = 4608, MIX = 1536;
constexpr int C_QA = 0, C_KA = 512, C_VA = 640, C_QB = 768, C_KB = 1280, C_VB = 1792, C_QC = 2304, C_KC = 2816, C_VC = 2944, C_G = 3072;
constexpr float LOG2E = 1.4426950408889634f;
constexpr float QSCALE = 0.125f * LOG2E;
constexpr float EPS = 1e-6f;
constexpr int NWAVES = 8, NTHREADS = 512;
#ifndef MK_PER_PHASE
#define MK_PER_PHASE 0
#endif
#ifndef PROBE_REP
#define PROBE_REP 0
#endif
constexpr int NPHASES = 10;

constexpr size_t MiB = 1u << 20;
constexpr size_t WS_CTL = 0, CTL_ZERO_BYTES = 1 * MiB;
constexpr size_t WS_MOD = 65536;
constexpr size_t WS_TAB = 1 * MiB;
constexpr size_t WS_WTIN = 4 * MiB;
constexpr size_t WS_WTOUT = 22 * MiB;
constexpr size_t WS_XCTX = 28 * MiB;
constexpr size_t WS_HXU = 32 * MiB;
constexpr size_t WS_P = 82 * MiB;
constexpr size_t WS_END = WS_P + (size_t)MT * NIN * 2;
static_assert(WS_END <= 256 * MiB, "ws map");
constexpr int CW_BAR = 4096;
constexpr int RING_BYTES = 131072, LDSCTL_OFF = RING_BYTES, MISC_OFF = LDSCTL_OFF + 320, LDS_BYTES = 147456;

__device__ __forceinline__ unsigned f2bf(float f) { unsigned u = __builtin_bit_cast(unsigned, f); return (u + 0x7fffu + ((u >> 16) & 1u)) >> 16; }
__device__ __forceinline__ float bf2f(unsigned h) { return __builtin_bit_cast(float, h << 16); }
__device__ __forceinline__ unsigned pk2(float lo, float hi) { return f2bf(lo) | (f2bf(hi) << 16); }
__device__ __forceinline__ float silu_f(float v) { return v / (1.f + __expf(-v)); }
__device__ __forceinline__ float wave_sum(float v) {
#pragma unroll
    for (int o = 1; o < 64; o <<= 1) v += __shfl_xor(v, o);
    return v;
}
#define LDS_WAIT() asm volatile("s_waitcnt lgkmcnt(0)" ::: "memory")
__device__ __forceinline__ int lane_id_fresh() { int l; asm volatile("v_mbcnt_lo_u32_b32 %0, -1, 0\n\tv_mbcnt_hi_u32_b32 %0, -1, %0" : "=v"(l)); return l; }

#define XB_TMO      128
#define XB_XCNT(j)  (256  + 64 * (j))
#define XB_XSUB(j)  (1280 + 64 * (j))
#define XB_XGEN(j)  (2304 + 64 * (j))
#define XB_TOP      3328
#define XB_TOPGEN   3392
#define XCD_BAR_WORDS 3456
#define XB_SPIN_CAP (1u << 18)
__device__ __forceinline__ unsigned xb_ld(unsigned* p)              { return __hip_atomic_load(p, __ATOMIC_RELAXED, __HIP_MEMORY_SCOPE_AGENT); }
__device__ __forceinline__ unsigned xb_add(unsigned* p, unsigned v) { return __hip_atomic_fetch_add(p, v, __ATOMIC_RELAXED, __HIP_MEMORY_SCOPE_AGENT); }
__device__ __forceinline__ unsigned xb_xcc_id() { return (unsigned)__builtin_amdgcn_s_getreg((3 << 11) | 20) & 0xFu; }
#define XB_SPIN(cond, bar) do { unsigned _sp = 0; while (cond) { __builtin_amdgcn_s_sleep(1); \
    if ((++_sp & 255u) == 0u) { if (xb_ld(&(bar)[XB_TMO])) break; if (_sp > XB_SPIN_CAP) { atomicAdd(&(bar)[XB_TMO], 1u); break; } } } } while (0)
struct XcdBarrier { unsigned* bar; unsigned x; volatile LAS unsigned* st; };
__device__ __forceinline__ XcdBarrier xcd_barrier_post(unsigned* bar, volatile LAS unsigned* st) {
    XcdBarrier b; b.bar = bar; b.x = xb_xcc_id(); b.st = st;
    if (threadIdx.x == 0) (void)xb_add(&bar[XB_XCNT(b.x)], 1u);
    return b;
}
__device__ __forceinline__ void xcd_barrier_complete(unsigned* bar, unsigned x, unsigned& nloc, unsigned& nx) {
    const unsigned G = gridDim.x * gridDim.y * gridDim.z;
    unsigned sum, cnt, mine, sp = 0u;
    for (;;) {
        sum = 0u; cnt = 0u; mine = 0u;
#pragma unroll
        for (unsigned j = 0; j < 16; ++j) { const unsigned c = xb_ld(&bar[XB_XCNT(j)]); sum += c; cnt += (c > 0u) ? 1u : 0u; mine = (j == x) ? c : mine; }
        if (sum == G) break;
        __builtin_amdgcn_s_sleep(1);
        if ((++sp & 255u) == 0u) { if (xb_ld(&bar[XB_TMO])) break; if (sp > XB_SPIN_CAP) { atomicAdd(&bar[XB_TMO], 1u); break; } }
    }
    nloc = mine > 0u ? mine : 1u; nx = cnt > 0u ? cnt : 1u;
}
__device__ __forceinline__ void xcd_barrier(const XcdBarrier& b, const int wave) {
    asm volatile("s_waitcnt vmcnt(0)" ::: "memory");
    __syncthreads();
    if (wave == 0 && lane_id_fresh() == 0) {
        unsigned* bar = b.bar; asm volatile("" : "+s"(bar));
        __builtin_amdgcn_s_waitcnt(0);
        unsigned nloc = b.st[0], nx = b.st[1];
        if (nloc == 0u) { xcd_barrier_complete(bar, b.x, nloc, nx); b.st[0] = nloc; b.st[1] = nx; }
        const unsigned old = xb_add(&bar[XB_XSUB(b.x)], 1u);
        const unsigned gen = old / nloc;
        if (old + 1u == (gen + 1u) * nloc) {
            __builtin_amdgcn_fence(__ATOMIC_RELEASE, "agent");
            asm volatile("s_waitcnt vmcnt(0)" ::: "memory");
            const unsigned og = xb_add(&bar[XB_TOP], 1u);
            const unsigned tg = og / nx;
            if (og + 1u == (tg + 1u) * nx) xb_add(&bar[XB_TOPGEN], 1u);
            else XB_SPIN(xb_ld(&bar[XB_TOPGEN]) == tg, bar);
            __builtin_amdgcn_fence(__ATOMIC_ACQUIRE, "agent");
            xb_add(&bar[XB_XGEN(b.x)], 1u);
            asm volatile("s_waitcnt vmcnt(0)" ::: "memory");
        } else {
            XB_SPIN(xb_ld(&bar[XB_XGEN(b.x)]) == gen, bar);
            __builtin_amdgcn_fence(__ATOMIC_ACQUIRE, "agent");
            asm volatile("s_waitcnt vmcnt(0)" ::: "memory");
        }
    }
    __syncthreads();
}

namespace pg8 {
#define PG8_LAS __attribute__((address_space(3)))
typedef unsigned short bf16_t;
typedef short bf16x8 __attribute__((ext_vector_type(8)));
typedef float f32x4 __attribute__((ext_vector_type(4)));
typedef unsigned u32x4 __attribute__((ext_vector_type(4)));
constexpr int BM = 256, BK = 64, HALF = 128, HTB = HALF * BK * 2  , STAGE_BYTES = 8 * HTB, NXCD = 8, WGM = 8;

__host__ __device__ __forceinline__ int lds_byte(int r, int c) { const int st = (r >> 4) * 2 + (c >> 5), rr = r & 15, cc = c & 31, ob = rr * 64 + cc * 2; return st * 1024 + (ob ^ (((ob >> 9) & 1) << 5)); }
__host__ __device__ __forceinline__ void stage_rc(int b, int& R, int& C) { const int st = b / 1024, sb = b % 1024, swz = sb ^ (((sb >> 9) & 1) << 5); R = (st >> 1) * 16 + swz / 64; C = (st & 1) * 32 + (swz % 64) / 2; }
__host__ __device__ __forceinline__ int perm32(int rho) { const int n = rho >> 4, i = rho & 15; return 8 * (i >> 2) + 4 * n + (i & 3); }

struct Unit { int pm, pn; };
struct Gemm { const bf16_t* A; const bf16_t* Bt; int M, N, K; };

struct StaticOrder {
    int nM, nN, nwg, G, c;
    __host__ __device__ void init(int M, int N, int G_, int c_) { nM = M / BM; nN = N / BM; nwg = nM * nN; G = G_; c = c_; }
    __host__ __device__ bool next(int i, Unit& u) const {
        const long L = (long)i * G + c; if (L >= nwg) return false;
        int wgid = (int)L; { const int q = nwg / NXCD, r = nwg % NXCD, xcd = wgid % NXCD, off = wgid / NXCD; wgid = (xcd < r ? xcd * (q + 1) : r * (q + 1) + (xcd - r) * q) + off; }
        const int nig = WGM * nN, gid = wgid / nig, fm = gid * WGM, gsz = (nM - fm) < WGM ? (nM - fm) : WGM;
        u.pm = fm + ((wgid % nig) % gsz); u.pn = (wgid % nig) / gsz; return true;
    }
    __device__ __forceinline__ void a_ready(const Unit&) const {}
    __device__ __forceinline__ void done(const Unit&) const {}
};
__device__ __forceinline__ unsigned cvt_pk_bf16(float lo, float hi) { unsigned r; asm volatile("v_cvt_pk_bf16_f32 %0, %1, %2" : "=v"(r) : "v"(lo), "v"(hi)); return r; }
typedef float f32x2 __attribute__((ext_vector_type(2)));
struct EpiIn {
    static constexpr bool PERM = true, AFTER_DRAIN = false;
    bf16_t* P; const float* qn; const float* kn; const float* tab;
    __device__ __forceinline__ void operator()(const f32x4 (&acc)[2][2][4][2], const Unit& u, int wr, int wc, int fr, int fq) const {
        const int col0 = u.pn * BM + wc * 64;
        int kind;
        if (col0 < 512) kind = 1; else if (col0 < 640) kind = 2; else if (col0 < 768) kind = 0; else if (col0 < 1280) kind = 3; else if (col0 < 2304) kind = 0;
        else if (col0 < 2816) kind = 4; else if (col0 < 2944) kind = 5; else if (col0 < 3072) kind = 0; else kind = 6;
        kind = __builtin_amdgcn_readfirstlane(kind);
        const bool latent = u.pm < 64;
        const bool do_norm = kind == 1 || kind == 2, do_rope = (kind == 1 || kind == 2 || kind == 4 || kind == 5) && latent, do_scale = kind == 1 || kind == 3 || kind == 4;
        f32x4 wlo[2], whi[2];
        if (do_norm) { const float* w = kind == 1 ? qn : kn;
#pragma unroll
            for (int n = 0; n < 2; ++n) { wlo[n] = *(const f32x4*)(w + 8 * fq + 4 * n); whi[n] = *(const f32x4*)(w + 32 + 8 * fq + 4 * n); } }
#pragma unroll
        for (int ai = 0; ai < 2; ++ai)
#pragma unroll
            for (int m = 0; m < 4; ++m) {
                const int row = u.pm * BM + ai * HALF + wr * 64 + m * 16 + fr;
                f32x4 lo[2], hi[2];
#pragma unroll
                for (int n = 0; n < 2; ++n) { lo[n] = acc[ai][0][m][n]; hi[n] = acc[ai][1][m][n]; }
                if (do_norm) {
                    float ss = 0.f;
#pragma unroll
                    for (int n = 0; n < 2; ++n)
#pragma unroll
                        for (int j = 0; j < 4; ++j) ss += lo[n][j] * lo[n][j] + hi[n][j] * hi[n][j];
                    ss += __shfl_xor(ss, 16); ss += __shfl_xor(ss, 32);
                    const float rstd = rsqrtf(ss * (1.f / 64.f) + 1e-6f);
#pragma unroll
                    for (int n = 0; n < 2; ++n) { lo[n] = lo[n] * rstd * wlo[n]; hi[n] = hi[n] * rstd * whi[n]; }
                }
                if (do_rope) {
                    const int pr = (4 * u.pm + 2 * ai + wr) & 127, pc = 16 * m + fr;
                    const int pos = fq < 2 ? pr : pc;
                    const float* tp = tab + (pos * 16 + 8 * (fq & 1)) * 2;
#pragma unroll
                    for (int n = 0; n < 2; ++n) {
                        const f32x4 t0 = *(const f32x4*)(tp + 8 * n), t1 = *(const f32x4*)(tp + 8 * n + 4);
                        const float cs[4] = {t0[0], t0[2], t1[0], t1[2]}, sn[4] = {t0[1], t0[3], t1[1], t1[3]};
#pragma unroll
                        for (int j = 0; j < 4; ++j) { const float a = lo[n][j], b = hi[n][j]; lo[n][j] = a * cs[j] - b * sn[j]; hi[n][j] = a * sn[j] + b * cs[j]; }
                    }
                }
                if (do_scale) {
#pragma unroll
                    for (int n = 0; n < 2; ++n) { lo[n] = lo[n] * (0.125f * 1.4426950408889634f); hi[n] = hi[n] * (0.125f * 1.4426950408889634f); }
                }
                if (kind == 6) {
#pragma unroll
                    for (int n = 0; n < 2; ++n)
#pragma unroll
                        for (int j = 0; j < 4; ++j) { lo[n][j] = lo[n][j] / (1.f + __expf(-lo[n][j])); hi[n][j] = hi[n][j] / (1.f + __expf(-hi[n][j])); }
                }
                bf16_t* rowp = P + (size_t)row * 4608 + col0 + 8 * fq;
                u32x4 w0, w1;
                w0.x = cvt_pk_bf16(lo[0][0], lo[0][1]); w0.y = cvt_pk_bf16(lo[0][2], lo[0][3]); w0.z = cvt_pk_bf16(lo[1][0], lo[1][1]); w0.w = cvt_pk_bf16(lo[1][2], lo[1][3]);
                w1.x = cvt_pk_bf16(hi[0][0], hi[0][1]); w1.y = cvt_pk_bf16(hi[0][2], hi[0][3]); w1.z = cvt_pk_bf16(hi[1][0], hi[1][1]); w1.w = cvt_pk_bf16(hi[1][2], hi[1][3]);
                *(u32x4*)rowp = w0; *(u32x4*)(rowp + 32) = w1;
            }
    }
};
struct EpiOut {
    static constexpr bool PERM = false, AFTER_DRAIN = false;
    const float* mod; const float* xlat_in; const float* xctx_in; float* xlat_out; float* xctx_out;
    __device__ __forceinline__ void operator()(const f32x4 (&acc)[2][2][4][2], const Unit& u, int wr, int wc, int fr, int fq) const {
        const bool latent = u.pm < 64;
        const int v = latent ? (u.pm >> 5) : 2;
        const float* gate = mod + (size_t)v * 3072 + 2048;
        const float* xin = latent ? xlat_in : xctx_in - (size_t)16384 * 1024;
        float* xout = latent ? xlat_out : xctx_out - (size_t)16384 * 1024;
        const int col0 = u.pn * BM + wc * 32 + 4 * fq;
        f32x4 g[2][2];
#pragma unroll
        for (int bj = 0; bj < 2; ++bj)
#pragma unroll
            for (int n = 0; n < 2; ++n) g[bj][n] = *(const f32x4*)(gate + col0 + bj * HALF + n * 16);
#pragma unroll
        for (int ai = 0; ai < 2; ++ai)
#pragma unroll
            for (int m = 0; m < 4; ++m) { const size_t off = (size_t)(u.pm * BM + ai * HALF + wr * 64 + m * 16 + fr) * 1024 + col0;
#pragma unroll
                for (int bj = 0; bj < 2; ++bj)
#pragma unroll
                    for (int n = 0; n < 2; ++n) { const f32x4 xo = *(const f32x4*)(xin + off + bj * HALF + n * 16); *(f32x4*)(xout + off + bj * HALF + n * 16) = xo + g[bj][n] * acc[ai][bj][m][n]; }
            }
    }
};
template <class Epi, class Sched, bool ALIGN_EPI = false, bool SP2 = false>
__device__ __forceinline__ void gemm_phase(PG8_LAS unsigned char* lds, const Gemm g, const Sched& S, const Epi& E, const int wid  ) {
    int lane; asm volatile("v_mbcnt_lo_u32_b32 %0, -1, 0\n\tv_mbcnt_hi_u32_b32 %0, -1, %0" : "=v"(lane));
    const int tid = wid * 64 + lane, wr = wid >> 2, wc = wid & 3, fr = lane & 15, fq = lane >> 4;
    const int K = g.K, nt = K / BK;
    unsigned voffA[2], voffB[2];
#pragma unroll
    for (int i = 0; i < 2; ++i) { int R, C; stage_rc(tid * 16 + i * 8192, R, C); const int Rb = Epi::PERM ? ((R & ~31) + perm32(R & 31)) : R;
        voffA[i] = (unsigned)(R * K + C) * 2u; voffB[i] = (unsigned)(Rb * K + C) * 2u; }
    const size_t kstep = (size_t)(BK * 2);
    const size_t hstep = (size_t)HALF * K * 2;
    const size_t tstep = 2 * hstep;
    const unsigned ldsw = (unsigned)wid * 1024u;
    const int aoff = lds_byte(wr * 64 + fr, fq * 8), boff = lds_byte(wc * 32 + fr, fq * 8);
#define PG8_SA(b, h) (((b) * 2 + (h)) * HTB)
#define PG8_SB(b, h) ((4 + (b) * 2 + (h)) * HTB)
#define PG8_STAGE(bufoff, gbase, voff) do { _Pragma("unroll") for (int _i = 0; _i < 2; ++_i) \
        __builtin_amdgcn_global_load_lds((const unsigned*)((const char*)(gbase) + (voff)[_i]), (PG8_LAS unsigned*)(lds + (bufoff) + ldsw + _i * 8192), 16, 0, 0); } while (0)
#define PG8_LDA(dst, b, h) do { _Pragma("unroll") for (int m = 0; m < 4; ++m) _Pragma("unroll") for (int k = 0; k < 2; ++k) dst[m][k] = *(const PG8_LAS bf16x8*)(lds + PG8_SA(b, h) + aoff + m * 2048 + k * 1024); } while (0)
#define PG8_LDB(dst, b, h) do { _Pragma("unroll") for (int n = 0; n < 2; ++n) _Pragma("unroll") for (int k = 0; k < 2; ++k) dst[n][k] = *(const PG8_LAS bf16x8*)(lds + PG8_SB(b, h) + boff + n * 2048 + k * 1024); } while (0)
#define PG8_MMA(ai, bj, At, Bt) do { __builtin_amdgcn_s_setprio(1); _Pragma("unroll") for (int m = 0; m < 4; ++m) _Pragma("unroll") for (int n = 0; n < 2; ++n) _Pragma("unroll") for (int k = 0; k < 2; ++k) \
        acc[ai][bj][m][n] = __builtin_amdgcn_mfma_f32_16x16x32_bf16(Bt[n][k], At[m][k], acc[ai][bj][m][n], 0, 0, 0); __builtin_amdgcn_s_setprio(0); } while (0)
#define PG8_WAIT_V(n) asm volatile("s_waitcnt vmcnt(" #n ")" ::: "memory")
#define PG8_WAIT_L(n) asm volatile("s_waitcnt lgkmcnt(" #n ")" ::: "memory")
#define PG8_BAR __builtin_amdgcn_s_barrier()
#define PG8_SCHED __builtin_amdgcn_sched_barrier(0)
    Unit cur, nxt; int ui = 0;
    if (!S.next(0, cur)) return;
    f32x4 acc[2][2][4][2];
#pragma unroll
    for (int a = 0; a < 2; ++a)
#pragma unroll
        for (int b = 0; b < 2; ++b)
#pragma unroll
            for (int m = 0; m < 4; ++m)
#pragma unroll
                for (int n = 0; n < 2; ++n) acc[a][b][m][n] = (f32x4){0.f, 0.f, 0.f, 0.f};
    bf16x8 At[4][2], B0[2][2], B1[2][2];
    const char* cA = (const char*)g.A + (size_t)cur.pm * tstep; const char* cB = (const char*)g.Bt + (size_t)cur.pn * tstep;
    S.a_ready(cur);
    if constexpr (SP2) {
        PG8_STAGE(PG8_SB(0, 0), cB, voffB); PG8_STAGE(PG8_SB(0, 1), cB + hstep, voffB); PG8_STAGE(PG8_SA(0, 0), cA, voffA); PG8_STAGE(PG8_SA(0, 1), cA + hstep, voffA);
        if (wr == 1) PG8_BAR;
        PG8_WAIT_V(2); PG8_BAR;
        PG8_STAGE(PG8_SB(1, 0), cB + kstep, voffB); PG8_STAGE(PG8_SA(1, 0), cA + kstep, voffA); PG8_STAGE(PG8_SB(1, 1), cB + hstep + kstep, voffB);
        PG8_WAIT_V(6); PG8_BAR;
    } else {
        PG8_STAGE(PG8_SB(0, 0), cB, voffB); PG8_STAGE(PG8_SA(0, 0), cA, voffA); PG8_STAGE(PG8_SB(0, 1), cB + hstep, voffB); PG8_STAGE(PG8_SA(0, 1), cA + hstep, voffA);
        if (wr == 1) PG8_BAR;
        PG8_WAIT_V(4); PG8_BAR;
        PG8_STAGE(PG8_SB(1, 0), cB + kstep, voffB); PG8_STAGE(PG8_SA(1, 0), cA + kstep, voffA); PG8_STAGE(PG8_SB(1, 1), cB + hstep + kstep, voffB);
        PG8_WAIT_V(6); PG8_BAR;
    }
    for (;;) {
        const bool has_next = S.next(ui + 1, nxt);
        const char* nA = has_next ? (const char*)g.A + (size_t)nxt.pm * tstep : cA; const char* nB = has_next ? (const char*)g.Bt + (size_t)nxt.pn * tstep : cB;
        for (int t = 0; t < nt; t += 2) {
            const bool last = (t == nt - 2);
            const char* a1 = cA + (size_t)(t + 1) * kstep;
            const char* a2 = last ? nA : cA + (size_t)(t + 2) * kstep; const char* b2 = last ? nB : cB + (size_t)(t + 2) * kstep;
            const char* a3 = a2 + kstep; const char* b3 = b2 + kstep;
            if (last && has_next) S.a_ready(nxt);
            if constexpr (SP2) {
            PG8_LDB(B0, 0, 0); PG8_LDB(B1, 0, 1); PG8_SCHED; PG8_LDA(At, 0, 0); PG8_STAGE(PG8_SA(1, 1), a1 + hstep, voffA);
            PG8_WAIT_V(8); PG8_WAIT_L(0); PG8_BAR; PG8_MMA(0, 0, At, B0); PG8_MMA(0, 1, At, B1); PG8_BAR; PG8_SCHED;
            PG8_LDA(At, 0, 1); PG8_STAGE(PG8_SB(0, 0), b2, voffB); PG8_STAGE(PG8_SB(0, 1), b2 + hstep, voffB); PG8_STAGE(PG8_SA(0, 0), a2, voffA);
            PG8_WAIT_V(8); PG8_WAIT_L(0); PG8_BAR; PG8_MMA(1, 0, At, B0); PG8_MMA(1, 1, At, B1); PG8_BAR; PG8_SCHED;
            PG8_LDB(B0, 1, 0); PG8_LDB(B1, 1, 1); PG8_SCHED; PG8_LDA(At, 1, 0); PG8_STAGE(PG8_SA(0, 1), a2 + hstep, voffA);
            PG8_WAIT_V(8); PG8_WAIT_L(0); PG8_BAR; PG8_MMA(0, 0, At, B0); PG8_MMA(0, 1, At, B1); PG8_BAR; PG8_SCHED;
            PG8_LDA(At, 1, 1); PG8_STAGE(PG8_SB(1, 0), b3, voffB); PG8_STAGE(PG8_SB(1, 1), b3 + hstep, voffB); PG8_STAGE(PG8_SA(1, 0), a3, voffA);
            PG8_WAIT_V(8); PG8_WAIT_L(0); PG8_BAR; PG8_MMA(1, 0, At, B0); PG8_MMA(1, 1, At, B1); PG8_BAR; PG8_SCHED;
            } else {
            PG8_LDB(B0, 0, 0); PG8_SCHED; PG8_LDA(At, 0, 0); PG8_STAGE(PG8_SA(1, 1), a1 + hstep, voffA);
            PG8_WAIT_L(8); PG8_BAR; PG8_WAIT_L(0); PG8_MMA(0, 0, At, B0); PG8_BAR; PG8_SCHED;
            PG8_LDB(B1, 0, 1); PG8_STAGE(PG8_SB(0, 0), b2, voffB);
            PG8_BAR; PG8_WAIT_L(0); PG8_MMA(0, 1, At, B1); PG8_BAR;
            PG8_LDA(At, 0, 1); PG8_STAGE(PG8_SA(0, 0), a2, voffA);
            PG8_BAR; PG8_WAIT_L(0); PG8_MMA(1, 0, At, B0); PG8_BAR; PG8_SCHED;
            PG8_STAGE(PG8_SB(0, 1), b2 + hstep, voffB);
            PG8_WAIT_V(6); PG8_BAR; PG8_MMA(1, 1, At, B1); PG8_BAR;
            PG8_LDB(B0, 1, 0); PG8_SCHED; PG8_LDA(At, 1, 0); PG8_STAGE(PG8_SA(0, 1), a2 + hstep, voffA);
            PG8_WAIT_L(8); PG8_BAR; PG8_WAIT_L(0); PG8_MMA(0, 0, At, B0); PG8_BAR; PG8_SCHED;
            PG8_LDB(B1, 1, 1); PG8_STAGE(PG8_SB(1, 0), b3, voffB);
            PG8_BAR; PG8_WAIT_L(0); PG8_MMA(0, 1, At, B1); PG8_BAR;
            PG8_LDA(At, 1, 1); PG8_STAGE(PG8_SA(1, 0), a3, voffA);
            PG8_BAR; PG8_WAIT_L(0); PG8_MMA(1, 0, At, B0); PG8_BAR; PG8_SCHED;
            PG8_STAGE(PG8_SB(1, 1), b3 + hstep, voffB);
            PG8_WAIT_V(6); PG8_BAR; PG8_MMA(1, 1, At, B1); PG8_BAR;
            }
        }
        if constexpr (ALIGN_EPI) { if (wr == 0) PG8_BAR; }
        if constexpr (!Epi::AFTER_DRAIN) { E(acc, cur, wr, wc, fr, fq); S.done(cur); }
        if (!has_next) break;
#pragma unroll
        for (int a = 0; a < 2; ++a)
#pragma unroll
            for (int b = 0; b < 2; ++b)
#pragma unroll
                for (int m = 0; m < 4; ++m)
#pragma unroll
                    for (int n = 0; n < 2; ++n) acc[a][b][m][n] = (f32x4){0.f, 0.f, 0.f, 0.f};
        cur = nxt; cA = nA; cB = nB; ++ui;
        if constexpr (ALIGN_EPI) { if (wr == 1) PG8_BAR; }
    }
    PG8_WAIT_V(0);
    if constexpr (!ALIGN_EPI) { if (wr == 0) PG8_BAR; }
    PG8_BAR;
    if constexpr (Epi::AFTER_DRAIN) { E.fused(acc, cur, wr, wc, fr, fq, lds, wid, lane); S.done(cur); }
#undef PG8_SA
#undef PG8_SB
#undef PG8_STAGE
#undef PG8_LDA
#undef PG8_LDB
#undef PG8_MMA
#undef PG8_WAIT_V
#undef PG8_WAIT_L
#undef PG8_BAR
#undef PG8_SCHED
}
}

struct Ctx {
    LAS unsigned char* lds; int tid, lane, wave, vcu, G;
};
__device__ __forceinline__ Ctx fresh(const Ctx& F0) { Ctx F = F0; const int l = lane_id_fresh(); F.lane = l; F.tid = F0.wave * 64 + l; return F; }

template <bool PERMUTE>
__device__ __forceinline__ void p0_transpose_item(const float* W, int K, int N, bf16_t* WT, LAS float* scr, int item, int lane) {
    const int nblk = N / 32, kb = item / nblk, nb = item % nblk, k0 = 64 * kb, n0 = 32 * nb;
    const int r0 = PERMUTE ? ((n0 & ~255) + 128 * ((n0 >> 5) & 1) + 32 * ((n0 >> 6) & 3)) : n0;
#pragma unroll 8
    for (int i = 0; i < 32; ++i) { const int kk = 2 * i + (lane >> 5); scr[kk * 33 + (lane & 31)] = W[(size_t)(k0 + kk) * N + n0 + (lane & 31)]; }
    LDS_WAIT(); asm volatile("" ::: "memory");
    const int c = lane & 7;
#pragma unroll
    for (int j = 0; j < 4; ++j) { const int n = (lane >> 3) + 8 * j; const LAS float* s = scr + (8 * c) * 33 + n;
        u32x4 o; o.x = pk2(s[0 * 33], s[1 * 33]); o.y = pk2(s[2 * 33], s[3 * 33]); o.z = pk2(s[4 * 33], s[5 * 33]); o.w = pk2(s[6 * 33], s[7 * 33]);
        *(u32x4*)(WT + (size_t)(r0 + n) * K + k0 + 8 * c) = o; }
    LDS_WAIT(); asm volatile("" ::: "memory");
}

__device__ __forceinline__ void phase_prologue(const Ctx& F0, const float* w_in, const float* w_out, const float* c, const float* c_ctx, const float* ada_w, const float* ada_b,
                                               bf16_t* wtin, bf16_t* wtout, float* tab, float* mod) {
    const Ctx F = fresh(F0);
    LAS float* scr = (LAS float*)(F.lds + F.wave * 16384);
    const int gw = F.vcu * NWAVES + F.wave, NGW = F.G * NWAVES;
    constexpr int I_IN = (DM / 64) * (NIN / 32), I_OUT = (MIX / 64) * (DM / 32), NITEMS = 2 * (I_IN + I_OUT);
    for (int it = gw; it < NITEMS; it += NGW) {
        int r = it;
        if (r < I_IN) { p0_transpose_item<true>(w_in, DM, NIN, wtin, scr, r, F.lane); continue; } r -= I_IN;
        if (r < I_IN) { p0_transpose_item<true>(w_in + (size_t)DM * NIN, DM, NIN, wtin + (size_t)NIN * DM, scr, r, F.lane); continue; } r -= I_IN;
        if (r < I_OUT) { p0_transpose_item<false>(w_out, MIX, DM, wtout, scr, r, F.lane); continue; } r -= I_OUT;
        p0_transpose_item<false>(w_out + (size_t)MIX * DM, MIX, DM, wtout + (size_t)DM * MIX, scr, r, F.lane);
    }
    { const int idx = F.vcu * NTHREADS + F.tid;
      if (idx < 128 * 16) { const int pos = idx >> 4, i = idx & 15; const float freq = powf(10000.f, -(float)i / 16.f); const float ang = (float)pos * freq; tab[idx * 2] = cosf(ang); tab[idx * 2 + 1] = sinf(ang); } }
    { const int wk = F.vcu * 2 + (F.tid >> 8), NWK = F.G * 2, t = F.tid & 255;
      for (int it = wk; it < 2 * 16 * 12; it += NWK) {
          const int nb = it % 12, kc = (it / 12) % 16, l = it / 192; const int n = nb * 256 + t;
          float a0 = 0.f, a1 = 0.f, a2 = 0.f;
          const float* w = ada_w + ((size_t)l * DM + kc * 64) * 3072 + n;
#pragma unroll 8
          for (int k = 0; k < 64; ++k) { const float wv = w[(size_t)k * 3072]; const int kk = kc * 64 + k;
              a0 += silu_f(c[kk]) * wv; a1 += silu_f(c[DM + kk]) * wv; a2 += silu_f(c_ctx[kk]) * wv; }
          if (kc == 0) { const float bb = ada_b[l * 3072 + n]; a0 += bb; a1 += bb; a2 += bb; }
          float* p = mod + (size_t)l * 3 * 3072 + n;
          atomicAdd(p, a0); atomicAdd(p + 3072, a1); atomicAdd(p + 2 * 3072, a2);
      } }
}

__device__ __forceinline__ void phase_norm_mod(const Ctx& F0, const float* xlat, const float* xctx, const float* nw, const float* mod, bf16_t* HX) {
    const Ctx F = fresh(F0);
    const int gw = F.vcu * NWAVES + F.wave, NGW = F.G * NWAVES, lane = F.lane;
    for (int row = gw; row < MT; row += NGW) {
        const int v = row < ML ? row / SEQ : 2;
        const float* xr = row < ML ? xlat + (size_t)row * DM : xctx + (size_t)(row - ML) * DM;
        f32x4 xv[4]; float ss = 0.f;
#pragma unroll
        for (int j = 0; j < 4; ++j) { xv[j] = *(const f32x4*)(xr + 256 * j + 4 * lane); ss += xv[j][0] * xv[j][0] + xv[j][1] * xv[j][1] + xv[j][2] * xv[j][2] + xv[j][3] * xv[j][3]; }
        const float rstd = rsqrtf(wave_sum(ss) * (1.f / DM) + EPS);
        const float* shift = mod + (size_t)v * 3072; const float* scale = shift + 1024;
#pragma unroll
        for (int j = 0; j < 4; ++j) {
            const int k = 256 * j + 4 * lane;
            const f32x4 w = *(const f32x4*)(nw + k), sc = *(const f32x4*)(scale + k), sh = *(const f32x4*)(shift + k);
            float y[4];
#pragma unroll
            for (int e = 0; e < 4; ++e) y[e] = xv[j][e] * rstd * w[e] * (1.f + sc[e]) + sh[e];
            uint2 o; o.x = pk2(y[0], y[1]); o.y = pk2(y[2], y[3]);
            *(uint2*)(HX + (size_t)row * DM + k) = o;
        }
    }
}

namespace att {
typedef unsigned short bf16;
using bf16x8=__attribute__((ext_vector_type(8)))short;
using s16x4=__attribute__((ext_vector_type(4)))short;
using f32x16=__attribute__((ext_vector_type(16)))float;
using f32x4=__attribute__((ext_vector_type(4)))float;
using u32x4=__attribute__((ext_vector_type(4)))unsigned;
constexpr int PITCH=4608, UPITCH=1536, GCOL=3072;
constexpr int NW=8,QBLK=32,KVBLK=64;
constexpr int NSLOT=3, SLOTB=8192, OSTR=68  ;
constexpr int LDS_K=0, LDS_V=NSLOT*SLOTB, LDS_WS=2*NSLOT*SLOTB, LDS_OST=LDS_WS+NW*64*4, LDS_BIAS=LDS_OST+NW*32*OSTR*4, LDS_BYTES=LDS_BIAS+2048;
constexpr float L2E=1.4426950408889634f;
struct Unit {
  int type;
  int nt;
  int nlat;
  int ctx0, lat0;
  int first;
  int kcol, vcol;
  int qrow0, tq0;
  int h0, gqa;
};
__device__ __forceinline__ int crow(int r,int hi){return (r&3)+8*(r>>2)+4*hi;}
#define SBAR() __builtin_amdgcn_sched_barrier(0)
__device__ __forceinline__ void glds16(const void*gsrc,unsigned lds_dst){unsigned keep;
  asm volatile("s_mov_b32 %0, m0\n\ts_mov_b32 m0, %2\n\ts_nop 0\n\tglobal_load_lds_dwordx4 %1, off\n\ts_mov_b32 m0, %0":"=&s"(keep):"v"(gsrc),"s"(lds_dst):"memory");}
__device__ __forceinline__ float max3f(float a,float b,float c){float r;asm("v_max3_f32 %0, %1, %2, %3":"=v"(r):"v"(a),"v"(b),"v"(c));return r;}
__device__ __forceinline__ float max2f(float a,float b){float r;asm("v_max_f32_e32 %0, %1, %2":"=v"(r):"v"(a),"v"(b));return r;}
__device__ __forceinline__ float fadd_s(float a,float b){float r;asm("v_add_f32_e32 %0, %1, %2":"=v"(r):"v"(a),"v"(b));return r;}
__device__ __forceinline__ float fsub_s(float a,float b){float r;asm("v_sub_f32_e32 %0, %1, %2":"=v"(r):"v"(a),"v"(b));return r;}
typedef float f32x2_t __attribute__((ext_vector_type(2))); typedef __bf16 bf16x2_t __attribute__((ext_vector_type(2)));
__device__ __forceinline__ unsigned cvtpk_s(float lo,float hi){f32x2_t v={lo,hi};bf16x2_t b=__builtin_convertvector(v,bf16x2_t);return __builtin_bit_cast(unsigned,b);}
#define WAIT_BAR(N) asm volatile("s_waitcnt vmcnt(" #N ") lgkmcnt(0)\n\ts_barrier":::"memory")
__device__ __forceinline__ void qkt(f32x16&p0,f32x16&p1,const char*Kslot,const bf16x8*qr,const f32x16&negm,int r32,int hi){
  const char*kb=Kslot+hi*1024+r32*16;
  #pragma unroll
  for(int d0=0;d0<4;++d0){
    const bf16x8 b0=*reinterpret_cast<const bf16x8*>(kb+d0*2048);
    const bf16x8 b1=*reinterpret_cast<const bf16x8*>(kb+d0*2048+512);
    if(d0==0){p0=__builtin_amdgcn_mfma_f32_32x32x16_bf16(b0,qr[0],negm,0,0,0);p1=__builtin_amdgcn_mfma_f32_32x32x16_bf16(b1,qr[0],negm,0,0,0);}
    else{p0=__builtin_amdgcn_mfma_f32_32x32x16_bf16(b0,qr[d0],p0,0,0,0);p1=__builtin_amdgcn_mfma_f32_32x32x16_bf16(b1,qr[d0],p1,0,0,0);}}
}
typedef __attribute__((address_space(3))) const char* lds_cptr;
typedef short v4i16_t __attribute__((ext_vector_type(4)));
__device__ __forceinline__ void kload8(bf16x8*kf,lds_cptr kp){
  kf[0]=*(const __attribute__((address_space(3))) bf16x8*)(kp);      kf[1]=*(const __attribute__((address_space(3))) bf16x8*)(kp+512);
  kf[2]=*(const __attribute__((address_space(3))) bf16x8*)(kp+2048); kf[3]=*(const __attribute__((address_space(3))) bf16x8*)(kp+2560);
  kf[4]=*(const __attribute__((address_space(3))) bf16x8*)(kp+4096); kf[5]=*(const __attribute__((address_space(3))) bf16x8*)(kp+4608);
  kf[6]=*(const __attribute__((address_space(3))) bf16x8*)(kp+6144); kf[7]=*(const __attribute__((address_space(3))) bf16x8*)(kp+6656);
}
__device__ __forceinline__ void kload2(bf16x8*kf,lds_cptr kp,int j){ kf[2*j]=*(const __attribute__((address_space(3))) bf16x8*)(kp+j*2048); kf[2*j+1]=*(const __attribute__((address_space(3))) bf16x8*)(kp+j*2048+512); }
__device__ __forceinline__ s16x4 vtr(lds_cptr p){ return __builtin_bit_cast(s16x4,__builtin_amdgcn_ds_read_tr16_b64_v4i16((__attribute__((address_space(3))) v4i16_t*)p)); }
__device__ __forceinline__ float rowmax(const f32x16&p0,const f32x16&p1){
  float a=max3f(p0[0],p0[1],p1[0]),b=max3f(p0[2],p0[3],p1[1]);a=max3f(a,p1[2],p1[3]);
  #pragma unroll
  for(int r=4;r<16;r+=4){a=max3f(a,p0[r],p0[r+1]);b=max3f(b,p0[r+2],p0[r+3]);a=max3f(a,p1[r],p1[r+1]);b=max3f(b,p1[r+2],p1[r+3]);}
  const float m=max2f(a,b);
  auto rr=__builtin_amdgcn_permlane32_swap(__float_as_uint(m),__float_as_uint(m),false,false);
  return max2f(__uint_as_float(rr[0]),__uint_as_float(rr[1]));
}
__device__ __forceinline__ void pv(f32x16*o,int vb,bf16x8 pa0,bf16x8 pa1,bf16x8 pa2,bf16x8 pa3){
  #pragma unroll
  for(int d0=0;d0<2;++d0){s16x4 lo[4],hi[4];
    #pragma unroll
    for(int ks=0;ks<4;++ks){
      asm volatile("ds_read_b64_tr_b16 %0,%1 offset:%c2":"=&v"(lo[ks]):"v"(vb),"i"(d0*4096+ks*1024):"memory");
      asm volatile("ds_read_b64_tr_b16 %0,%1 offset:%c2":"=&v"(hi[ks]):"v"(vb),"i"(d0*4096+ks*1024+512):"memory");}
    asm volatile("s_waitcnt lgkmcnt(0)":::"memory");SBAR();
    #define PK(k) (bf16x8){lo[k][0],lo[k][1],lo[k][2],lo[k][3],hi[k][0],hi[k][1],hi[k][2],hi[k][3]}
    o[d0]=__builtin_amdgcn_mfma_f32_32x32x16_bf16(pa0,PK(0),o[d0],0,0,0);
    o[d0]=__builtin_amdgcn_mfma_f32_32x32x16_bf16(pa1,PK(1),o[d0],0,0,0);
    o[d0]=__builtin_amdgcn_mfma_f32_32x32x16_bf16(pa2,PK(2),o[d0],0,0,0);
    o[d0]=__builtin_amdgcn_mfma_f32_32x32x16_bf16(pa3,PK(3),o[d0],0,0,0);
    #undef PK
  }
}
template<int TYPE> __device__ __forceinline__ void amask(f32x16&c0,f32x16&c1,int li,int nlat,int mA,int mB,int u0,int u1,const float*bt){
  const float NEG=-INFINITY;
  bool dead = li>=nlat;
  if(TYPE==1) dead = dead || (unsigned)(li-u0)>=8u;
  if(dead){
    #pragma unroll
    for(int r=0;r<16;++r){c0[r]=NEG;c1[r]=NEG;}
    return; }
  if(TYPE==1){
    const float*row=bt+(li-u1+7)*31;
    #pragma unroll
    for(int r=0;r<16;++r){ const int kk0=(r&3)+8*(r>>2);
      int i0=kk0+mB; i0=i0<0?0:(i0>30?30:i0); int i1=kk0+32+mB; i1=i1<0?0:(i1>30?30:i1);
      const float b0=row[i0], b1=row[i1];
      c0[r]=((unsigned)(kk0+mA)<16u)?c0[r]+b0:NEG; c1[r]=((unsigned)(kk0+32+mA)<16u)?c1[r]+b1:NEG; }
  } else {
    const int base=mA+64*li;
    #pragma unroll
    for(int r=0;r<16;++r){ const int kk0=(r&3)+8*(r>>2);
      if((unsigned)(kk0+base)>256u)c0[r]=NEG; if((unsigned)(kk0+32+base)>256u)c1[r]=NEG; }
  }
}

template<int TYPE,int THRL,bool NOMAX> __device__ __forceinline__ void attn_unit(const Unit&ud,const bf16*__restrict__ P,bf16*__restrict__ U,const float*rpbl,const float*sinkl,char*shm,const int wid){
  int lane; asm volatile("v_mbcnt_lo_u32_b32 %0, -1, 0\n\tv_mbcnt_hi_u32_b32 %0, -1, %0":"=v"(lane));
  const int tid=wid*64+lane,r32=lane&31,hi=lane>>5;
  const int hq=ud.gqa?ud.h0+(wid&3):ud.h0, qoff=ud.gqa?32*(wid>>2):32*wid;
  const int qcol=(TYPE==0?0:TYPE==1?768:2304)+hq*64, ucol=TYPE*512+hq*64;
  const long qrow=ud.qrow0+qoff;
  const bf16*Qw=P+qrow*PITCH+qcol;
  const unsigned lds0=(unsigned)(uintptr_t)shm;
  float*wsf=(float*)(shm+LDS_WS)+wid*64;
  const bf16*ksrc=P+(long)lane*PITCH+ud.kcol+wid*8;
  const bf16*vsrc=P+(long)(16*(wid&3)+(lane>>2))*PITCH+ud.vcol+(wid>>2)*32+(lane&3)*8;
  const unsigned kdst=lds0+LDS_K+wid*1024, vdst=lds0+LDS_V+wid*1024;
  const int NT=ud.nt, nlat=ud.nlat;
  #define TROW(t) ((long)(((t)<4)?(ud.ctx0+64*(t)):(ud.lat0+64*((((t)-4)<nlat)?((t)-4):(nlat-1)))))
  #define DMA_K(t,slot) glds16(ksrc+TROW(t)*PITCH,(unsigned)__builtin_amdgcn_readfirstlane(kdst+(slot)))
  #define DMA_V(t,slot) glds16(vsrc+TROW(t)*PITCH,(unsigned)__builtin_amdgcn_readfirstlane(vdst+(slot)))
  const int vb0=(int)(lds0+LDS_V)+((lane>>4)&1)*32+(lane&3)*8+(4*hi+((lane&15)>>2))*64;
  const char*Kbase=shm+LDS_K; bf16x8 kf[8];
  const lds_cptr shm3=(lds_cptr)shm; const lds_cptr kp0=shm3+LDS_K+hi*1024+r32*16; const lds_cptr vp0=shm3+LDS_V+((lane>>4)&1)*32+(lane&3)*8+(4*hi+((lane&15)>>2))*64;
  int mA=0,mB=0,u0=0,u1=0; const float*bt=(const float*)(shm+LDS_BIAS);
  if(TYPE==1){ const int tqw=ud.tq0+qoff, qg=tqw>>6, qc=(tqw&63)+r32; int rs=qg-4; rs=rs<0?0:(rs>120?120:rs); int cs=qc-8; cs=cs<0?0:(cs>48?48:cs);
    mA=4*hi-cs; mB=4*hi-qc+15; u0=rs-ud.first; u1=qg-ud.first;
    float*btw=(float*)(shm+LDS_BIAS); for(int i=tid;i<465;i+=512)btw[i]=rpbl[hq*465+i]*L2E; }
  if(TYPE==2){ const int tq=ud.tq0+qoff+r32; mA=4*hi-(tq-64*ud.first)+128; }
  DMA_K(0,0);DMA_V(0,0);DMA_K(1,SLOTB);
  bf16x8 qr[4];
  #pragma unroll
  for(int d0=0;d0<4;++d0)qr[d0]=*reinterpret_cast<const bf16x8*>(&Qw[(long)r32*PITCH+d0*16+hi*8]);
  float mhat=0.f,l_reg=0.f;f32x16 o[2];o[0]=f32x16{};o[1]=f32x16{};f32x16 negm=f32x16{};if(!NOMAX)asm volatile("":"+v"(negm));
  #define NEGM (NOMAX?(f32x16){}:negm)
  #define AMASK(P0,P1,t) do{ if(TYPE!=0){ if((t)>=4) amask<TYPE>(P0,P1,(t)-4,nlat,mA,mB,u0,u1,bt); } }while(0)
  bool resc=false;
  #define START(P0,P1) do{ resc=false; if(!NOMAX){ const float rm=rowmax(P0,P1); \
    { const float dl=rm; mhat=fadd_s(mhat,dl); \
      _Pragma("unroll") for(int r=0;r<16;++r){P0[r]=fsub_s(P0[r],dl);P1[r]=fsub_s(P1[r],dl);} \
      _Pragma("unroll") for(int r=0;r<16;++r)negm[r]=-mhat; asm volatile("":"+v"(negm)); } } \
    _Pragma("unroll") for(int r=0;r<16;++r)P0[r]=__builtin_amdgcn_exp2f(P0[r]); }while(0)
  #define RESC() do{ if(!NOMAX&&resc){ asm volatile("s_waitcnt lgkmcnt(0)":::"memory"); \
      _Pragma("unroll") for(int d_=0;d_<2;++d_) _Pragma("unroll") for(int r=0;r<16;++r)o[d_][r]*=wsf[crow(r,hi)]; } }while(0)
  f32x16 pA0,pA1,pB0,pB1;
  int sl_prev=0,sl_cur=0,sl_next=SLOTB;
  #define ROT() do{sl_prev=sl_cur;sl_cur=sl_next;sl_next=(sl_next==(NSLOT-1)*SLOTB)?0:sl_next+SLOTB;}while(0)
  DMA_K(2,2*SLOTB);
  WAIT_BAR(3);
  qkt(pA0,pA1,Kbase,qr,NEGM,r32,hi);asm volatile("s_nop 15\n\ts_nop 7":"+v"(pA0),"+v"(pA1));
  START(pA0,pA1);
  _Pragma("unroll") for(int r=0;r<16;++r)pA1[r]=__builtin_amdgcn_exp2f(pA1[r]);
  WAIT_BAR(0);
  DMA_K(3,0);DMA_V(1,SLOTB);
  ROT();
  kload8(kf,kp0+sl_cur);
  WAIT_BAR(2);
  s16x4 vlo[8],vhi[8]; u32x4 pw0,pw1,pw2,pw3;
  #define PKW(P,B) cvtpk_s(P[B],P[B+1])
  #define PAF(k) __builtin_bit_cast(bf16x8,pw##k)
  #define VFR(i) (bf16x8){vlo[i][0],vlo[i][1],vlo[i][2],vlo[i][3],vhi[i][0],vhi[i][1],vhi[i][2],vhi[i][3]}
  #define PIN(x) asm volatile("":"+v"(x))
  #define MX3(a,b,c) __builtin_fmaxf(__builtin_fmaxf((a),(b)),(c))
  #define GAPA(MF,A0,A1,A2,A3,W0,W1,PW) do{ MF; sacc+=A0; sacc+=A1; sacc+=A2; sacc+=A3; PIN(sacc); W0; W1; PIN(PW); SBAR(); }while(0)
  #define EX(v) __builtin_amdgcn_exp2f(v)
  #define GAPB(MF,X,B) do{ MF; X[B]=EX(X[B]); X[B+1]=EX(X[B+1]); X[B+2]=EX(X[B+2]); X[B+3]=EX(X[B+3]); PIN(X); SBAR(); }while(0)
  #define VRD(i) do{ vlo[i]=vtr(vp_+(((i)>>2)*4096+((i)&3)*1024)); vhi[i]=vtr(vp_+(((i)>>2)*4096+((i)&3)*1024+512)); }while(0)
  #define KRD(G,j) do{ if(G){ kload2(kf,kp0+sl_next,j); SBAR(); } }while(0)
  #define STEP(C0,C1,P0,P1,t,GK,GV,GL) do{ SBAR(); \
    const lds_cptr vp_=vp0+sl_prev; \
    VRD(0); SBAR(); float sacc=(P0[0]+P0[1]); \
    GAPA(C0=__builtin_amdgcn_mfma_f32_32x32x16_bf16(kf[0],qr[0],NEGM,0,0,0), P0[2],P0[3],P0[4],P0[5],     pw0[0]=PKW(P0,0), pw0[1]=PKW(P0,2), pw0); \
    VRD(4); SBAR(); GAPA(C1=__builtin_amdgcn_mfma_f32_32x32x16_bf16(kf[1],qr[0],NEGM,0,0,0), P0[6],P0[7],P0[8],P0[9],     pw0[2]=PKW(P0,4), pw0[3]=PKW(P0,6), pw0); \
    VRD(1); SBAR(); GAPA(C0=__builtin_amdgcn_mfma_f32_32x32x16_bf16(kf[2],qr[1],C0,0,0,0),   P0[10],P0[11],P0[12],P0[13], pw1[0]=PKW(P0,8), pw1[1]=PKW(P0,10), pw1); \
    VRD(5); SBAR(); GAPA(C1=__builtin_amdgcn_mfma_f32_32x32x16_bf16(kf[3],qr[1],C1,0,0,0),   P0[14],P0[15],P1[0],P1[1],   pw1[2]=PKW(P0,12),pw1[3]=PKW(P0,14), pw1); \
    VRD(2); SBAR(); GAPA(C0=__builtin_amdgcn_mfma_f32_32x32x16_bf16(kf[4],qr[2],C0,0,0,0),   P1[2],P1[3],P1[4],P1[5],     pw2[0]=PKW(P1,0), pw2[1]=PKW(P1,2), pw2); \
    VRD(6); SBAR(); GAPA(C1=__builtin_amdgcn_mfma_f32_32x32x16_bf16(kf[5],qr[2],C1,0,0,0),   P1[6],P1[7],P1[8],P1[9],     pw2[2]=PKW(P1,4), pw2[3]=PKW(P1,6), pw2); \
    VRD(3); SBAR(); GAPA(C0=__builtin_amdgcn_mfma_f32_32x32x16_bf16(kf[6],qr[3],C0,0,0,0),   P1[10],P1[11],P1[12],P1[13], pw3[0]=PKW(P1,8), pw3[1]=PKW(P1,10), pw3); \
    VRD(7); SBAR(); GAPA(C1=__builtin_amdgcn_mfma_f32_32x32x16_bf16(kf[7],qr[3],C1,0,0,0),   P1[14],P1[15],0.f,0.f,       pw3[2]=PKW(P1,12),pw3[3]=PKW(P1,14), pw3); \
    l_reg+=sacc; \
    if(GK){DMA_K((t)+3,sl_cur);} if(GV){DMA_V((t)+1,sl_next);} \
    AMASK(C0,C1,t); \
    if(!NOMAX){ float a=MX3(C0[0],C0[1],C1[0]),b=MX3(C0[2],C0[3],C1[1]); a=MX3(a,C1[2],C1[3]); \
      _Pragma("unroll") for(int r=4;r<16;r+=4){a=MX3(a,C0[r],C0[r+1]);b=MX3(b,C0[r+2],C0[r+3]);a=MX3(a,C1[r],C1[r+1]);b=MX3(b,C1[r+2],C1[r+3]);} \
      float rm=__builtin_fmaxf(a,b); { auto rr=__builtin_amdgcn_permlane32_swap(__float_as_uint(rm),__float_as_uint(rm),false,false); rm=__builtin_fmaxf(__uint_as_float(rr[0]),__uint_as_float(rr[1])); } \
      resc=false; \
      if(__builtin_expect(__any(rm>(float)THRL),0)){ const float dl=__builtin_fmaxf(rm,0.f); mhat+=dl; \
        _Pragma("unroll") for(int r=0;r<16;++r){C0[r]-=dl;C1[r]-=dl;} \
        _Pragma("unroll") for(int r=0;r<16;++r)negm[r]=-mhat; asm volatile("":"+v"(negm)); \
        const float f=__builtin_amdgcn_exp2f(-dl); l_reg*=f; if(hi==0)wsf[r32]=f; resc=true; } } \
    SBAR(); \
    GAPB(o[0]=__builtin_amdgcn_mfma_f32_32x32x16_bf16(PAF(0),VFR(0),o[0],0,0,0), C0,0); \
    GAPB(o[1]=__builtin_amdgcn_mfma_f32_32x32x16_bf16(PAF(0),VFR(4),o[1],0,0,0), C0,4); \
    KRD(GL,0); GAPB(o[0]=__builtin_amdgcn_mfma_f32_32x32x16_bf16(PAF(1),VFR(1),o[0],0,0,0), C0,8); \
    KRD(GL,1); GAPB(o[1]=__builtin_amdgcn_mfma_f32_32x32x16_bf16(PAF(1),VFR(5),o[1],0,0,0), C0,12); \
    KRD(GL,2); GAPB(o[0]=__builtin_amdgcn_mfma_f32_32x32x16_bf16(PAF(2),VFR(2),o[0],0,0,0), C1,0); \
    KRD(GL,3); GAPB(o[1]=__builtin_amdgcn_mfma_f32_32x32x16_bf16(PAF(2),VFR(6),o[1],0,0,0), C1,4); \
    GAPB(o[0]=__builtin_amdgcn_mfma_f32_32x32x16_bf16(PAF(3),VFR(3),o[0],0,0,0), C1,8); \
    GAPB(o[1]=__builtin_amdgcn_mfma_f32_32x32x16_bf16(PAF(3),VFR(7),o[1],0,0,0), C1,12); \
    }while(0)
  int t=1;
  if(TYPE==0){
    for(;t+5<NT;t+=2){
      STEP(pB0,pB1,pA0,pA1,t,true,true,true);     WAIT_BAR(2); RESC(); ROT();
      STEP(pA0,pA1,pB0,pB1,t+1,true,true,true);   WAIT_BAR(2); RESC(); ROT();
    }
  }
  #define ENDW(tt) do{ if((tt)+3<NT){WAIT_BAR(2);} else if((tt)+2<NT){WAIT_BAR(1);} else {WAIT_BAR(0);} }while(0)
  for(;t+1<NT;t+=2){
    STEP(pB0,pB1,pA0,pA1,t,(t+3<NT),(t+1<NT),(t+1<NT));       ENDW(t);   RESC(); ROT();
    STEP(pA0,pA1,pB0,pB1,t+1,(t+4<NT),(t+2<NT),(t+2<NT));     ENDW(t+1); RESC(); ROT();
  }
  STEP(pB0,pB1,pA0,pA1,NT-1,false,false,false); RESC();
  { float sacc=pB0[0]+pB0[1]; _Pragma("unroll") for(int r=2;r<16;++r)sacc+=pB0[r]; _Pragma("unroll") for(int r=0;r<16;++r)sacc+=pB1[r]; l_reg+=sacc;
    pw0=(u32x4){PKW(pB0,0),PKW(pB0,2),PKW(pB0,4),PKW(pB0,6)};pw1=(u32x4){PKW(pB0,8),PKW(pB0,10),PKW(pB0,12),PKW(pB0,14)};pw2=(u32x4){PKW(pB1,0),PKW(pB1,2),PKW(pB1,4),PKW(pB1,6)};pw3=(u32x4){PKW(pB1,8),PKW(pB1,10),PKW(pB1,12),PKW(pB1,14)};
    SBAR(); pv(o,vb0+sl_cur,PAF(0),PAF(1),PAF(2),PAF(3)); }
  #undef PKW
  #undef PAF
  #undef VFR
  #undef PIN
  #undef MX3
  #undef GAPA
  #undef GAPB
  #undef EX
  #undef VRD
  #undef KRD
  #undef STEP
  #undef ENDW
  {auto rr=__builtin_amdgcn_permlane32_swap(__float_as_uint(l_reg),__float_as_uint(l_reg),false,false);l_reg=__uint_as_float(rr[0])+__uint_as_float(rr[1]);}
  if(TYPE==2) l_reg+=__builtin_amdgcn_exp2f(sinkl[hq]*L2E-mhat);
  if(hi==0)wsf[32+r32]=l_reg;asm volatile("s_waitcnt lgkmcnt(0)":::"memory");
  float rli[16];
  #pragma unroll
  for(int r=0;r<16;++r)rli[r]=__builtin_amdgcn_rcpf(wsf[32+crow(r,hi)]);
  { float*stg=(float*)(shm+LDS_OST)+wid*(32*OSTR);
    #pragma unroll
    for(int r=0;r<16;++r){const int orow=crow(r,hi);
      #pragma unroll
      for(int d0=0;d0<2;++d0)stg[orow*OSTR+d0*32+r32]=o[d0][r]*rli[r];}
    asm volatile("s_waitcnt lgkmcnt(0)":::"memory");
    #pragma unroll
    for(int i=0;i<4;++i){const int row=i*8+(lane>>3),ch=lane&7;
      const f32x4 a=*(const f32x4*)(stg+row*OSTR+ch*8), b=*(const f32x4*)(stg+row*OSTR+ch*8+4);
      const u32x4 g=*(const u32x4*)(P+(qrow+row)*PITCH+GCOL+ucol+ch*8);
      u32x4 w;
      w.x=cvtpk_s(a[0]*__uint_as_float(g.x<<16),a[1]*__uint_as_float(g.x&0xffff0000u)); w.y=cvtpk_s(a[2]*__uint_as_float(g.y<<16),a[3]*__uint_as_float(g.y&0xffff0000u));
      w.z=cvtpk_s(b[0]*__uint_as_float(g.z<<16),b[1]*__uint_as_float(g.z&0xffff0000u)); w.w=cvtpk_s(b[2]*__uint_as_float(g.w<<16),b[3]*__uint_as_float(g.w&0xffff0000u));
      *(u32x4*)(U+(qrow+row)*UPITCH+ucol+ch*8)=w; } }
  asm volatile("s_waitcnt lgkmcnt(0)\n\ts_barrier":::"memory");
  #undef TROW
  #undef DMA_K
  #undef DMA_V
  #undef AMASK
  #undef START
  #undef NEGM
  #undef RESC
  #undef ROT
}
constexpr int THRL_DEFAULT=8;
__device__ __forceinline__ Unit unit_A(int ua){ Unit u; const int b=ua>>8,h=(ua>>5)&7,qb=ua&31; u.type=0; u.nt=132; u.nlat=128; u.ctx0=16384+256*b; u.lat0=8192*b; u.first=0;
  u.kcol=512+64*(h>>2); u.vcol=640+64*(h>>2); u.qrow0=8192*b+256*qb; u.tq0=256*qb; u.h0=h; u.gqa=0; return u; }
__device__ __forceinline__ Unit unit_B(int ub){ Unit u; const int b=ub>>8,h=(ub>>5)&7,qb=ub&31; u.type=1;
  int f=4*qb-4; f=f<0?0:(f>120?120:f); int l=4*qb+3-4; l=l<0?0:(l>120?120:l); l+=7;
  u.first=f; u.nlat=l-f+1; u.nt=(4+u.nlat+1)&~1; u.ctx0=16384+256*b; u.lat0=8192*b+64*f;
  u.kcol=1280+64*h; u.vcol=1792+64*h; u.qrow0=8192*b+256*qb; u.tq0=256*qb; u.h0=h; u.gqa=0; return u; }
__device__ __forceinline__ Unit unit_C(int uc){ Unit u; const int b=uc>>8,kvh=(uc>>7)&1,qb=uc&127; u.type=2;
  const int f=qb-2<0?0:qb-2, l=qb+2>127?127:qb+2;
  u.first=f; u.nlat=l-f+1; u.nt=(4+u.nlat+1)&~1; u.ctx0=16384+256*b; u.lat0=8192*b+64*f;
  u.kcol=2816+64*kvh; u.vcol=2944+64*kvh; u.qrow0=8192*b+64*qb; u.tq0=64*qb; u.h0=4*kvh; u.gqa=1; return u; }
__device__ __forceinline__ Unit unit_ctx(int ux){ Unit u; const int type=ux>>4,b=(ux>>3)&1,h=ux&7; u.type=type; u.nt=4; u.nlat=0; u.ctx0=16384+256*b; u.lat0=0; u.first=0;
  const int kvh=(type==1)?h:(h>>2); u.kcol=(type==0?512:type==1?1280:2816)+64*kvh; u.vcol=(type==0?640:type==1?1792:2944)+64*kvh;
  u.qrow0=16384+256*b; u.tq0=0; u.h0=h; u.gqa=0; return u; }
__device__ __forceinline__ void run_unit(const Unit&u,const bf16*P,bf16*U,const float*rpbl,const float*sinkl,char*lds,const int wid,const bool nomaxA){
  if(u.type==0){ if(nomaxA) attn_unit<0,THRL_DEFAULT,true>(u,P,U,rpbl,sinkl,lds,wid); else attn_unit<0,THRL_DEFAULT,false>(u,P,U,rpbl,sinkl,lds,wid); }
  else if(u.type==1) attn_unit<1,THRL_DEFAULT,false>(u,P,U,rpbl,sinkl,lds,wid);
  else attn_unit<2,THRL_DEFAULT,false>(u,P,U,rpbl,sinkl,lds,wid);
}
__device__ __forceinline__ void attn_phase(int vcu,int G,const bf16*P,bf16*U,const float*rpbl,const float*sinkl,const float*qnl,const float*knl,bool need_ctx,char*lds,const int wid){
  bool nomaxA; { const int l=lane_id_fresh(); float a=fabsf(qnl[l]),b=fabsf(knl[l]);
    _Pragma("unroll") for(int o=1;o<64;o<<=1){ a=fmaxf(a,__shfl_xor(a,o)); b=fmaxf(b,__shfl_xor(b,o)); }
    nomaxA=__builtin_amdgcn_readfirstlane((int)(11.6f*a*b<80.f))!=0; }
  for(int rep=0;rep<((PROBE_REP&16)?2:1);++rep) for(int ua=2*vcu;ua<512;ua+=2*G){ run_unit(unit_A(ua),P,U,rpbl,sinkl,lds,wid,nomaxA); run_unit(unit_A(ua+1),P,U,rpbl,sinkl,lds,wid,nomaxA); }
  for(int rep=0;rep<((PROBE_REP&32)?2:1);++rep) for(int ub=2*vcu;ub<512;ub+=2*G){ run_unit(unit_B(ub),P,U,rpbl,sinkl,lds,wid,nomaxA); run_unit(unit_B(ub+1),P,U,rpbl,sinkl,lds,wid,nomaxA); }
  for(int rep=0;rep<((PROBE_REP&64)?2:1);++rep) for(int uc=2*vcu;uc<512;uc+=2*G){ run_unit(unit_C(uc),P,U,rpbl,sinkl,lds,wid,nomaxA); run_unit(unit_C(uc+1),P,U,rpbl,sinkl,lds,wid,nomaxA); }
  if(need_ctx) for(int ux=vcu;ux<48;ux+=G) run_unit(unit_ctx(ux),P,U,rpbl,sinkl,lds,wid,nomaxA);
}
#undef SBAR
#undef WAIT_BAR
}

__device__ __forceinline__ void phase_final_norm(const Ctx& F0, float* x, const float* w) {
    const Ctx F = fresh(F0);
    const int gw = F.vcu * NWAVES + F.wave, NGW = F.G * NWAVES, lane = F.lane;
    for (int row = gw; row < ML; row += NGW) {
        float* xr = x + (size_t)row * DM;
        f32x4 xv[4]; float ss = 0.f;
#pragma unroll
        for (int j = 0; j < 4; ++j) { xv[j] = *(const f32x4*)(xr + 256 * j + 4 * lane); ss += xv[j][0] * xv[j][0] + xv[j][1] * xv[j][1] + xv[j][2] * xv[j][2] + xv[j][3] * xv[j][3]; }
        const float rstd = rsqrtf(wave_sum(ss) * (1.f / DM) + EPS);
#pragma unroll
        for (int j = 0; j < 4; ++j) { const f32x4 wv = *(const f32x4*)(w + 256 * j + 4 * lane); f32x4 y = xv[j] * rstd * wv; *(f32x4*)(xr + 256 * j + 4 * lane) = y; }
    }
}

struct Args { const float* in[14]; float* out; unsigned char* ws; int ph_lo, ph_hi; };
__global__ void __launch_bounds__(NTHREADS, 2) fwd_kernel(Args args) {
    extern __shared__ __attribute__((aligned(16))) unsigned char lds[];
    Ctx F;
    F.lds = (LAS unsigned char*)lds;
    F.wave = __builtin_amdgcn_readfirstlane((int)threadIdx.x >> 6); F.lane = lane_id_fresh(); F.tid = F.wave * 64 + F.lane;
    F.G = gridDim.x; { const int bx = blockIdx.x; F.vcu = (F.G % 8 == 0) ? (bx % 8) * (F.G / 8) + bx / 8 : bx; }
    volatile LAS unsigned* MISC = (volatile LAS unsigned*)(F.lds + MISC_OFF);
    for (int u = F.tid; u < (LDS_BYTES - LDSCTL_OFF) / 4; u += NTHREADS) ((LAS unsigned*)(F.lds + LDSCTL_OFF))[u] = 0u;
    __syncthreads();
    unsigned char* ws = args.ws;
    unsigned* ctl = (unsigned*)(ws + WS_CTL);
    XcdBarrier bar; bar.bar = ctl + CW_BAR; bar.x = 0; bar.st = nullptr;
    if (!MK_PER_PHASE) bar = xcd_barrier_post(ctl + CW_BAR, MISC + 8);
    const float* x = args.in[0]; const float* c = args.in[1]; const float* ctxin = args.in[2]; const float* c_ctx = args.in[3];
    const float* norm_w = args.in[4]; const float* ada_w = args.in[5]; const float* ada_b = args.in[6];
    const float* w_in = args.in[7]; const float* w_out = args.in[8]; const float* qn = args.in[9]; const float* kn = args.in[10];
    const float* rpb = args.in[11]; const float* sink = args.in[12]; const float* fnw = args.in[13];
    float* out = args.out;
    float* tab = (float*)(ws + WS_TAB); float* mod = (float*)(ws + WS_MOD);
    bf16_t* wtin = (bf16_t*)(ws + WS_WTIN); bf16_t* wtout = (bf16_t*)(ws + WS_WTOUT); float* xctx = (float*)(ws + WS_XCTX);
    bf16_t* HX = (bf16_t*)(ws + WS_HXU); bf16_t* U = (bf16_t*)(ws + WS_HXU); bf16_t* P = (bf16_t*)(ws + WS_P);
    const int lo = args.ph_lo, hi = args.ph_hi;
#define IN(k) (lo <= (k) && (k) < hi)
#define SEAM(k) do { if (IN(k) && IN((k) + 1)) xcd_barrier(bar, F.wave); } while (0)
    if (IN(0)) { phase_prologue(F, w_in, w_out, c, c_ctx, ada_w, ada_b, wtin, wtout, tab, mod); }
    SEAM(0);
#pragma unroll 1
    for (int l = 0; l < 2; ++l) {
        const float* xl = l == 0 ? x : out; const float* xc = l == 0 ? ctxin : xctx;
        const float* modl = mod + (size_t)l * 3 * 3072;
        const int pb = 1 + 4 * l;
        if (IN(pb)) { phase_norm_mod(F, xl, xc, norm_w + l * DM, modl, HX); if (PROBE_REP & 4) phase_norm_mod(F, xl, xc, norm_w + l * DM, modl, HX); }
        SEAM(pb);
        if (IN(pb + 1)) { pg8::Gemm g{HX, wtin + (size_t)l * NIN * DM, MT, NIN, DM}; pg8::StaticOrder S; S.init(MT, NIN, F.G, (int)blockIdx.x);
            pg8::EpiIn E{P, qn + l * 64, kn + l * 64, tab};
            pg8::gemm_phase<pg8::EpiIn, pg8::StaticOrder, true, true>(F.lds, g, S, E, F.wave);
            if (PROBE_REP & 2) pg8::gemm_phase<pg8::EpiIn, pg8::StaticOrder, true, true>(F.lds, g, S, E, F.wave); }
        SEAM(pb + 1);
        if (IN(pb + 2)) { att::attn_phase(F.vcu, F.G, P, U, rpb + (size_t)l * 8 * 465, sink + l * 8, qn + l * 64, kn + l * 64, l == 0, (char*)lds, F.wave);
            if (PROBE_REP & 1) att::attn_phase(F.vcu, F.G, P, U, rpb + (size_t)l * 8 * 465, sink + l * 8, qn + l * 64, kn + l * 64, l == 0, (char*)lds, F.wave); }
        SEAM(pb + 2);
        if (IN(pb + 3)) { const int mrows = l == 0 ? MT : ML; pg8::Gemm g{U, wtout + (size_t)l * DM * MIX, mrows, DM, MIX}; pg8::StaticOrder S; S.init(mrows, DM, F.G, (int)blockIdx.x);
            pg8::EpiOut E{modl, xl, xc, out, xctx};
            pg8::gemm_phase<pg8::EpiOut, pg8::StaticOrder, true, true>(F.lds, g, S, E, F.wave);
            if ((PROBE_REP & 8) && l == 0) pg8::gemm_phase<pg8::EpiOut, pg8::StaticOrder, true, true>(F.lds, g, S, E, F.wave); }
        SEAM(pb + 3);
    }
    if (IN(9)) phase_final_norm(F, out, fnw);
#undef IN
#undef SEAM
}

extern "C" void kernel_launch(void* const* d_in, const int* in_sizes, int n_in, void* d_out, int out_size, void* d_ws, size_t ws_size, hipStream_t stream) {
    static int grid = 0;
    if (grid == 0) {
        int dev = 0, cus = 0, per_cu = 0;
        if (n_in != 14 || ws_size < WS_END) { fprintf(stderr, "kernel_launch: unexpected inputs / workspace\n"); grid = -1; return; }
        if (hipGetDevice(&dev) != hipSuccess || hipDeviceGetAttribute(&cus, hipDeviceAttributeMultiprocessorCount, dev) != hipSuccess) { grid = -1; return; }
        if (hipFuncSetAttribute((const void*)fwd_kernel, hipFuncAttributeMaxDynamicSharedMemorySize, LDS_BYTES) != hipSuccess) { fprintf(stderr, "kernel_launch: hipFuncSetAttribute failed\n"); grid = -1; return; }
        if (hipOccupancyMaxActiveBlocksPerMultiprocessor(&per_cu, (const void*)fwd_kernel, NTHREADS, LDS_BYTES) != hipSuccess || per_cu < 1) { fprintf(stderr, "kernel_launch: occupancy query says %d\n", per_cu); }
        (void)hipGetLastError();
        grid = cus;
    }
    if (grid < 0) return;
    (void)hipMemsetAsync((char*)d_ws + WS_CTL, 0, CTL_ZERO_BYTES, stream);
    Args a{};
    for (int i = 0; i < 14; ++i) a.in[i] = (const float*)d_in[i];
    a.out = (float*)d_out; a.ws = (unsigned char*)d_ws;
#if MK_PER_PHASE
    for (int p = 0; p < NPHASES; ++p) { a.ph_lo = p; a.ph_hi = p + 1; hipLaunchKernelGGL(fwd_kernel, dim3(grid), dim3(NTHREADS), LDS_BYTES, stream, a); }
#else
    a.ph_lo = 0; a.ph_hi = NPHASES;
    hipLaunchKernelGGL(fwd_kernel, dim3(grid), dim3(NTHREADS), LDS_BYTES, stream, a);
#endif
}
```

```cpp
#include <hip/hip_runtime.h>
#include <cstdint>
#include <cstdio>

typedef unsigned short bf16_t;
typedef short bf16x8 __attribute__((ext_vector_type(8)));
typedef float f32x4 __attribute__((ext_vector_type(4)));
typedef unsigned u32x4 __attribute__((ext_vector_type(4)));
#define GAS __attribute__((address_space(1)))
#define LAS __attribute__((address_space(3)))

constexpr int DM = 1024, NB = 2, SEQ = 8192, CTX = 256;
constexpr int ML = NB * SEQ;
constexpr int MT = ML + NB * CTX;
constexpr int NIN = 4608, MIX = 1536;
constexpr int C_QA = 0, C_KA = 512, C_VA = 640, C_QB = 768, C_KB = 1280, C_VB = 1792, C_QC = 2304, C_KC = 2816, C_VC = 2944, C_G = 3072;
constexpr float LOG2E = 1.4426950408889634f;
constexpr float QSCALE = 0.125f * LOG2E;
constexpr float EPS = 1e-6f;
constexpr int NWAVES = 8, NTHREADS = 512;
#ifndef MK_PER_PHASE
#define MK_PER_PHASE 0
#endif
#ifndef PROBE_REP
#define PROBE_REP 0
#endif
constexpr int NPHASES = 10;

constexpr size_t MiB = 1u << 20;
constexpr size_t WS_CTL = 0, CTL_ZERO_BYTES = 1 * MiB;
constexpr size_t WS_MOD = 65536;
constexpr size_t WS_TAB = 1 * MiB;
constexpr size_t WS_WTIN = 4 * MiB;
constexpr size_t WS_WTOUT = 22 * MiB;
constexpr size_t WS_XCTX = 28 * MiB;
constexpr size_t WS_HXU = 32 * MiB;
constexpr size_t WS_P = 82 * MiB;
constexpr size_t WS_END = WS_P + (size_t)MT * NIN * 2;
static_assert(WS_END <= 256 * MiB, "ws map");
constexpr int CW_BAR = 4096;
constexpr int RING_BYTES = 131072, LDSCTL_OFF = RING_BYTES, MISC_OFF = LDSCTL_OFF + 320, LDS_BYTES = 147456;

__device__ __forceinline__ unsigned f2bf(float f) { unsigned u = __builtin_bit_cast(unsigned, f); return (u + 0x7fffu + ((u >> 16) & 1u)) >> 16; }
__device__ __forceinline__ float bf2f(unsigned h) { return __builtin_bit_cast(float, h << 16); }
__device__ __forceinline__ unsigned pk2(float lo, float hi) { return f2bf(lo) | (f2bf(hi) << 16); }
__device__ __forceinline__ float silu_f(float v) { return v / (1.f + __expf(-v)); }
__device__ __forceinline__ float wave_sum(float v) {
#pragma unroll
    for (int o = 1; o < 64; o <<= 1) v += __shfl_xor(v, o);
    return v;
}
#define LDS_WAIT() asm volatile("s_waitcnt lgkmcnt(0)" ::: "memory")
__device__ __forceinline__ int lane_id_fresh() { int l; asm volatile("v_mbcnt_lo_u32_b32 %0, -1, 0\n\tv_mbcnt_hi_u32_b32 %0, -1, %0" : "=v"(l)); return l; }

#define XB_TMO      128
#define XB_XCNT(j)  (256  + 64 * (j))
#define XB_XSUB(j)  (1280 + 64 * (j))
#define XB_XGEN(j)  (2304 + 64 * (j))
#define XB_TOP      3328
#define XB_TOPGEN   3392
#define XCD_BAR_WORDS 3456
#define XB_SPIN_CAP (1u << 18)
__device__ __forceinline__ unsigned xb_ld(unsigned* p)              { return __hip_atomic_load(p, __ATOMIC_RELAXED, __HIP_MEMORY_SCOPE_AGENT); }
__device__ __forceinline__ unsigned xb_add(unsigned* p, unsigned v) { return __hip_atomic_fetch_add(p, v, __ATOMIC_RELAXED, __HIP_MEMORY_SCOPE_AGENT); }
__device__ __forceinline__ unsigned xb_xcc_id() { return (unsigned)__builtin_amdgcn_s_getreg((3 << 11) | 20) & 0xFu; }
#define XB_SPIN(cond, bar) do { unsigned _sp = 0; while (cond) { __builtin_amdgcn_s_sleep(1); \
    if ((++_sp & 255u) == 0u) { if (xb_ld(&(bar)[XB_TMO])) break; if (_sp > XB_SPIN_CAP) { atomicAdd(&(bar)[XB_TMO], 1u); break; } } } } while (0)
struct XcdBarrier { unsigned* bar; unsigned x; volatile LAS unsigned* st; };
__device__ __forceinline__ XcdBarrier xcd_barrier_post(unsigned* bar, volatile LAS unsigned* st) {
    XcdBarrier b; b.bar = bar; b.x = xb_xcc_id(); b.st = st;
    if (threadIdx.x == 0) (void)xb_add(&bar[XB_XCNT(b.x)], 1u);
    return b;
}
__device__ __forceinline__ void xcd_barrier_complete(unsigned* bar, unsigned x, unsigned& nloc, unsigned& nx) {
    const unsigned G = gridDim.x * gridDim.y * gridDim.z;
    unsigned sum, cnt, mine, sp = 0u;
    for (;;) {
        sum = 0u; cnt = 0u; mine = 0u;
#pragma unroll
        for (unsigned j = 0; j < 16; ++j) { const unsigned c = xb_ld(&bar[XB_XCNT(j)]); sum += c; cnt += (c > 0u) ? 1u : 0u; mine = (j == x) ? c : mine; }
        if (sum == G) break;
        __builtin_amdgcn_s_sleep(1);
        if ((++sp & 255u) == 0u) { if (xb_ld(&bar[XB_TMO])) break; if (sp > XB_SPIN_CAP) { atomicAdd(&bar[XB_TMO], 1u); break; } }
    }
    nloc = mine > 0u ? mine : 1u; nx = cnt > 0u ? cnt : 1u;
}
__device__ __forceinline__ void xcd_barrier(const XcdBarrier& b, const int wave) {
    asm volatile("s_waitcnt vmcnt(0)" ::: "memory");
    __syncthreads();
    if (wave == 0 && lane_id_fresh() == 0) {
        unsigned* bar = b.bar; asm volatile("" : "+s"(bar));
        __builtin_amdgcn_s_waitcnt(0);
        unsigned nloc = b.st[0], nx = b.st[1];
        if (nloc == 0u) { xcd_barrier_complete(bar, b.x, nloc, nx); b.st[0] = nloc; b.st[1] = nx; }
        const unsigned old = xb_add(&bar[XB_XSUB(b.x)], 1u);
        const unsigned gen = old / nloc;
        if (old + 1u == (gen + 1u) * nloc) {
            __builtin_amdgcn_fence(__ATOMIC_RELEASE, "agent");
            asm volatile("s_waitcnt vmcnt(0)" ::: "memory");
            const unsigned og = xb_add(&bar[XB_TOP], 1u);
            const unsigned tg = og / nx;
            if (og + 1u == (tg + 1u) * nx) xb_add(&bar[XB_TOPGEN], 1u);
            else XB_SPIN(xb_ld(&bar[XB_TOPGEN]) == tg, bar);
            __builtin_amdgcn_fence(__ATOMIC_ACQUIRE, "agent");
            xb_add(&bar[XB_XGEN(b.x)], 1u);
            asm volatile("s_waitcnt vmcnt(0)" ::: "memory");
        } else {
            XB_SPIN(xb_ld(&bar[XB_XGEN(b.x)]) == gen, bar);
            __builtin_amdgcn_fence(__ATOMIC_ACQUIRE, "agent");
            asm volatile("s_waitcnt vmcnt(0)" ::: "memory");
        }
    }
    __syncthreads();
}

namespace pg8 {
#define PG8_LAS __attribute__((address_space(3)))
typedef unsigned short bf16_t;
typedef short bf16x8 __attribute__((ext_vector_type(8)));
typedef float f32x4 __attribute__((ext_vector_type(4)));
typedef unsigned u32x4 __attribute__((ext_vector_type(4)));
constexpr int BM = 256, BK = 64, HALF = 128, HTB = HALF * BK * 2  , STAGE_BYTES = 8 * HTB, NXCD = 8, WGM = 8;

__host__ __device__ __forceinline__ int lds_byte(int r, int c) { const int st = (r >> 4) * 2 + (c >> 5), rr = r & 15, cc = c & 31, ob = rr * 64 + cc * 2; return st * 1024 + (ob ^ (((ob >> 9) & 1) << 5)); }
__host__ __device__ __forceinline__ void stage_rc(int b, int& R, int& C) { const int st = b / 1024, sb = b % 1024, swz = sb ^ (((sb >> 9) & 1) << 5); R = (st >> 1) * 16 + swz / 64; C = (st & 1) * 32 + (swz % 64) / 2; }
__host__ __device__ __forceinline__ int perm32(int rho) { const int n = rho >> 4, i = rho & 15; return 8 * (i >> 2) + 4 * n + (i & 3); }

struct Unit { int pm, pn; };
struct Gemm { const bf16_t* A; const bf16_t* Bt; int M, N, K; };

struct StaticOrder {
    int nM, nN, nwg, G, c;
    __host__ __device__ void init(int M, int N, int G_, int c_) { nM = M / BM; nN = N / BM; nwg = nM * nN; G = G_; c = c_; }
    __host__ __device__ bool next(int i, Unit& u) const {
        const long L = (long)i * G + c; if (L >= nwg) return false;
        int wgid = (int)L; { const int q = nwg / NXCD, r = nwg % NXCD, xcd = wgid % NXCD, off = wgid / NXCD; wgid = (xcd < r ? xcd * (q + 1) : r * (q + 1) + (xcd - r) * q) + off; }
        const int nig = WGM * nN, gid = wgid / nig, fm = gid * WGM, gsz = (nM - fm) < WGM ? (nM - fm) : WGM;
        u.pm = fm + ((wgid % nig) % gsz); u.pn = (wgid % nig) / gsz; return true;
    }
    __device__ __forceinline__ void a_ready(const Unit&) const {}
    __device__ __forceinline__ void done(const Unit&) const {}
};
__device__ __forceinline__ unsigned cvt_pk_bf16(float lo, float hi) { unsigned r; asm volatile("v_cvt_pk_bf16_f32 %0, %1, %2" : "=v"(r) : "v"(lo), "v"(hi)); return r; }
typedef float f32x2 __attribute__((ext_vector_type(2)));
struct EpiIn {
    static constexpr bool PERM = true, AFTER_DRAIN = false;
    bf16_t* P; const float* qn; const float* kn; const float* tab;
    __device__ __forceinline__ void operator()(const f32x4 (&acc)[2][2][4][2], const Unit& u, int wr, int wc, int fr, int fq) const {
        const int col0 = u.pn * BM + wc * 64;
        int kind;
        if (col0 < 512) kind = 1; else if (col0 < 640) kind = 2; else if (col0 < 768) kind = 0; else if (col0 < 1280) kind = 3; else if (col0 < 2304) kind = 0;
        else if (col0 < 2816) kind = 4; else if (col0 < 2944) kind = 5; else if (col0 < 3072) kind = 0; else kind = 6;
        kind = __builtin_amdgcn_readfirstlane(kind);
        const bool latent = u.pm < 64;
        const bool do_norm = kind == 1 || kind == 2, do_rope = (kind == 1 || kind == 2 || kind == 4 || kind == 5) && latent, do_scale = kind == 1 || kind == 3 || kind == 4;
        f32x4 wlo[2], whi[2];
        if (do_norm) { const float* w = kind == 1 ? qn : kn;
#pragma unroll
            for (int n = 0; n < 2; ++n) { wlo[n] = *(const f32x4*)(w + 8 * fq + 4 * n); whi[n] = *(const f32x4*)(w + 32 + 8 * fq + 4 * n); } }
#pragma unroll
        for (int ai = 0; ai < 2; ++ai)
#pragma unroll
            for (int m = 0; m < 4; ++m) {
                const int row = u.pm * BM + ai * HALF + wr * 64 + m * 16 + fr;
                f32x4 lo[2], hi[2];
#pragma unroll
                for (int n = 0; n < 2; ++n) { lo[n] = acc[ai][0][m][n]; hi[n] = acc[ai][1][m][n]; }
                if (do_norm) {
                    float ss = 0.f;
#pragma unroll
                    for (int n = 0; n < 2; ++n)
#pragma unroll
                        for (int j = 0; j < 4; ++j) ss += lo[n][j] * lo[n][j] + hi[n][j] * hi[n][j];
                    ss += __shfl_xor(ss, 16); ss += __shfl_xor(ss, 32);
                    const float rstd = rsqrtf(ss * (1.f / 64.f) + 1e-6f);
#pragma unroll
                    for (int n = 0; n < 2; ++n) { lo[n] = lo[n] * rstd * wlo[n]; hi[n] = hi[n] * rstd * whi[n]; }
                }
                if (do_rope) {
                    const int pr = (4 * u.pm + 2 * ai + wr) & 127, pc = 16 * m + fr;
                    const int pos = fq < 2 ? pr : pc;
                    const float* tp = tab + (pos * 16 + 8 * (fq & 1)) * 2;
#pragma unroll
                    for (int n = 0; n < 2; ++n) {
                        const f32x4 t0 = *(const f32x4*)(tp + 8 * n), t1 = *(const f32x4*)(tp + 8 * n + 4);
                        const float cs[4] = {t0[0], t0[2], t1[0], t1[2]}, sn[4] = {t0[1], t0[3], t1[1], t1[3]};
#pragma unroll
                        for (int j = 0; j < 4; ++j) { const float a = lo[n][j], b = hi[n][j]; lo[n][j] = a * cs[j] - b * sn[j]; hi[n][j] = a * sn[j] + b * cs[j]; }
                    }
                }
                if (do_scale) {
#pragma unroll
                    for (int n = 0; n < 2; ++n) { lo[n] = lo[n] * (0.125f * 1.4426950408889634f); hi[n] = hi[n] * (0.125f * 1.4426950408889634f); }
                }
                if (kind == 6) {
#pragma unroll
                    for (int n = 0; n < 2; ++n)
#pragma unroll
                        for (int j = 0; j < 4; ++j) { lo[n][j] = lo[n][j] / (1.f + __expf(-lo[n][j])); hi[n][j] = hi[n][j] / (1.f + __expf(-hi[n][j])); }
                }
                bf16_t* rowp = P + (size_t)row * 4608 + col0 + 8 * fq;
                u32x4 w0, w1;
                w0.x = cvt_pk_bf16(lo[0][0], lo[0][1]); w0.y = cvt_pk_bf16(lo[0][2], lo[0][3]); w0.z = cvt_pk_bf16(lo[1][0], lo[1][1]); w0.w = cvt_pk_bf16(lo[1][2], lo[1][3]);
                w1.x = cvt_pk_bf16(hi[0][0], hi[0][1]); w1.y = cvt_pk_bf16(hi[0][2], hi[0][3]); w1.z = cvt_pk_bf16(hi[1][0], hi[1][1]); w1.w = cvt_pk_bf16(hi[1][2], hi[1][3]);
                *(u32x4*)rowp = w0; *(u32x4*)(rowp + 32) = w1;
            }
    }
};
struct EpiOut {
    static constexpr bool PERM = false, AFTER_DRAIN = false;
    const float* mod; const float* xlat_in; const float* xctx_in; float* xlat_out; float* xctx_out;
    __device__ __forceinline__ void operator()(const f32x4 (&acc)[2][2][4][2], const Unit& u, int wr, int wc, int fr, int fq) const {
        const bool latent = u.pm < 64;
        const int v = latent ? (u.pm >> 5) : 2;
        const float* gate = mod + (size_t)v * 3072 + 2048;
        const float* xin = latent ? xlat_in : xctx_in - (size_t)16384 * 1024;
        float* xout = latent ? xlat_out : xctx_out - (size_t)16384 * 1024;
        const int col0 = u.pn * BM + wc * 32 + 4 * fq;
        f32x4 g[2][2];
#pragma unroll
        for (int bj = 0; bj < 2; ++bj)
#pragma unroll
            for (int n = 0; n < 2; ++n) g[bj][n] = *(const f32x4*)(gate + col0 + bj * HALF + n * 16);
#pragma unroll
        for (int ai = 0; ai < 2; ++ai)
#pragma unroll
            for (int m = 0; m < 4; ++m) { const size_t off = (size_t)(u.pm * BM + ai * HALF + wr * 64 + m * 16 + fr) * 1024 + col0;
#pragma unroll
                for (int bj = 0; bj < 2; ++bj)
#pragma unroll
                    for (int n = 0; n < 2; ++n) { const f32x4 xo = *(const f32x4*)(xin + off + bj * HALF + n * 16); *(f32x4*)(xout + off + bj * HALF + n * 16) = xo + g[bj][n] * acc[ai][bj][m][n]; }
            }
    }
};
template <class Epi, class Sched, bool ALIGN_EPI = false, bool SP2 = false>
__device__ __forceinline__ void gemm_phase(PG8_LAS unsigned char* lds, const Gemm g, const Sched& S, const Epi& E, const int wid  ) {
    int lane; asm volatile("v_mbcnt_lo_u32_b32 %0, -1, 0\n\tv_mbcnt_hi_u32_b32 %0, -1, %0" : "=v"(lane));
    const int tid = wid * 64 + lane, wr = wid >> 2, wc = wid & 3, fr = lane & 15, fq = lane >> 4;
    const int K = g.K, nt = K / BK;
    unsigned voffA[2], voffB[2];
#pragma unroll
    for (int i = 0; i < 2; ++i) { int R, C; stage_rc(tid * 16 + i * 8192, R, C); const int Rb = Epi::PERM ? ((R & ~31) + perm32(R & 31)) : R;
        voffA[i] = (unsigned)(R * K + C) * 2u; voffB[i] = (unsigned)(Rb * K + C) * 2u; }
    const size_t kstep = (size_t)(BK * 2);
    const size_t hstep = (size_t)HALF * K * 2;
    const size_t tstep = 2 * hstep;
    const unsigned ldsw = (unsigned)wid * 1024u;
    const int aoff = lds_byte(wr * 64 + fr, fq * 8), boff = lds_byte(wc * 32 + fr, fq * 8);
#define PG8_SA(b, h) (((b) * 2 + (h)) * HTB)
#define PG8_SB(b, h) ((4 + (b) * 2 + (h)) * HTB)
#define PG8_STAGE(bufoff, gbase, voff) do { _Pragma("unroll") for (int _i = 0; _i < 2; ++_i) \
        __builtin_amdgcn_global_load_lds((const unsigned*)((const char*)(gbase) + (voff)[_i]), (PG8_LAS unsigned*)(lds + (bufoff) + ldsw + _i * 8192), 16, 0, 0); } while (0)
#define PG8_LDA(dst, b, h) do { _Pragma("unroll") for (int m = 0; m < 4; ++m) _Pragma("unroll") for (int k = 0; k < 2; ++k) dst[m][k] = *(const PG8_LAS bf16x8*)(lds + PG8_SA(b, h) + aoff + m * 2048 + k * 1024); } while (0)
#define PG8_LDB(dst, b, h) do { _Pragma("unroll") for (int n = 0; n < 2; ++n) _Pragma("unroll") for (int k = 0; k < 2; ++k) dst[n][k] = *(const PG8_LAS bf16x8*)(lds + PG8_SB(b, h) + boff + n * 2048 + k * 1024); } while (0)
#define PG8_MMA(ai, bj, At, Bt) do { __builtin_amdgcn_s_setprio(1); _Pragma("unroll") for (int m = 0; m < 4; ++m) _Pragma("unroll") for (int n = 0; n < 2; ++n) _Pragma("unroll") for (int k = 0; k < 2; ++k) \
        acc[ai][bj][m][n] = __builtin_amdgcn_mfma_f32_16x16x32_bf16(Bt[n][k], At[m][k], acc[ai][bj][m][n], 0, 0, 0); __builtin_amdgcn_s_setprio(0); } while (0)
#define PG8_WAIT_V(n) asm volatile("s_waitcnt vmcnt(" #n ")" ::: "memory")
#define PG8_WAIT_L(n) asm volatile("s_waitcnt lgkmcnt(" #n ")" ::: "memory")
#define PG8_BAR __builtin_amdgcn_s_barrier()
#define PG8_SCHED __builtin_amdgcn_sched_barrier(0)
    Unit cur, nxt; int ui = 0;
    if (!S.next(0, cur)) return;
    f32x4 acc[2][2][4][2];
#pragma unroll
    for (int a = 0; a < 2; ++a)
#pragma unroll
        for (int b = 0; b < 2; ++b)
#pragma unroll
            for (int m = 0; m < 4; ++m)
#pragma unroll
                for (int n = 0; n < 2; ++n) acc[a][b][m][n] = (f32x4){0.f, 0.f, 0.f, 0.f};
    bf16x8 At[4][2], B0[2][2], B1[2][2];
    const char* cA = (const char*)g.A + (size_t)cur.pm * tstep; const char* cB = (const char*)g.Bt + (size_t)cur.pn * tstep;
    S.a_ready(cur);
    if constexpr (SP2) {
        PG8_STAGE(PG8_SB(0, 0), cB, voffB); PG8_STAGE(PG8_SB(0, 1), cB + hstep, voffB); PG8_STAGE(PG8_SA(0, 0), cA, voffA); PG8_STAGE(PG8_SA(0, 1), cA + hstep, voffA);
        if (wr == 1) PG8_BAR;
        PG8_WAIT_V(2); PG8_BAR;
        PG8_STAGE(PG8_SB(1, 0), cB + kstep, voffB); PG8_STAGE(PG8_SA(1, 0), cA + kstep, voffA); PG8_STAGE(PG8_SB(1, 1), cB + hstep + kstep, voffB);
        PG8_WAIT_V(6); PG8_BAR;
    } else {
        PG8_STAGE(PG8_SB(0, 0), cB, voffB); PG8_STAGE(PG8_SA(0, 0), cA, voffA); PG8_STAGE(PG8_SB(0, 1), cB + hstep, voffB); PG8_STAGE(PG8_SA(0, 1), cA + hstep, voffA);
        if (wr == 1) PG8_BAR;
        PG8_WAIT_V(4); PG8_BAR;
        PG8_STAGE(PG8_SB(1, 0), cB + kstep, voffB); PG8_STAGE(PG8_SA(1, 0), cA + kstep, voffA); PG8_STAGE(PG8_SB(1, 1), cB + hstep + kstep, voffB);
        PG8_WAIT_V(6); PG8_BAR;
    }
    for (;;) {
        const bool has_next = S.next(ui + 1, nxt);
        const char* nA = has_next ? (const char*)g.A + (size_t)nxt.pm * tstep : cA; const char* nB = has_next ? (const char*)g.Bt + (size_t)nxt.pn * tstep : cB;
        for (int t = 0; t < nt; t += 2) {
            const bool last = (t == nt - 2);
            const char* a1 = cA + (size_t)(t + 1) * kstep;
            const char* a2 = last ? nA : cA + (size_t)(t + 2) * kstep; const char* b2 = last ? nB : cB + (size_t)(t + 2) * kstep;
            const char* a3 = a2 + kstep; const char* b3 = b2 + kstep;
            if (last && has_next) S.a_ready(nxt);
            if constexpr (SP2) {
            PG8_LDB(B0, 0, 0); PG8_LDB(B1, 0, 1); PG8_SCHED; PG8_LDA(At, 0, 0); PG8_STAGE(PG8_SA(1, 1), a1 + hstep, voffA);
            PG8_WAIT_V(8); PG8_WAIT_L(0); PG8_BAR; PG8_MMA(0, 0, At, B0); PG8_MMA(0, 1, At, B1); PG8_BAR; PG8_SCHED;
            PG8_LDA(At, 0, 1); PG8_STAGE(PG8_SB(0, 0), b2, voffB); PG8_STAGE(PG8_SB(0, 1), b2 + hstep, voffB); PG8_STAGE(PG8_SA(0, 0), a2, voffA);
            PG8_WAIT_V(8); PG8_WAIT_L(0); PG8_BAR; PG8_MMA(1, 0, At, B0); PG8_MMA(1, 1, At, B1); PG8_BAR; PG8_SCHED;
            PG8_LDB(B0, 1, 0); PG8_LDB(B1, 1, 1); PG8_SCHED; PG8_LDA(At, 1, 0); PG8_STAGE(PG8_SA(0, 1), a2 + hstep, voffA);
            PG8_WAIT_V(8); PG8_WAIT_L(0); PG8_BAR; PG8_MMA(0, 0, At, B0); PG8_MMA(0, 1, At, B1); PG8_BAR; PG8_SCHED;
            PG8_LDA(At, 1, 1); PG8_STAGE(PG8_SB(1, 0), b3, voffB); PG8_STAGE(PG8_SB(1, 1), b3 + hstep, voffB); PG8_STAGE(PG8_SA(1, 0), a3, voffA);
            PG8_WAIT_V(8); PG8_WAIT_L(0); PG8_BAR; PG8_MMA(1, 0, At, B0); PG8_MMA(1, 1, At, B1); PG8_BAR; PG8_SCHED;
            } else {
            PG8_LDB(B0, 0, 0); PG8_SCHED; PG8_LDA(At, 0, 0); PG8_STAGE(PG8_SA(1, 1), a1 + hstep, voffA);
            PG8_WAIT_L(8); PG8_BAR; PG8_WAIT_L(0); PG8_MMA(0, 0, At, B0); PG8_BAR; PG8_SCHED;
            PG8_LDB(B1, 0, 1); PG8_STAGE(PG8_SB(0, 0), b2, voffB);
            PG8_BAR; PG8_WAIT_L(0); PG8_MMA(0, 1, At, B1); PG8_BAR;
            PG8_LDA(At, 0, 1); PG8_STAGE(PG8_SA(0, 0), a2, voffA);
            PG8_BAR; PG8_WAIT_L(0); PG8_MMA(1, 0, At, B0); PG8_BAR; PG8_SCHED;
            PG8_STAGE(PG8_SB(0, 1), b2 + hstep, voffB);
            PG8_WAIT_V(6); PG8_BAR; PG8_MMA(1, 1, At, B1); PG8_BAR;
            PG8_LDB(B0, 1, 0); PG8_SCHED; PG8_LDA(At, 1, 0); PG8_STAGE(PG8_SA(0, 1), a2 + hstep, voffA);
            PG8_WAIT_L(8); PG8_BAR; PG8_WAIT_L(0); PG8_MMA(0, 0, At, B0); PG8_BAR; PG8_SCHED;
            PG8_LDB(B1, 1, 1); PG8_STAGE(PG8_SB(1, 0), b3, voffB);
            PG8_BAR; PG8_WAIT_L(0); PG8_MMA(0, 1, At, B1); PG8_BAR;
            PG8_LDA(At, 1, 1); PG8_STAGE(PG8_SA(1, 0), a3, voffA);
            PG8_BAR; PG8_WAIT_L(0); PG8_MMA(1, 0, At, B0); PG8_BAR; PG8_SCHED;
            PG8_STAGE(PG8_SB(1, 1), b3 + hstep, voffB);
            PG8_WAIT_V(6); PG8_BAR; PG8_MMA(1, 1, At, B1); PG8_BAR;
            }
        }
        if constexpr (ALIGN_EPI) { if (wr == 0) PG8_BAR; }
        if constexpr (!Epi::AFTER_DRAIN) { E(acc, cur, wr, wc, fr, fq); S.done(cur); }
        if (!has_next) break;
#pragma unroll
        for (int a = 0; a < 2; ++a)
#pragma unroll
            for (int b = 0; b < 2; ++b)
#pragma unroll
                for (int m = 0; m < 4; ++m)
#pragma unroll
                    for (int n = 0; n < 2; ++n) acc[a][b][m][n] = (f32x4){0.f, 0.f, 0.f, 0.f};
        cur = nxt; cA = nA; cB = nB; ++ui;
        if constexpr (ALIGN_EPI) { if (wr == 1) PG8_BAR; }
    }
    PG8_WAIT_V(0);
    if constexpr (!ALIGN_EPI) { if (wr == 0) PG8_BAR; }
    PG8_BAR;
    if constexpr (Epi::AFTER_DRAIN) { E.fused(acc, cur, wr, wc, fr, fq, lds, wid, lane); S.done(cur); }
#undef PG8_SA
#undef PG8_SB
#undef PG8_STAGE
#undef PG8_LDA
#undef PG8_LDB
#undef PG8_MMA
#undef PG8_WAIT_V
#undef PG8_WAIT_L
#undef PG8_BAR
#undef PG8_SCHED
}
}

struct Ctx {
    LAS unsigned char* lds; int tid, lane, wave, vcu, G;
};
__device__ __forceinline__ Ctx fresh(const Ctx& F0) { Ctx F = F0; const int l = lane_id_fresh(); F.lane = l; F.tid = F0.wave * 64 + l; return F; }

template <bool PERMUTE>
__device__ __forceinline__ void p0_transpose_item(const float* W, int K, int N, bf16_t* WT, LAS float* scr, int item, int lane) {
    const int nblk = N / 32, kb = item / nblk, nb = item % nblk, k0 = 64 * kb, n0 = 32 * nb;
    const int r0 = PERMUTE ? ((n0 & ~255) + 128 * ((n0 >> 5) & 1) + 32 * ((n0 >> 6) & 3)) : n0;
#pragma unroll 8
    for (int i = 0; i < 32; ++i) { const int kk = 2 * i + (lane >> 5); scr[kk * 33 + (lane & 31)] = W[(size_t)(k0 + kk) * N + n0 + (lane & 31)]; }
    LDS_WAIT(); asm volatile("" ::: "memory");
    const int c = lane & 7;
#pragma unroll
    for (int j = 0; j < 4; ++j) { const int n = (lane >> 3) + 8 * j; const LAS float* s = scr + (8 * c) * 33 + n;
        u32x4 o; o.x = pk2(s[0 * 33], s[1 * 33]); o.y = pk2(s[2 * 33], s[3 * 33]); o.z = pk2(s[4 * 33], s[5 * 33]); o.w = pk2(s[6 * 33], s[7 * 33]);
        *(u32x4*)(WT + (size_t)(r0 + n) * K + k0 + 8 * c) = o; }
    LDS_WAIT(); asm volatile("" ::: "memory");
}

__device__ __forceinline__ void phase_prologue(const Ctx& F0, const float* w_in, const float* w_out, const float* c, const float* c_ctx, const float* ada_w, const float* ada_b,
                                               bf16_t* wtin, bf16_t* wtout, float* tab, float* mod) {
    const Ctx F = fresh(F0);
    LAS float* scr = (LAS float*)(F.lds + F.wave * 16384);
    const int gw = F.vcu * NWAVES + F.wave, NGW = F.G * NWAVES;
    constexpr int I_IN = (DM / 64) * (NIN / 32), I_OUT = (MIX / 64) * (DM / 32), NITEMS = 2 * (I_IN + I_OUT);
    for (int it = gw; it < NITEMS; it += NGW) {
        int r = it;
        if (r < I_IN) { p0_transpose_item<true>(w_in, DM, NIN, wtin, scr, r, F.lane); continue; } r -= I_IN;
        if (r < I_IN) { p0_transpose_item<true>(w_in + (size_t)DM * NIN, DM, NIN, wtin + (size_t)NIN * DM, scr, r, F.lane); continue; } r -= I_IN;
        if (r < I_OUT) { p0_transpose_item<false>(w_out, MIX, DM, wtout, scr, r, F.lane); continue; } r -= I_OUT;
        p0_transpose_item<false>(w_out + (size_t)MIX * DM, MIX, DM, wtout + (size_t)DM * MIX, scr, r, F.lane);
    }
    { const int idx = F.vcu * NTHREADS + F.tid;
      if (idx < 128 * 16) { const int pos = idx >> 4, i = idx & 15; const float freq = powf(10000.f, -(float)i / 16.f); const float ang = (float)pos * freq; tab[idx * 2] = cosf(ang); tab[idx * 2 + 1] = sinf(ang); } }
    { const int wk = F.vcu * 2 + (F.tid >> 8), NWK = F.G * 2, t = F.tid & 255;
      for (int it = wk; it < 2 * 16 * 12; it += NWK) {
          const int nb = it % 12, kc = (it / 12) % 16, l = it / 192; const int n = nb * 256 + t;
          float a0 = 0.f, a1 = 0.f, a2 = 0.f;
          const float* w = ada_w + ((size_t)l * DM + kc * 64) * 3072 + n;
#pragma unroll 8
          for (int k = 0; k < 64; ++k) { const float wv = w[(size_t)k * 3072]; const int kk = kc * 64 + k;
              a0 += silu_f(c[kk]) * wv; a1 += silu_f(c[DM + kk]) * wv; a2 += silu_f(c_ctx[kk]) * wv; }
          if (kc == 0) { const float bb = ada_b[l * 3072 + n]; a0 += bb; a1 += bb; a2 += bb; }
          float* p = mod + (size_t)l * 3 * 3072 + n;
          atomicAdd(p, a0); atomicAdd(p + 3072, a1); atomicAdd(p + 2 * 3072, a2);
      } }
}

__device__ __forceinline__ void phase_norm_mod(const Ctx& F0, const float* xlat, const float* xctx, const float* nw, const float* mod, bf16_t* HX) {
    const Ctx F = fresh(F0);
    const int gw = F.vcu * NWAVES + F.wave, NGW = F.G * NWAVES, lane = F.lane;
    for (int row = gw; row < MT; row += NGW) {
        const int v = row < ML ? row / SEQ : 2;
        const float* xr = row < ML ? xlat + (size_t)row * DM : xctx + (size_t)(row - ML) * DM;
        f32x4 xv[4]; float ss = 0.f;
#pragma unroll
        for (int j = 0; j < 4; ++j) { xv[j] = *(const f32x4*)(xr + 256 * j + 4 * lane); ss += xv[j][0] * xv[j][0] + xv[j][1] * xv[j][1] + xv[j][2] * xv[j][2] + xv[j][3] * xv[j][3]; }
        const float rstd = rsqrtf(wave_sum(ss) * (1.f / DM) + EPS);
        const float* shift = mod + (size_t)v * 3072; const float* scale = shift + 1024;
#pragma unroll
        for (int j = 0; j < 4; ++j) {
            const int k = 256 * j + 4 * lane;
            const f32x4 w = *(const f32x4*)(nw + k), sc = *(const f32x4*)(scale + k), sh = *(const f32x4*)(shift + k);
            float y[4];
#pragma unroll
            for (int e = 0; e < 4; ++e) y[e] = xv[j][e] * rstd * w[e] * (1.f + sc[e]) + sh[e];
            uint2 o; o.x = pk2(y[0], y[1]); o.y = pk2(y[2], y[3]);
            *(uint2*)(HX + (size_t)row * DM + k) = o;
        }
    }
}

namespace att {
typedef unsigned short bf16;
using bf16x8=__attribute__((ext_vector_type(8)))short;
using s16x4=__attribute__((ext_vector_type(4)))short;
using f32x16=__attribute__((ext_vector_type(16)))float;
using f32x4=__attribute__((ext_vector_type(4)))float;
using u32x4=__attribute__((ext_vector_type(4)))unsigned;
constexpr int PITCH=4608, UPITCH=1536, GCOL=3072;
constexpr int NW=8,QBLK=32,KVBLK=64;
constexpr int NSLOT=3, SLOTB=8192, OSTR=68  ;
constexpr int LDS_K=0, LDS_V=NSLOT*SLOTB, LDS_WS=2*NSLOT*SLOTB, LDS_OST=LDS_WS+NW*64*4, LDS_BIAS=LDS_OST+NW*32*OSTR*4, LDS_BYTES=LDS_BIAS+2048;
constexpr float L2E=1.4426950408889634f;
struct Unit {
  int type;
  int nt;
  int nlat;
  int ctx0, lat0;
  int first;
  int kcol, vcol;
  int qrow0, tq0;
  int h0, gqa;
};
__device__ __forceinline__ int crow(int r,int hi){return (r&3)+8*(r>>2)+4*hi;}
#define SBAR() __builtin_amdgcn_sched_barrier(0)
__device__ __forceinline__ void glds16(const void*gsrc,unsigned lds_dst){unsigned keep;
  asm volatile("s_mov_b32 %0, m0\n\ts_mov_b32 m0, %2\n\ts_nop 0\n\tglobal_load_lds_dwordx4 %1, off\n\ts_mov_b32 m0, %0":"=&s"(keep):"v"(gsrc),"s"(lds_dst):"memory");}
__device__ __forceinline__ float max3f(float a,float b,float c){float r;asm("v_max3_f32 %0, %1, %2, %3":"=v"(r):"v"(a),"v"(b),"v"(c));return r;}
__device__ __forceinline__ float max2f(float a,float b){float r;asm("v_max_f32_e32 %0, %1, %2":"=v"(r):"v"(a),"v"(b));return r;}
__device__ __forceinline__ float fadd_s(float a,float b){float r;asm("v_add_f32_e32 %0, %1, %2":"=v"(r):"v"(a),"v"(b));return r;}
__device__ __forceinline__ float fsub_s(float a,float b){float r;asm("v_sub_f32_e32 %0, %1, %2":"=v"(r):"v"(a),"v"(b));return r;}
typedef float f32x2_t __attribute__((ext_vector_type(2))); typedef __bf16 bf16x2_t __attribute__((ext_vector_type(2)));
__device__ __forceinline__ unsigned cvtpk_s(float lo,float hi){f32x2_t v={lo,hi};bf16x2_t b=__builtin_convertvector(v,bf16x2_t);return __builtin_bit_cast(unsigned,b);}
#define WAIT_BAR(N) asm volatile("s_waitcnt vmcnt(" #N ") lgkmcnt(0)\n\ts_barrier":::"memory")
__device__ __forceinline__ void qkt(f32x16&p0,f32x16&p1,const char*Kslot,const bf16x8*qr,const f32x16&negm,int r32,int hi){
  const char*kb=Kslot+hi*1024+r32*16;
  #pragma unroll
  for(int d0=0;d0<4;++d0){
    const bf16x8 b0=*reinterpret_cast<const bf16x8*>(kb+d0*2048);
    const bf16x8 b1=*reinterpret_cast<const bf16x8*>(kb+d0*2048+512);
    if(d0==0){p0=__builtin_amdgcn_mfma_f32_32x32x16_bf16(b0,qr[0],negm,0,0,0);p1=__builtin_amdgcn_mfma_f32_32x32x16_bf16(b1,qr[0],negm,0,0,0);}
    else{p0=__builtin_amdgcn_mfma_f32_32x32x16_bf16(b0,qr[d0],p0,0,0,0);p1=__builtin_amdgcn_mfma_f32_32x32x16_bf16(b1,qr[d0],p1,0,0,0);}}
}
typedef __attribute__((address_space(3))) const char* lds_cptr;
typedef short v4i16_t __attribute__((ext_vector_type(4)));
__device__ __forceinline__ void kload8(bf16x8*kf,lds_cptr kp){
  kf[0]=*(const __attribute__((address_space(3))) bf16x8*)(kp);      kf[1]=*(const __attribute__((address_space(3))) bf16x8*)(kp+512);
  kf[2]=*(const __attribute__((address_space(3))) bf16x8*)(kp+2048); kf[3]=*(const __attribute__((address_space(3))) bf16x8*)(kp+2560);
  kf[4]=*(const __attribute__((address_space(3))) bf16x8*)(kp+4096); kf[5]=*(const __attribute__((address_space(3))) bf16x8*)(kp+4608);
  kf[6]=*(const __attribute__((address_space(3))) bf16x8*)(kp+6144); kf[7]=*(const __attribute__((address_space(3))) bf16x8*)(kp+6656);
}
__device__ __forceinline__ void kload2(bf16x8*kf,lds_cptr kp,int j){ kf[2*j]=*(const __attribute__((address_space(3))) bf16x8*)(kp+j*2048); kf[2*j+1]=*(const __attribute__((address_space(3))) bf16x8*)(kp+j*2048+512); }
__device__ __forceinline__ s16x4 vtr(lds_cptr p){ return __builtin_bit_cast(s16x4,__builtin_amdgcn_ds_read_tr16_b64_v4i16((__attribute__((address_space(3))) v4i16_t*)p)); }
__device__ __forceinline__ float rowmax(const f32x16&p0,const f32x16&p1){
  float a=max3f(p0[0],p0[1],p1[0]),b=max3f(p0[2],p0[3],p1[1]);a=max3f(a,p1[2],p1[3]);
  #pragma unroll
  for(int r=4;r<16;r+=4){a=max3f(a,p0[r],p0[r+1]);b=max3f(b,p0[r+2],p0[r+3]);a=max3f(a,p1[r],p1[r+1]);b=max3f(b,p1[r+2],p1[r+3]);}
  const float m=max2f(a,b);
  auto rr=__builtin_amdgcn_permlane32_swap(__float_as_uint(m),__float_as_uint(m),false,false);
  return max2f(__uint_as_float(rr[0]),__uint_as_float(rr[1]));
}
__device__ __forceinline__ void pv(f32x16*o,int vb,bf16x8 pa0,bf16x8 pa1,bf16x8 pa2,bf16x8 pa3){
  #pragma unroll
  for(int d0=0;d0<2;++d0){s16x4 lo[4],hi[4];
    #pragma unroll
    for(int ks=0;ks<4;++ks){
      asm volatile("ds_read_b64_tr_b16 %0,%1 offset:%c2":"=&v"(lo[ks]):"v"(vb),"i"(d0*4096+ks*1024):"memory");
      asm volatile("ds_read_b64_tr_b16 %0,%1 offset:%c2":"=&v"(hi[ks]):"v"(vb),"i"(d0*4096+ks*1024+512):"memory");}
    asm volatile("s_waitcnt lgkmcnt(0)":::"memory");SBAR();
    #define PK(k) (bf16x8){lo[k][0],lo[k][1],lo[k][2],lo[k][3],hi[k][0],hi[k][1],hi[k][2],hi[k][3]}
    o[d0]=__builtin_amdgcn_mfma_f32_32x32x16_bf16(pa0,PK(0),o[d0],0,0,0);
    o[d0]=__builtin_amdgcn_mfma_f32_32x32x16_bf16(pa1,PK(1),o[d0],0,0,0);
    o[d0]=__builtin_amdgcn_mfma_f32_32x32x16_bf16(pa2,PK(2),o[d0],0,0,0);
    o[d0]=__builtin_amdgcn_mfma_f32_32x32x16_bf16(pa3,PK(3),o[d0],0,0,0);
    #undef PK
  }
}
template<int TYPE> __device__ __forceinline__ void amask(f32x16&c0,f32x16&c1,int li,int nlat,int mA,int mB,int u0,int u1,const float*bt){
  const float NEG=-INFINITY;
  bool dead = li>=nlat;
  if(TYPE==1) dead = dead || (unsigned)(li-u0)>=8u;
  if(dead){
    #pragma unroll
    for(int r=0;r<16;++r){c0[r]=NEG;c1[r]=NEG;}
    return; }
  if(TYPE==1){
    const float*row=bt+(li-u1+7)*31;
    #pragma unroll
    for(int r=0;r<16;++r){ const int kk0=(r&3)+8*(r>>2);
      int i0=kk0+mB; i0=i0<0?0:(i0>30?30:i0); int i1=kk0+32+mB; i1=i1<0?0:(i1>30?30:i1);
      const float b0=row[i0], b1=row[i1];
      c0[r]=((unsigned)(kk0+mA)<16u)?c0[r]+b0:NEG; c1[r]=((unsigned)(kk0+32+mA)<16u)?c1[r]+b1:NEG; }
  } else {
    const int base=mA+64*li;
    #pragma unroll
    for(int r=0;r<16;++r){ const int kk0=(r&3)+8*(r>>2);
      if((unsigned)(kk0+base)>256u)c0[r]=NEG; if((unsigned)(kk0+32+base)>256u)c1[r]=NEG; }
  }
}

template<int TYPE,int THRL,bool NOMAX> __device__ __forceinline__ void attn_unit(const Unit&ud,const bf16*__restrict__ P,bf16*__restrict__ U,const float*rpbl,const float*sinkl,char*shm,const int wid){
  int lane; asm volatile("v_mbcnt_lo_u32_b32 %0, -1, 0\n\tv_mbcnt_hi_u32_b32 %0, -1, %0":"=v"(lane));
  const int tid=wid*64+lane,r32=lane&31,hi=lane>>5;
  const int hq=ud.gqa?ud.h0+(wid&3):ud.h0, qoff=ud.gqa?32*(wid>>2):32*wid;
  const int qcol=(TYPE==0?0:TYPE==1?768:2304)+hq*64, ucol=TYPE*512+hq*64;
  const long qrow=ud.qrow0+qoff;
  const bf16*Qw=P+qrow*PITCH+qcol;
  const unsigned lds0=(unsigned)(uintptr_t)shm;
  float*wsf=(float*)(shm+LDS_WS)+wid*64;
  const bf16*ksrc=P+(long)lane*PITCH+ud.kcol+wid*8;
  const bf16*vsrc=P+(long)(16*(wid&3)+(lane>>2))*PITCH+ud.vcol+(wid>>2)*32+(lane&3)*8;
  const unsigned kdst=lds0+LDS_K+wid*1024, vdst=lds0+LDS_V+wid*1024;
  const int NT=ud.nt, nlat=ud.nlat;
  #define TROW(t) ((long)(((t)<4)?(ud.ctx0+64*(t)):(ud.lat0+64*((((t)-4)<nlat)?((t)-4):(nlat-1)))))
  #define DMA_K(t,slot) glds16(ksrc+TROW(t)*PITCH,(unsigned)__builtin_amdgcn_readfirstlane(kdst+(slot)))
  #define DMA_V(t,slot) glds16(vsrc+TROW(t)*PITCH,(unsigned)__builtin_amdgcn_readfirstlane(vdst+(slot)))
  const int vb0=(int)(lds0+LDS_V)+((lane>>4)&1)*32+(lane&3)*8+(4*hi+((lane&15)>>2))*64;
  const char*Kbase=shm+LDS_K; bf16x8 kf[8];
  const lds_cptr shm3=(lds_cptr)shm; const lds_cptr kp0=shm3+LDS_K+hi*1024+r32*16; const lds_cptr vp0=shm3+LDS_V+((lane>>4)&1)*32+(lane&3)*8+(4*hi+((lane&15)>>2))*64;
  int mA=0,mB=0,u0=0,u1=0; const float*bt=(const float*)(shm+LDS_BIAS);
  if(TYPE==1){ const int tqw=ud.tq0+qoff, qg=tqw>>6, qc=(tqw&63)+r32; int rs=qg-4; rs=rs<0?0:(rs>120?120:rs); int cs=qc-8; cs=cs<0?0:(cs>48?48:cs);
    mA=4*hi-cs; mB=4*hi-qc+15; u0=rs-ud.first; u1=qg-ud.first;
    float*btw=(float*)(shm+LDS_BIAS); for(int i=tid;i<465;i+=512)btw[i]=rpbl[hq*465+i]*L2E; }
  if(TYPE==2){ const int tq=ud.tq0+qoff+r32; mA=4*hi-(tq-64*ud.first)+128; }
  DMA_K(0,0);DMA_V(0,0);DMA_K(1,SLOTB);
  bf16x8 qr[4];
  #pragma unroll
  for(int d0=0;d0<4;++d0)qr[d0]=*reinterpret_cast<const bf16x8*>(&Qw[(long)r32*PITCH+d0*16+hi*8]);
  float mhat=0.f,l_reg=0.f;f32x16 o[2];o[0]=f32x16{};o[1]=f32x16{};f32x16 negm=f32x16{};if(!NOMAX)asm volatile("":"+v"(negm));
  #define NEGM (NOMAX?(f32x16){}:negm)
  #define AMASK(P0,P1,t) do{ if(TYPE!=0){ if((t)>=4) amask<TYPE>(P0,P1,(t)-4,nlat,mA,mB,u0,u1,bt); } }while(0)
  bool resc=false;
  #define START(P0,P1) do{ resc=false; if(!NOMAX){ const float rm=rowmax(P0,P1); \
    { const float dl=rm; mhat=fadd_s(mhat,dl); \
      _Pragma("unroll") for(int r=0;r<16;++r){P0[r]=fsub_s(P0[r],dl);P1[r]=fsub_s(P1[r],dl);} \
      _Pragma("unroll") for(int r=0;r<16;++r)negm[r]=-mhat; asm volatile("":"+v"(negm)); } } \
    _Pragma("unroll") for(int r=0;r<16;++r)P0[r]=__builtin_amdgcn_exp2f(P0[r]); }while(0)
  #define RESC() do{ if(!NOMAX&&resc){ asm volatile("s_waitcnt lgkmcnt(0)":::"memory"); \
      _Pragma("unroll") for(int d_=0;d_<2;++d_) _Pragma("unroll") for(int r=0;r<16;++r)o[d_][r]*=wsf[crow(r,hi)]; } }while(0)
  f32x16 pA0,pA1,pB0,pB1;
  int sl_prev=0,sl_cur=0,sl_next=SLOTB;
  #define ROT() do{sl_prev=sl_cur;sl_cur=sl_next;sl_next=(sl_next==(NSLOT-1)*SLOTB)?0:sl_next+SLOTB;}while(0)
  DMA_K(2,2*SLOTB);
  WAIT_BAR(3);
  qkt(pA0,pA1,Kbase,qr,NEGM,r32,hi);asm volatile("s_nop 15\n\ts_nop 7":"+v"(pA0),"+v"(pA1));
  START(pA0,pA1);
  _Pragma("unroll") for(int r=0;r<16;++r)pA1[r]=__builtin_amdgcn_exp2f(pA1[r]);
  WAIT_BAR(0);
  DMA_K(3,0);DMA_V(1,SLOTB);
  ROT();
  kload8(kf,kp0+sl_cur);
  WAIT_BAR(2);
  s16x4 vlo[8],vhi[8]; u32x4 pw0,pw1,pw2,pw3;
  #define PKW(P,B) cvtpk_s(P[B],P[B+1])
  #define PAF(k) __builtin_bit_cast(bf16x8,pw##k)
  #define VFR(i) (bf16x8){vlo[i][0],vlo[i][1],vlo[i][2],vlo[i][3],vhi[i][0],vhi[i][1],vhi[i][2],vhi[i][3]}
  #define PIN(x) asm volatile("":"+v"(x))
  #define MX3(a,b,c) __builtin_fmaxf(__builtin_fmaxf((a),(b)),(c))
  #define GAPA(MF,A0,A1,A2,A3,W0,W1,PW) do{ MF; sacc+=A0; sacc+=A1; sacc+=A2; sacc+=A3; PIN(sacc); W0; W1; PIN(PW); SBAR(); }while(0)
  #define EX(v) __builtin_amdgcn_exp2f(v)
  #define GAPB(MF,X,B) do{ MF; X[B]=EX(X[B]); X[B+1]=EX(X[B+1]); X[B+2]=EX(X[B+2]); X[B+3]=EX(X[B+3]); PIN(X); SBAR(); }while(0)
  #define VRD(i) do{ vlo[i]=vtr(vp_+(((i)>>2)*4096+((i)&3)*1024)); vhi[i]=vtr(vp_+(((i)>>2)*4096+((i)&3)*1024+512)); }while(0)
  #define KRD(G,j) do{ if(G){ kload2(kf,kp0+sl_next,j); SBAR(); } }while(0)
  #define STEP(C0,C1,P0,P1,t,GK,GV,GL) do{ SBAR(); \
    const lds_cptr vp_=vp0+sl_prev; \
    VRD(0); SBAR(); float sacc=(P0[0]+P0[1]); \
    GAPA(C0=__builtin_amdgcn_mfma_f32_32x32x16_bf16(kf[0],qr[0],NEGM,0,0,0), P0[2],P0[3],P0[4],P0[5],     pw0[0]=PKW(P0,0), pw0[1]=PKW(P0,2), pw0); \
    VRD(4); SBAR(); GAPA(C1=__builtin_amdgcn_mfma_f32_32x32x16_bf16(kf[1],qr[0],NEGM,0,0,0), P0[6],P0[7],P0[8],P0[9],     pw0[2]=PKW(P0,4), pw0[3]=PKW(P0,6), pw0); \
    VRD(1); SBAR(); GAPA(C0=__builtin_amdgcn_mfma_f32_32x32x16_bf16(kf[2],qr[1],C0,0,0,0),   P0[10],P0[11],P0[12],P0[13], pw1[0]=PKW(P0,8), pw1[1]=PKW(P0,10), pw1); \
    VRD(5); SBAR(); GAPA(C1=__builtin_amdgcn_mfma_f32_32x32x16_bf16(kf[3],qr[1],C1,0,0,0),   P0[14],P0[15],P1[0],P1[1],   pw1[2]=PKW(P0,12),pw1[3]=PKW(P0,14), pw1); \
    VRD(2); SBAR(); GAPA(C0=__builtin_amdgcn_mfma_f32_32x32x16_bf16(kf[4],qr[2],C0,0,0,0),   P1[2],P1[3],P1[4],P1[5],     pw2[0]=PKW(P1,0), pw2[1]=PKW(P1,2), pw2); \
    VRD(6); SBAR(); GAPA(C1=__builtin_amdgcn_mfma_f32_32x32x16_bf16(kf[5],qr[2],C1,0,0,0),   P1[6],P1[7],P1[8],P1[9],     pw2[2]=PKW(P1,4), pw2[3]=PKW(P1,6), pw2); \
    VRD(3); SBAR(); GAPA(C0=__builtin_amdgcn_mfma_f32_32x32x16_bf16(kf[6],qr[3],C0,0,0,0),   P1[10],P1[11],P1[12],P1[13], pw3[0]=PKW(P1,8), pw3[1]=PKW(P1,10), pw3); \
    VRD(7); SBAR(); GAPA(C1=__builtin_amdgcn_mfma_f32_32x32x16_bf16(kf[7],qr[3],C1,0,0,0),   P1[14],P1[15],0.f,0.f,       pw3[2]=PKW(P1,12),pw3[3]=PKW(P1,14), pw3); \
    l_reg+=sacc; \
    if(GK){DMA_K((t)+3,sl_cur);} if(GV){DMA_V((t)+1,sl_next);} \
    AMASK(C0,C1,t); \
    if(!NOMAX){ float a=MX3(C0[0],C0[1],C1[0]),b=MX3(C0[2],C0[3],C1[1]); a=MX3(a,C1[2],C1[3]); \
      _Pragma("unroll") for(int r=4;r<16;r+=4){a=MX3(a,C0[r],C0[r+1]);b=MX3(b,C0[r+2],C0[r+3]);a=MX3(a,C1[r],C1[r+1]);b=MX3(b,C1[r+2],C1[r+3]);} \
      float rm=__builtin_fmaxf(a,b); { auto rr=__builtin_amdgcn_permlane32_swap(__float_as_uint(rm),__float_as_uint(rm),false,false); rm=__builtin_fmaxf(__uint_as_float(rr[0]),__uint_as_float(rr[1])); } \
      resc=false; \
      if(__builtin_expect(__any(rm>(float)THRL),0)){ const float dl=__builtin_fmaxf(rm,0.f); mhat+=dl; \
        _Pragma("unroll") for(int r=0;r<16;++r){C0[r]-=dl;C1[r]-=dl;} \
        _Pragma("unroll") for(int r=0;r<16;++r)negm[r]=-mhat; asm volatile("":"+v"(negm)); \
        const float f=__builtin_amdgcn_exp2f(-dl); l_reg*=f; if(hi==0)wsf[r32]=f; resc=true; } } \
    SBAR(); \
    GAPB(o[0]=__builtin_amdgcn_mfma_f32_32x32x16_bf16(PAF(0),VFR(0),o[0],0,0,0), C0,0); \
    GAPB(o[1]=__builtin_amdgcn_mfma_f32_32x32x16_bf16(PAF(0),VFR(4),o[1],0,0,0), C0,4); \
    KRD(GL,0); GAPB(o[0]=__builtin_amdgcn_mfma_f32_32x32x16_bf16(PAF(1),VFR(1),o[0],0,0,0), C0,8); \
    KRD(GL,1); GAPB(o[1]=__builtin_amdgcn_mfma_f32_32x32x16_bf16(PAF(1),VFR(5),o[1],0,0,0), C0,12); \
    KRD(GL,2); GAPB(o[0]=__builtin_amdgcn_mfma_f32_32x32x16_bf16(PAF(2),VFR(2),o[0],0,0,0), C1,0); \
    KRD(GL,3); GAPB(o[1]=__builtin_amdgcn_mfma_f32_32x32x16_bf16(PAF(2),VFR(6),o[1],0,0,0), C1,4); \
    GAPB(o[0]=__builtin_amdgcn_mfma_f32_32x32x16_bf16(PAF(3),VFR(3),o[0],0,0,0), C1,8); \
    GAPB(o[1]=__builtin_amdgcn_mfma_f32_32x32x16_bf16(PAF(3),VFR(7),o[1],0,0,0), C1,12); \
    }while(0)
  int t=1;
  if(TYPE==0){
    for(;t+5<NT;t+=2){
      STEP(pB0,pB1,pA0,pA1,t,true,true,true);     WAIT_BAR(2); RESC(); ROT();
      STEP(pA0,pA1,pB0,pB1,t+1,true,true,true);   WAIT_BAR(2); RESC(); ROT();
    }
  }
  #define ENDW(tt) do{ if((tt)+3<NT){WAIT_BAR(2);} else if((tt)+2<NT){WAIT_BAR(1);} else {WAIT_BAR(0);} }while(0)
  for(;t+1<NT;t+=2){
    STEP(pB0,pB1,pA0,pA1,t,(t+3<NT),(t+1<NT),(t+1<NT));       ENDW(t);   RESC(); ROT();
    STEP(pA0,pA1,pB0,pB1,t+1,(t+4<NT),(t+2<NT),(t+2<NT));     ENDW(t+1); RESC(); ROT();
  }
  STEP(pB0,pB1,pA0,pA1,NT-1,false,false,false); RESC();
  { float sacc=pB0[0]+pB0[1]; _Pragma("unroll") for(int r=2;r<16;++r)sacc+=pB0[r]; _Pragma("unroll") for(int r=0;r<16;++r)sacc+=pB1[r]; l_reg+=sacc;
    pw0=(u32x4){PKW(pB0,0),PKW(pB0,2),PKW(pB0,4),PKW(pB0,6)};pw1=(u32x4){PKW(pB0,8),PKW(pB0,10),PKW(pB0,12),PKW(pB0,14)};pw2=(u32x4){PKW(pB1,0),PKW(pB1,2),PKW(pB1,4),PKW(pB1,6)};pw3=(u32x4){PKW(pB1,8),PKW(pB1,10),PKW(pB1,12),PKW(pB1,14)};
    SBAR(); pv(o,vb0+sl_cur,PAF(0),PAF(1),PAF(2),PAF(3)); }
  #undef PKW
  #undef PAF
  #undef VFR
  #undef PIN
  #undef MX3
  #undef GAPA
  #undef GAPB
  #undef EX
  #undef VRD
  #undef KRD
  #undef STEP
  #undef ENDW
  {auto rr=__builtin_amdgcn_permlane32_swap(__float_as_uint(l_reg),__float_as_uint(l_reg),false,false);l_reg=__uint_as_float(rr[0])+__uint_as_float(rr[1]);}
  if(TYPE==2) l_reg+=__builtin_amdgcn_exp2f(sinkl[hq]*L2E-mhat);
  if(hi==0)wsf[32+r32]=l_reg;asm volatile("s_waitcnt lgkmcnt(0)":::"memory");
  float rli[16];
  #pragma unroll
  for(int r=0;r<16;++r)rli[r]=__builtin_amdgcn_rcpf(wsf[32+crow(r,hi)]);
  { float*stg=(float*)(shm+LDS_OST)+wid*(32*OSTR);
    #pragma unroll
    for(int r=0;r<16;++r){const int orow=crow(r,hi);
      #pragma unroll
      for(int d0=0;d0<2;++d0)stg[orow*OSTR+d0*32+r32]=o[d0][r]*rli[r];}
    asm volatile("s_waitcnt lgkmcnt(0)":::"memory");
    #pragma unroll
    for(int i=0;i<4;++i){const int row=i*8+(lane>>3),ch=lane&7;
      const f32x4 a=*(const f32x4*)(stg+row*OSTR+ch*8), b=*(const f32x4*)(stg+row*OSTR+ch*8+4);
      const u32x4 g=*(const u32x4*)(P+(qrow+row)*PITCH+GCOL+ucol+ch*8);
      u32x4 w;
      w.x=cvtpk_s(a[0]*__uint_as_float(g.x<<16),a[1]*__uint_as_float(g.x&0xffff0000u)); w.y=cvtpk_s(a[2]*__uint_as_float(g.y<<16),a[3]*__uint_as_float(g.y&0xffff0000u));
      w.z=cvtpk_s(b[0]*__uint_as_float(g.z<<16),b[1]*__uint_as_float(g.z&0xffff0000u)); w.w=cvtpk_s(b[2]*__uint_as_float(g.w<<16),b[3]*__uint_as_float(g.w&0xffff0000u));
      *(u32x4*)(U+(qrow+row)*UPITCH+ucol+ch*8)=w; } }
  asm volatile("s_waitcnt lgkmcnt(0)\n\ts_barrier":::"memory");
  #undef TROW
  #undef DMA_K
  #undef DMA_V
  #undef AMASK
  #undef START
  #undef NEGM
  #undef RESC
  #undef ROT
}
constexpr int THRL_DEFAULT=8;
__device__ __forceinline__ Unit unit_A(int ua){ Unit u; const int b=ua>>8,h=(ua>>5)&7,qb=ua&31; u.type=0; u.nt=132; u.nlat=128; u.ctx0=16384+256*b; u.lat0=8192*b; u.first=0;
  u.kcol=512+64*(h>>2); u.vcol=640+64*(h>>2); u.qrow0=8192*b+256*qb; u.tq0=256*qb; u.h0=h; u.gqa=0; return u; }
__device__ __forceinline__ Unit unit_B(int ub){ Unit u; const int b=ub>>8,h=(ub>>5)&7,qb=ub&31; u.type=1;
  int f=4*qb-4; f=f<0?0:(f>120?120:f); int l=4*qb+3-4; l=l<0?0:(l>120?120:l); l+=7;
  u.first=f; u.nlat=l-f+1; u.nt=(4+u.nlat+1)&~1; u.ctx0=16384+256*b; u.lat0=8192*b+64*f;
  u.kcol=1280+64*h; u.vcol=1792+64*h; u.qrow0=8192*b+256*qb; u.tq0=256*qb; u.h0=h; u.gqa=0; return u; }
__device__ __forceinline__ Unit unit_C(int uc){ Unit u; const int b=uc>>8,kvh=(uc>>7)&1,qb=uc&127; u.type=2;
  const int f=qb-2<0?0:qb-2, l=qb+2>127?127:qb+2;
  u.first=f; u.nlat=l-f+1; u.nt=(4+u.nlat+1)&~1; u.ctx0=16384+256*b; u.lat0=8192*b+64*f;
  u.kcol=2816+64*kvh; u.vcol=2944+64*kvh; u.qrow0=8192*b+64*qb; u.tq0=64*qb; u.h0=4*kvh; u.gqa=1; return u; }
__device__ __forceinline__ Unit unit_ctx(int ux){ Unit u; const int type=ux>>4,b=(ux>>3)&1,h=ux&7; u.type=type; u.nt=4; u.nlat=0; u.ctx0=16384+256*b; u.lat0=0; u.first=0;
  const int kvh=(type==1)?h:(h>>2); u.kcol=(type==0?512:type==1?1280:2816)+64*kvh; u.vcol=(type==0?640:type==1?1792:2944)+64*kvh;
  u.qrow0=16384+256*b; u.tq0=0; u.h0=h; u.gqa=0; return u; }
__device__ __forceinline__ void run_unit(const Unit&u,const bf16*P,bf16*U,const float*rpbl,const float*sinkl,char*lds,const int wid,const bool nomaxA){
  if(u.type==0){ if(nomaxA) attn_unit<0,THRL_DEFAULT,true>(u,P,U,rpbl,sinkl,lds,wid); else attn_unit<0,THRL_DEFAULT,false>(u,P,U,rpbl,sinkl,lds,wid); }
  else if(u.type==1) attn_unit<1,THRL_DEFAULT,false>(u,P,U,rpbl,sinkl,lds,wid);
  else attn_unit<2,THRL_DEFAULT,false>(u,P,U,rpbl,sinkl,lds,wid);
}
__device__ __forceinline__ void attn_phase(int vcu,int G,const bf16*P,bf16*U,const float*rpbl,const float*sinkl,const float*qnl,const float*knl,bool need_ctx,char*lds,const int wid){
  bool nomaxA; { const int l=lane_id_fresh(); float a=fabsf(qnl[l]),b=fabsf(knl[l]);
    _Pragma("unroll") for(int o=1;o<64;o<<=1){ a=fmaxf(a,__shfl_xor(a,o)); b=fmaxf(b,__shfl_xor(b,o)); }
    nomaxA=__builtin_amdgcn_readfirstlane((int)(11.6f*a*b<80.f))!=0; }
  for(int rep=0;rep<((PROBE_REP&16)?2:1);++rep) for(int ua=2*vcu;ua<512;ua+=2*G){ run_unit(unit_A(ua),P,U,rpbl,sinkl,lds,wid,nomaxA); run_unit(unit_A(ua+1),P,U,rpbl,sinkl,lds,wid,nomaxA); }
  for(int rep=0;rep<((PROBE_REP&32)?2:1);++rep) for(int ub=2*vcu;ub<512;ub+=2*G){ run_unit(unit_B(ub),P,U,rpbl,sinkl,lds,wid,nomaxA); run_unit(unit_B(ub+1),P,U,rpbl,sinkl,lds,wid,nomaxA); }
  for(int rep=0;rep<((PROBE_REP&64)?2:1);++rep) for(int uc=2*vcu;uc<512;uc+=2*G){ run_unit(unit_C(uc),P,U,rpbl,sinkl,lds,wid,nomaxA); run_unit(unit_C(uc+1),P,U,rpbl,sinkl,lds,wid,nomaxA); }
  if(need_ctx) for(int ux=vcu;ux<48;ux+=G) run_unit(unit_ctx(ux),P,U,rpbl,sinkl,lds,wid,nomaxA);
}
#undef SBAR
#undef WAIT_BAR
}

__device__ __forceinline__ void phase_final_norm(const Ctx& F0, float* x, const float* w) {
    const Ctx F = fresh(F0);
    const int gw = F.vcu * NWAVES + F.wave, NGW = F.G * NWAVES, lane = F.lane;
    for (int row = gw; row < ML; row += NGW) {
        float* xr = x + (size_t)row * DM;
        f32x4 xv[4]; float ss = 0.f;
#pragma unroll
        for (int j = 0; j < 4; ++j) { xv[j] = *(const f32x4*)(xr + 256 * j + 4 * lane); ss += xv[j][0] * xv[j][0] + xv[j][1] * xv[j][1] + xv[j][2] * xv[j][2] + xv[j][3] * xv[j][3]; }
        const float rstd = rsqrtf(wave_sum(ss) * (1.f / DM) + EPS);
#pragma unroll
        for (int j = 0; j < 4; ++j) { const f32x4 wv = *(const f32x4*)(w + 256 * j + 4 * lane); f32x4 y = xv[j] * rstd * wv; *(f32x4*)(xr + 256 * j + 4 * lane) = y; }
    }
}

__device__ __forceinline__ void ctx_out_proj(const Ctx& F0, const bf16_t* U, const bf16_t* WT, const float* mod, const float* xctx_in, float* xctx_out) {
    const Ctx F = fresh(F0);
    const int lane = F.lane, fr = lane & 15, fq = lane >> 4, w = F.wave;
    LAS float* red = (LAS float*)F.lds;
    for (int it = F.vcu; it < 256; it += F.G) {
        const int row0 = ML + (it >> 4) * 32, col0 = (it & 15) * 64;
        f32x4 acc[2][4];
#pragma unroll
        for (int m = 0; m < 2; ++m)
#pragma unroll
            for (int n = 0; n < 4; ++n) acc[m][n] = (f32x4){0.f, 0.f, 0.f, 0.f};
        const bf16_t* ap = U + (size_t)(row0 + fr) * MIX + w * 192 + 8 * fq;
        const bf16_t* bp = WT + (size_t)(col0 + fr) * MIX + w * 192 + 8 * fq;
#pragma unroll
        for (int k0 = 0; k0 < 192; k0 += 32) {
            bf16x8 a[2], b[4];
#pragma unroll
            for (int m = 0; m < 2; ++m) a[m] = *(const bf16x8*)(ap + (size_t)(16 * m) * MIX + k0);
#pragma unroll
            for (int n = 0; n < 4; ++n) b[n] = *(const bf16x8*)(bp + (size_t)(16 * n) * MIX + k0);
#pragma unroll
            for (int m = 0; m < 2; ++m)
#pragma unroll
                for (int n = 0; n < 4; ++n) acc[m][n] = __builtin_amdgcn_mfma_f32_16x16x32_bf16(a[m], b[n], acc[m][n], 0, 0, 0);
        }
#pragma unroll
        for (int m = 0; m < 2; ++m)
#pragma unroll
            for (int n = 0; n < 4; ++n)
#pragma unroll
                for (int r = 0; r < 4; ++r) red[(w * 32 + 16 * m + 4 * fq + r) * 64 + 16 * n + fr] = acc[m][n][r];
        __syncthreads();
        const float* gate = mod + 2 * 3072 + 2048;
#pragma unroll
        for (int j = 0; j < 4; ++j) {
            const int idx = F.tid + 512 * j, row = idx >> 6, col = idx & 63;
            float s = 0.f;
#pragma unroll
            for (int ww = 0; ww < 8; ++ww) s += red[(ww * 32 + row) * 64 + col];
            const size_t o = (size_t)(row0 - ML + row) * DM + col0 + col;
            xctx_out[o] = xctx_in[o] + gate[col0 + col] * s;
        }
        __syncthreads();
    }
}

struct Args { const float* in[14]; float* out; unsigned char* ws; int ph_lo, ph_hi; };
__global__ void __launch_bounds__(NTHREADS, 2) fwd_kernel(Args args) {
    extern __shared__ __attribute__((aligned(16))) unsigned char lds[];
    Ctx F;
    F.lds = (LAS unsigned char*)lds;
    F.wave = __builtin_amdgcn_readfirstlane((int)threadIdx.x >> 6); F.lane = lane_id_fresh(); F.tid = F.wave * 64 + F.lane;
    F.G = gridDim.x; { const int bx = blockIdx.x; F.vcu = (F.G % 8 == 0) ? (bx % 8) * (F.G / 8) + bx / 8 : bx; }
    volatile LAS unsigned* MISC = (volatile LAS unsigned*)(F.lds + MISC_OFF);
    for (int u = F.tid; u < (LDS_BYTES - LDSCTL_OFF) / 4; u += NTHREADS) ((LAS unsigned*)(F.lds + LDSCTL_OFF))[u] = 0u;
    __syncthreads();
    unsigned char* ws = args.ws;
    unsigned* ctl = (unsigned*)(ws + WS_CTL);
    XcdBarrier bar; bar.bar = ctl + CW_BAR; bar.x = 0; bar.st = nullptr;
    if (!MK_PER_PHASE) bar = xcd_barrier_post(ctl + CW_BAR, MISC + 8);
    const float* x = args.in[0]; const float* c = args.in[1]; const float* ctxin = args.in[2]; const float* c_ctx = args.in[3];
    const float* norm_w = args.in[4]; const float* ada_w = args.in[5]; const float* ada_b = args.in[6];
    const float* w_in = args.in[7]; const float* w_out = args.in[8]; const float* qn = args.in[9]; const float* kn = args.in[10];
    const float* rpb = args.in[11]; const float* sink = args.in[12]; const float* fnw = args.in[13];
    float* out = args.out;
    float* tab = (float*)(ws + WS_TAB); float* mod = (float*)(ws + WS_MOD);
    bf16_t* wtin = (bf16_t*)(ws + WS_WTIN); bf16_t* wtout = (bf16_t*)(ws + WS_WTOUT); float* xctx = (float*)(ws + WS_XCTX);
    bf16_t* HX = (bf16_t*)(ws + WS_HXU); bf16_t* U = (bf16_t*)(ws + WS_HXU); bf16_t* P = (bf16_t*)(ws + WS_P);
    const int lo = args.ph_lo, hi = args.ph_hi;
#define IN(k) (lo <= (k) && (k) < hi)
#define SEAM(k) do { if (IN(k) && IN((k) + 1)) xcd_barrier(bar, F.wave); } while (0)
    if (IN(0)) { phase_prologue(F, w_in, w_out, c, c_ctx, ada_w, ada_b, wtin, wtout, tab, mod); }
    SEAM(0);
#pragma unroll 1
    for (int l = 0; l < 2; ++l) {
        const float* xl = l == 0 ? x : out; const float* xc = l == 0 ? ctxin : xctx;
        const float* modl = mod + (size_t)l * 3 * 3072;
        const int pb = 1 + 4 * l;
        if (IN(pb)) { phase_norm_mod(F, xl, xc, norm_w + l * DM, modl, HX); if (PROBE_REP & 4) phase_norm_mod(F, xl, xc, norm_w + l * DM, modl, HX); }
        SEAM(pb);
        if (IN(pb + 1)) { pg8::Gemm g{HX, wtin + (size_t)l * NIN * DM, MT, NIN, DM}; pg8::StaticOrder S; S.init(MT, NIN, F.G, (int)blockIdx.x);
            pg8::EpiIn E{P, qn + l * 64, kn + l * 64, tab};
            pg8::gemm_phase<pg8::EpiIn, pg8::StaticOrder, true, true>(F.lds, g, S, E, F.wave);
            if (PROBE_REP & 2) pg8::gemm_phase<pg8::EpiIn, pg8::StaticOrder, true, true>(F.lds, g, S, E, F.wave); }
        SEAM(pb + 1);
        if (IN(pb + 2)) { att::attn_phase(F.vcu, F.G, P, U, rpb + (size_t)l * 8 * 465, sink + l * 8, qn + l * 64, kn + l * 64, l == 0, (char*)lds, F.wave);
            if (PROBE_REP & 1) att::attn_phase(F.vcu, F.G, P, U, rpb + (size_t)l * 8 * 465, sink + l * 8, qn + l * 64, kn + l * 64, l == 0, (char*)lds, F.wave); }
        SEAM(pb + 2);
        if (IN(pb + 3)) { if (l == 0) ctx_out_proj(F, U, wtout, modl, xc, xctx);
            const int mrows = ML; pg8::Gemm g{U, wtout + (size_t)l * DM * MIX, mrows, DM, MIX}; pg8::StaticOrder S; S.init(mrows, DM, F.G, (int)blockIdx.x);
            pg8::EpiOut E{modl, xl, xc, out, xctx};
            pg8::gemm_phase<pg8::EpiOut, pg8::StaticOrder, true, true>(F.lds, g, S, E, F.wave);
            if ((PROBE_REP & 8) && l == 0) pg8::gemm_phase<pg8::EpiOut, pg8::StaticOrder, true, true>(F.lds, g, S, E, F.wave); }
        SEAM(pb + 3);
    }
    if (IN(9)) phase_final_norm(F, out, fnw);
#undef IN
#undef SEAM
}

extern "C" void kernel_launch(void* const* d_in, const int* in_sizes, int n_in, void* d_out, int out_size, void* d_ws, size_t ws_size, hipStream_t stream) {
    static int grid = 0;
    if (grid == 0) {
        int dev = 0, cus = 0, per_cu = 0;
        if (n_in != 14 || ws_size < WS_END) { fprintf(stderr, "kernel_launch: unexpected inputs / workspace\n"); grid = -1; return; }
        if (hipGetDevice(&dev) != hipSuccess || hipDeviceGetAttribute(&cus, hipDeviceAttributeMultiprocessorCount, dev) != hipSuccess) { grid = -1; return; }
        if (hipFuncSetAttribute((const void*)fwd_kernel, hipFuncAttributeMaxDynamicSharedMemorySize, LDS_BYTES) != hipSuccess) { fprintf(stderr, "kernel_launch: hipFuncSetAttribute failed\n"); grid = -1; return; }
        if (hipOccupancyMaxActiveBlocksPerMultiprocessor(&per_cu, (const void*)fwd_kernel, NTHREADS, LDS_BYTES) != hipSuccess || per_cu < 1) { fprintf(stderr, "kernel_launch: occupancy query says %d\n", per_cu); }
        (void)hipGetLastError();
        grid = cus;
    }
    if (grid < 0) return;
    (void)hipMemsetAsync((char*)d_ws + WS_CTL, 0, CTL_ZERO_BYTES, stream);
    Args a{};
    for (int i = 0; i < 14; ++i) a.in[i] = (const float*)d_in[i];
    a.out = (float*)d_out; a.ws = (unsigned char*)d_ws;
#if MK_PER_PHASE
    for (int p = 0; p < NPHASES; ++p) { a.ph_lo = p; a.ph_hi = p + 1; hipLaunchKernelGGL(fwd_kernel, dim3(grid), dim3(NTHREADS), LDS_BYTES, stream, a); }
#else
    a.ph_lo = 0; a.ph_hi = NPHASES;
    hipLaunchKernelGGL(fwd_kernel, dim3(grid), dim3(NTHREADS), LDS_BYTES, stream, a);
#endif
}
```

```cpp
#include <hip/hip_runtime.h>
#include <cstdint>
#include <cstdio>

typedef unsigned short bf16_t;
typedef short bf16x8 __attribute__((ext_vector_type(8)));
typedef float f32x4 __attribute__((ext_vector_type(4)));
typedef unsigned u32x4 __attribute__((ext_vector_type(4)));
#define GAS __attribute__((address_space(1)))
#define LAS __attribute__((address_space(3)))

constexpr int DM = 1024, NB = 2, SEQ = 8192, CTX = 256;
constexpr int ML = NB * SEQ;
constexpr int MT = ML + NB * CTX;
constexpr int NIN = 4608, MIX = 1536;
constexpr int C_QA = 0, C_KA = 512, C_VA = 640, C_QB = 768, C_KB = 1280, C_VB = 1792, C_QC = 2304, C_KC = 2816, C_VC = 2944, C_G = 3072;
constexpr float LOG2E = 1.4426950408889634f;
constexpr float QSCALE = 0.125f * LOG2E;
constexpr float EPS = 1e-6f;
constexpr int NWAVES = 8, NTHREADS = 512;
#ifndef MK_PER_PHASE
#define MK_PER_PHASE 0
#endif
#ifndef PROBE_REP
#define PROBE_REP 0
#endif
constexpr int NPHASES = 10;

constexpr size_t MiB = 1u << 20;
constexpr size_t WS_CTL = 0, CTL_ZERO_BYTES = 1 * MiB;
constexpr size_t WS_MOD = 65536;
constexpr size_t WS_TAB = 1 * MiB;
constexpr size_t WS_WTIN = 4 * MiB;
constexpr size_t WS_WTOUT = 22 * MiB;
constexpr size_t WS_XCTX = 28 * MiB;
constexpr size_t WS_HXU = 32 * MiB;
constexpr size_t WS_P = 82 * MiB;
constexpr size_t WS_END = WS_P + (size_t)MT * NIN * 2;
static_assert(WS_END <= 256 * MiB, "ws map");
constexpr int CW_BAR = 4096;
constexpr int RING_BYTES = 131072, LDSCTL_OFF = RING_BYTES, MISC_OFF = LDSCTL_OFF + 320, LDS_BYTES = 147456;

__device__ __forceinline__ unsigned f2bf(float f) { unsigned u = __builtin_bit_cast(unsigned, f); return (u + 0x7fffu + ((u >> 16) & 1u)) >> 16; }
__device__ __forceinline__ float bf2f(unsigned h) { return __builtin_bit_cast(float, h << 16); }
__device__ __forceinline__ unsigned pk2(float lo, float hi) { return f2bf(lo) | (f2bf(hi) << 16); }
__device__ __forceinline__ float silu_f(float v) { return v / (1.f + __expf(-v)); }
template <int M> __device__ __forceinline__ float swz_xor(float v) { return __builtin_bit_cast(float, __builtin_amdgcn_ds_swizzle(__builtin_bit_cast(int, v), (M << 10) | 0x1f)); }
__device__ __forceinline__ void swap32(float v, float& lo, float& hi) { float a = v, b = v; asm volatile("s_nop 1\n\tv_permlane32_swap_b32 %0, %1" : "+v"(a), "+v"(b)); lo = a; hi = b; }
__device__ __forceinline__ float half_sum(float v) { float a, b; swap32(v, a, b); return a + b; }
__device__ __forceinline__ float half_max(float v) { float a, b; swap32(v, a, b); return fmaxf(a, b); }
__device__ __forceinline__ float wave_sum(float v) {
    v += swz_xor<1>(v); v += swz_xor<2>(v); v += swz_xor<4>(v); v += swz_xor<8>(v); v += swz_xor<16>(v);
    return half_sum(v);
}
__device__ __forceinline__ float wave_max(float v) {
    v = fmaxf(v, swz_xor<1>(v)); v = fmaxf(v, swz_xor<2>(v)); v = fmaxf(v, swz_xor<4>(v)); v = fmaxf(v, swz_xor<8>(v)); v = fmaxf(v, swz_xor<16>(v));
    return half_max(v);
}
#define LDS_WAIT() asm volatile("s_waitcnt lgkmcnt(0)" ::: "memory")
__device__ __forceinline__ int lane_id_fresh() { int l; asm volatile("v_mbcnt_lo_u32_b32 %0, -1, 0\n\tv_mbcnt_hi_u32_b32 %0, -1, %0" : "=v"(l)); return l; }

#define XB_TMO      128
#define XB_XCNT(j)  (256  + 64 * (j))
#define XB_XSUB(j)  (1280 + 64 * (j))
#define XB_XGEN(j)  (2304 + 64 * (j))
#define XB_TOP      3328
#define XB_TOPGEN   3392
#define XCD_BAR_WORDS 3456
#define XB_SPIN_CAP (1u << 18)
__device__ __forceinline__ unsigned xb_ld(unsigned* p)              { return __hip_atomic_load(p, __ATOMIC_RELAXED, __HIP_MEMORY_SCOPE_AGENT); }
__device__ __forceinline__ unsigned xb_add(unsigned* p, unsigned v) { return __hip_atomic_fetch_add(p, v, __ATOMIC_RELAXED, __HIP_MEMORY_SCOPE_AGENT); }
__device__ __forceinline__ unsigned xb_xcc_id() { return (unsigned)__builtin_amdgcn_s_getreg((3 << 11) | 20) & 0xFu; }
#define XB_SPIN(cond, bar) do { unsigned _sp = 0; while (cond) { __builtin_amdgcn_s_sleep(1); \
    if ((++_sp & 255u) == 0u) { if (xb_ld(&(bar)[XB_TMO])) break; if (_sp > XB_SPIN_CAP) { atomicAdd(&(bar)[XB_TMO], 1u); break; } } } } while (0)
struct XcdBarrier { unsigned* bar; unsigned x; volatile LAS unsigned* st; };
__device__ __forceinline__ XcdBarrier xcd_barrier_post(unsigned* bar, volatile LAS unsigned* st) {
    XcdBarrier b; b.bar = bar; b.x = xb_xcc_id(); b.st = st;
    if (threadIdx.x == 0) (void)xb_add(&bar[XB_XCNT(b.x)], 1u);
    return b;
}
__device__ __forceinline__ void xcd_barrier_complete(unsigned* bar, unsigned x, unsigned& nloc, unsigned& nx) {
    const unsigned G = gridDim.x * gridDim.y * gridDim.z;
    unsigned sum, cnt, mine, sp = 0u;
    for (;;) {
        sum = 0u; cnt = 0u; mine = 0u;
#pragma unroll
        for (unsigned j = 0; j < 16; ++j) { const unsigned c = xb_ld(&bar[XB_XCNT(j)]); sum += c; cnt += (c > 0u) ? 1u : 0u; mine = (j == x) ? c : mine; }
        if (sum == G) break;
        __builtin_amdgcn_s_sleep(1);
        if ((++sp & 255u) == 0u) { if (xb_ld(&bar[XB_TMO])) break; if (sp > XB_SPIN_CAP) { atomicAdd(&bar[XB_TMO], 1u); break; } }
    }
    nloc = mine > 0u ? mine : 1u; nx = cnt > 0u ? cnt : 1u;
}
__device__ __forceinline__ void xcd_barrier(const XcdBarrier& b, const int wave) {
    asm volatile("s_waitcnt vmcnt(0)" ::: "memory");
    __syncthreads();
    if (wave == 0 && lane_id_fresh() == 0) {
        unsigned* bar = b.bar; asm volatile("" : "+s"(bar));
        __builtin_amdgcn_s_waitcnt(0);
        unsigned nloc = b.st[0], nx = b.st[1];
        if (nloc == 0u) { xcd_barrier_complete(bar, b.x, nloc, nx); b.st[0] = nloc; b.st[1] = nx; }
        const unsigned old = xb_add(&bar[XB_XSUB(b.x)], 1u);
        const unsigned gen = old / nloc;
        if (old + 1u == (gen + 1u) * nloc) {
            __builtin_amdgcn_fence(__ATOMIC_RELEASE, "agent");
            asm volatile("s_waitcnt vmcnt(0)" ::: "memory");
            const unsigned og = xb_add(&bar[XB_TOP], 1u);
            const unsigned tg = og / nx;
            if (og + 1u == (tg + 1u) * nx) xb_add(&bar[XB_TOPGEN], 1u);
            else XB_SPIN(xb_ld(&bar[XB_TOPGEN]) == tg, bar);
            __builtin_amdgcn_fence(__ATOMIC_ACQUIRE, "agent");
            xb_add(&bar[XB_XGEN(b.x)], 1u);
            asm volatile("s_waitcnt vmcnt(0)" ::: "memory");
        } else {
            XB_SPIN(xb_ld(&bar[XB_XGEN(b.x)]) == gen, bar);
            __builtin_amdgcn_fence(__ATOMIC_ACQUIRE, "agent");
            asm volatile("s_waitcnt vmcnt(0)" ::: "memory");
        }
    }
    __syncthreads();
}

namespace pg8 {
#define PG8_LAS __attribute__((address_space(3)))
typedef unsigned short bf16_t;
typedef short bf16x8 __attribute__((ext_vector_type(8)));
typedef float f32x4 __attribute__((ext_vector_type(4)));
typedef unsigned u32x4 __attribute__((ext_vector_type(4)));
constexpr int BM = 256, BK = 64, HALF = 128, HTB = HALF * BK * 2  , STAGE_BYTES = 8 * HTB, NXCD = 8, WGM = 8;

__host__ __device__ __forceinline__ int lds_byte(int r, int c) { const int st = (r >> 4) * 2 + (c >> 5), rr = r & 15, cc = c & 31, ob = rr * 64 + cc * 2; return st * 1024 + (ob ^ (((ob >> 9) & 1) << 5)); }
__host__ __device__ __forceinline__ void stage_rc(int b, int& R, int& C) { const int st = b / 1024, sb = b % 1024, swz = sb ^ (((sb >> 9) & 1) << 5); R = (st >> 1) * 16 + swz / 64; C = (st & 1) * 32 + (swz % 64) / 2; }
__host__ __device__ __forceinline__ int perm32(int rho) { const int n = rho >> 4, i = rho & 15; return 8 * (i >> 2) + 4 * n + (i & 3); }

struct Unit { int pm, pn; };
struct Gemm { const bf16_t* A; const bf16_t* Bt; int M, N, K; };

struct StaticOrder {
    int nM, nN, nwg, G, c;
    __host__ __device__ void init(int M, int N, int G_, int c_) { nM = M / BM; nN = N / BM; nwg = nM * nN; G = G_; c = c_; }
    __host__ __device__ bool next(int i, Unit& u) const {
        const long L = (long)i * G + c; if (L >= nwg) return false;
        int wgid = (int)L; { const int q = nwg / NXCD, r = nwg % NXCD, xcd = wgid % NXCD, off = wgid / NXCD; wgid = (xcd < r ? xcd * (q + 1) : r * (q + 1) + (xcd - r) * q) + off; }
        const int nig = WGM * nN, gid = wgid / nig, fm = gid * WGM, gsz = (nM - fm) < WGM ? (nM - fm) : WGM;
        u.pm = fm + ((wgid % nig) % gsz); u.pn = (wgid % nig) / gsz; return true;
    }
    __device__ __forceinline__ void a_ready(const Unit&) const {}
    __device__ __forceinline__ void done(const Unit&) const {}
};
__device__ __forceinline__ unsigned cvt_pk_bf16(float lo, float hi) { unsigned r; asm volatile("v_cvt_pk_bf16_f32 %0, %1, %2" : "=v"(r) : "v"(lo), "v"(hi)); return r; }
typedef float f32x2 __attribute__((ext_vector_type(2)));
struct EpiIn {
    static constexpr bool PERM = true, AFTER_DRAIN = false;
    bf16_t* P; const float* qn; const float* kn; const float* tab;
    __device__ __forceinline__ void operator()(const f32x4 (&acc)[2][2][4][2], const Unit& u, int wr, int wc, int fr, int fq) const {
        const int col0 = u.pn * BM + wc * 64;
        int kind;
        if (col0 < 512) kind = 1; else if (col0 < 640) kind = 2; else if (col0 < 768) kind = 0; else if (col0 < 1280) kind = 3; else if (col0 < 2304) kind = 0;
        else if (col0 < 2816) kind = 4; else if (col0 < 2944) kind = 5; else if (col0 < 3072) kind = 0; else kind = 6;
        kind = __builtin_amdgcn_readfirstlane(kind);
        const bool latent = u.pm < 64;
        const bool do_norm = kind == 1 || kind == 2, do_rope = (kind == 1 || kind == 2 || kind == 4 || kind == 5) && latent, do_scale = kind == 1 || kind == 3 || kind == 4;
        f32x4 wlo[2], whi[2];
        if (do_norm) { const float* w = kind == 1 ? qn : kn;
#pragma unroll
            for (int n = 0; n < 2; ++n) { wlo[n] = *(const f32x4*)(w + 8 * fq + 4 * n); whi[n] = *(const f32x4*)(w + 32 + 8 * fq + 4 * n); } }
#pragma unroll
        for (int ai = 0; ai < 2; ++ai)
#pragma unroll
            for (int m = 0; m < 4; ++m) {
                const int row = u.pm * BM + ai * HALF + wr * 64 + m * 16 + fr;
                f32x4 lo[2], hi[2];
#pragma unroll
                for (int n = 0; n < 2; ++n) { lo[n] = acc[ai][0][m][n]; hi[n] = acc[ai][1][m][n]; }
                if (do_norm) {
                    float ss = 0.f;
#pragma unroll
                    for (int n = 0; n < 2; ++n)
#pragma unroll
                        for (int j = 0; j < 4; ++j) ss += lo[n][j] * lo[n][j] + hi[n][j] * hi[n][j];
                    ss += swz_xor<16>(ss); ss = half_sum(ss);
                    const float rstd = rsqrtf(ss * (1.f / 64.f) + 1e-6f);
#pragma unroll
                    for (int n = 0; n < 2; ++n) { lo[n] = lo[n] * rstd * wlo[n]; hi[n] = hi[n] * rstd * whi[n]; }
                }
                if (do_rope) {
                    const int pr = (4 * u.pm + 2 * ai + wr) & 127, pc = 16 * m + fr;
                    const int pos = fq < 2 ? pr : pc;
                    const float* tp = tab + (pos * 16 + 8 * (fq & 1)) * 2;
#pragma unroll
                    for (int n = 0; n < 2; ++n) {
                        const f32x4 t0 = *(const f32x4*)(tp + 8 * n), t1 = *(const f32x4*)(tp + 8 * n + 4);
                        const float cs[4] = {t0[0], t0[2], t1[0], t1[2]}, sn[4] = {t0[1], t0[3], t1[1], t1[3]};
#pragma unroll
                        for (int j = 0; j < 4; ++j) { const float a = lo[n][j], b = hi[n][j]; lo[n][j] = a * cs[j] - b * sn[j]; hi[n][j] = a * sn[j] + b * cs[j]; }
                    }
                }
                if (do_scale) {
#pragma unroll
                    for (int n = 0; n < 2; ++n) { lo[n] = lo[n] * (0.125f * 1.4426950408889634f); hi[n] = hi[n] * (0.125f * 1.4426950408889634f); }
                }
                if (kind == 6) {
#pragma unroll
                    for (int n = 0; n < 2; ++n)
#pragma unroll
                        for (int j = 0; j < 4; ++j) { lo[n][j] = lo[n][j] / (1.f + __expf(-lo[n][j])); hi[n][j] = hi[n][j] / (1.f + __expf(-hi[n][j])); }
                }
                bf16_t* rowp = P + (size_t)row * 4608 + col0 + 8 * fq;
                u32x4 w0, w1;
                w0.x = cvt_pk_bf16(lo[0][0], lo[0][1]); w0.y = cvt_pk_bf16(lo[0][2], lo[0][3]); w0.z = cvt_pk_bf16(lo[1][0], lo[1][1]); w0.w = cvt_pk_bf16(lo[1][2], lo[1][3]);
                w1.x = cvt_pk_bf16(hi[0][0], hi[0][1]); w1.y = cvt_pk_bf16(hi[0][2], hi[0][3]); w1.z = cvt_pk_bf16(hi[1][0], hi[1][1]); w1.w = cvt_pk_bf16(hi[1][2], hi[1][3]);
                *(u32x4*)rowp = w0; *(u32x4*)(rowp + 32) = w1;
            }
    }
};
struct EpiOut {
    static constexpr bool PERM = false, AFTER_DRAIN = false;
    const float* mod; const float* xlat_in; const float* xctx_in; float* xlat_out; float* xctx_out;
    __device__ __forceinline__ void operator()(const f32x4 (&acc)[2][2][4][2], const Unit& u, int wr, int wc, int fr, int fq) const {
        const bool latent = u.pm < 64;
        const int v = latent ? (u.pm >> 5) : 2;
        const float* gate = mod + (size_t)v * 3072 + 2048;
        const float* xin = latent ? xlat_in : xctx_in - (size_t)16384 * 1024;
        float* xout = latent ? xlat_out : xctx_out - (size_t)16384 * 1024;
        const int col0 = u.pn * BM + wc * 32 + 4 * fq;
        f32x4 g[2][2];
#pragma unroll
        for (int bj = 0; bj < 2; ++bj)
#pragma unroll
            for (int n = 0; n < 2; ++n) g[bj][n] = *(const f32x4*)(gate + col0 + bj * HALF + n * 16);
#pragma unroll
        for (int ai = 0; ai < 2; ++ai)
#pragma unroll
            for (int m = 0; m < 4; ++m) { const size_t off = (size_t)(u.pm * BM + ai * HALF + wr * 64 + m * 16 + fr) * 1024 + col0;
#pragma unroll
                for (int bj = 0; bj < 2; ++bj)
#pragma unroll
                    for (int n = 0; n < 2; ++n) { const f32x4 xo = *(const f32x4*)(xin + off + bj * HALF + n * 16); *(f32x4*)(xout + off + bj * HALF + n * 16) = xo + g[bj][n] * acc[ai][bj][m][n]; }
            }
    }
};
template <class Epi, class Sched, bool ALIGN_EPI = false, bool SP2 = false>
__device__ __forceinline__ void gemm_phase(PG8_LAS unsigned char* lds, const Gemm g, const Sched& S, const Epi& E, const int wid  ) {
    int lane; asm volatile("v_mbcnt_lo_u32_b32 %0, -1, 0\n\tv_mbcnt_hi_u32_b32 %0, -1, %0" : "=v"(lane));
    const int tid = wid * 64 + lane, wr = wid >> 2, wc = wid & 3, fr = lane & 15, fq = lane >> 4;
    const int K = g.K, nt = K / BK;
    unsigned voffA[2], voffB[2];
#pragma unroll
    for (int i = 0; i < 2; ++i) { int R, C; stage_rc(tid * 16 + i * 8192, R, C); const int Rb = Epi::PERM ? ((R & ~31) + perm32(R & 31)) : R;
        voffA[i] = (unsigned)(R * K + C) * 2u; voffB[i] = (unsigned)(Rb * K + C) * 2u; }
    const size_t kstep = (size_t)(BK * 2);
    const size_t hstep = (size_t)HALF * K * 2;
    const size_t tstep = 2 * hstep;
    const unsigned ldsw = (unsigned)wid * 1024u;
    const int aoff = lds_byte(wr * 64 + fr, fq * 8), boff = lds_byte(wc * 32 + fr, fq * 8);
#define PG8_SA(b, h) (((b) * 2 + (h)) * HTB)
#define PG8_SB(b, h) ((4 + (b) * 2 + (h)) * HTB)
#define PG8_STAGE(bufoff, gbase, voff) do { _Pragma("unroll") for (int _i = 0; _i < 2; ++_i) \
        __builtin_amdgcn_global_load_lds((const unsigned*)((const char*)(gbase) + (voff)[_i]), (PG8_LAS unsigned*)(lds + (bufoff) + ldsw + _i * 8192), 16, 0, 0); } while (0)
#define PG8_LDA(dst, b, h) do { _Pragma("unroll") for (int m = 0; m < 4; ++m) _Pragma("unroll") for (int k = 0; k < 2; ++k) dst[m][k] = *(const PG8_LAS bf16x8*)(lds + PG8_SA(b, h) + aoff + m * 2048 + k * 1024); } while (0)
#define PG8_LDB(dst, b, h) do { _Pragma("unroll") for (int n = 0; n < 2; ++n) _Pragma("unroll") for (int k = 0; k < 2; ++k) dst[n][k] = *(const PG8_LAS bf16x8*)(lds + PG8_SB(b, h) + boff + n * 2048 + k * 1024); } while (0)
#define PG8_MMA(ai, bj, At, Bt) do { __builtin_amdgcn_s_setprio(1); _Pragma("unroll") for (int m = 0; m < 4; ++m) _Pragma("unroll") for (int n = 0; n < 2; ++n) _Pragma("unroll") for (int k = 0; k < 2; ++k) \
        acc[ai][bj][m][n] = __builtin_amdgcn_mfma_f32_16x16x32_bf16(Bt[n][k], At[m][k], acc[ai][bj][m][n], 0, 0, 0); __builtin_amdgcn_s_setprio(0); } while (0)
#define PG8_WAIT_V(n) asm volatile("s_waitcnt vmcnt(" #n ")" ::: "memory")
#define PG8_WAIT_L(n) asm volatile("s_waitcnt lgkmcnt(" #n ")" ::: "memory")
#define PG8_BAR __builtin_amdgcn_s_barrier()
#define PG8_SCHED __builtin_amdgcn_sched_barrier(0)
    Unit cur, nxt; int ui = 0;
    if (!S.next(0, cur)) return;
    f32x4 acc[2][2][4][2];
#pragma unroll
    for (int a = 0; a < 2; ++a)
#pragma unroll
        for (int b = 0; b < 2; ++b)
#pragma unroll
            for (int m = 0; m < 4; ++m)
#pragma unroll
                for (int n = 0; n < 2; ++n) acc[a][b][m][n] = (f32x4){0.f, 0.f, 0.f, 0.f};
    bf16x8 At[4][2], B0[2][2], B1[2][2];
    const char* cA = (const char*)g.A + (size_t)cur.pm * tstep; const char* cB = (const char*)g.Bt + (size_t)cur.pn * tstep;
    S.a_ready(cur);
    if constexpr (SP2) {
        PG8_STAGE(PG8_SB(0, 0), cB, voffB); PG8_STAGE(PG8_SB(0, 1), cB + hstep, voffB); PG8_STAGE(PG8_SA(0, 0), cA, voffA); PG8_STAGE(PG8_SA(0, 1), cA + hstep, voffA);
        if (wr == 1) PG8_BAR;
        PG8_WAIT_V(2); PG8_BAR;
        PG8_STAGE(PG8_SB(1, 0), cB + kstep, voffB); PG8_STAGE(PG8_SA(1, 0), cA + kstep, voffA); PG8_STAGE(PG8_SB(1, 1), cB + hstep + kstep, voffB);
        PG8_WAIT_V(6); PG8_BAR;
    } else {
        PG8_STAGE(PG8_SB(0, 0), cB, voffB); PG8_STAGE(PG8_SA(0, 0), cA, voffA); PG8_STAGE(PG8_SB(0, 1), cB + hstep, voffB); PG8_STAGE(PG8_SA(0, 1), cA + hstep, voffA);
        if (wr == 1) PG8_BAR;
        PG8_WAIT_V(4); PG8_BAR;
        PG8_STAGE(PG8_SB(1, 0), cB + kstep, voffB); PG8_STAGE(PG8_SA(1, 0), cA + kstep, voffA); PG8_STAGE(PG8_SB(1, 1), cB + hstep + kstep, voffB);
        PG8_WAIT_V(6); PG8_BAR;
    }
    for (;;) {
        const bool has_next = S.next(ui + 1, nxt);
        const char* nA = has_next ? (const char*)g.A + (size_t)nxt.pm * tstep : cA; const char* nB = has_next ? (const char*)g.Bt + (size_t)nxt.pn * tstep : cB;
        for (int t = 0; t < nt; t += 2) {
            const bool last = (t == nt - 2);
            const char* a1 = cA + (size_t)(t + 1) * kstep;
            const char* a2 = last ? nA : cA + (size_t)(t + 2) * kstep; const char* b2 = last ? nB : cB + (size_t)(t + 2) * kstep;
            const char* a3 = a2 + kstep; const char* b3 = b2 + kstep;
            if (last && has_next) S.a_ready(nxt);
            if constexpr (SP2) {
            PG8_LDB(B0, 0, 0); PG8_LDB(B1, 0, 1); PG8_SCHED; PG8_LDA(At, 0, 0); PG8_STAGE(PG8_SA(1, 1), a1 + hstep, voffA);
            PG8_WAIT_V(8); PG8_WAIT_L(0); PG8_BAR; PG8_MMA(0, 0, At, B0); PG8_MMA(0, 1, At, B1); PG8_BAR; PG8_SCHED;
            PG8_LDA(At, 0, 1); PG8_STAGE(PG8_SB(0, 0), b2, voffB); PG8_STAGE(PG8_SB(0, 1), b2 + hstep, voffB); PG8_STAGE(PG8_SA(0, 0), a2, voffA);
            PG8_WAIT_V(8); PG8_WAIT_L(0); PG8_BAR; PG8_MMA(1, 0, At, B0); PG8_MMA(1, 1, At, B1); PG8_BAR; PG8_SCHED;
            PG8_LDB(B0, 1, 0); PG8_LDB(B1, 1, 1); PG8_SCHED; PG8_LDA(At, 1, 0); PG8_STAGE(PG8_SA(0, 1), a2 + hstep, voffA);
            PG8_WAIT_V(8); PG8_WAIT_L(0); PG8_BAR; PG8_MMA(0, 0, At, B0); PG8_MMA(0, 1, At, B1); PG8_BAR; PG8_SCHED;
            PG8_LDA(At, 1, 1); PG8_STAGE(PG8_SB(1, 0), b3, voffB); PG8_STAGE(PG8_SB(1, 1), b3 + hstep, voffB); PG8_STAGE(PG8_SA(1, 0), a3, voffA);
            PG8_WAIT_V(8); PG8_WAIT_L(0); PG8_BAR; PG8_MMA(1, 0, At, B0); PG8_MMA(1, 1, At, B1); PG8_BAR; PG8_SCHED;
            } else {
            PG8_LDB(B0, 0, 0); PG8_SCHED; PG8_LDA(At, 0, 0); PG8_STAGE(PG8_SA(1, 1), a1 + hstep, voffA);
            PG8_WAIT_L(8); PG8_BAR; PG8_WAIT_L(0); PG8_MMA(0, 0, At, B0); PG8_BAR; PG8_SCHED;
            PG8_LDB(B1, 0, 1); PG8_STAGE(PG8_SB(0, 0), b2, voffB);
            PG8_BAR; PG8_WAIT_L(0); PG8_MMA(0, 1, At, B1); PG8_BAR;
            PG8_LDA(At, 0, 1); PG8_STAGE(PG8_SA(0, 0), a2, voffA);
            PG8_BAR; PG8_WAIT_L(0); PG8_MMA(1, 0, At, B0); PG8_BAR; PG8_SCHED;
            PG8_STAGE(PG8_SB(0, 1), b2 + hstep, voffB);
            PG8_WAIT_V(6); PG8_BAR; PG8_MMA(1, 1, At, B1); PG8_BAR;
            PG8_LDB(B0, 1, 0); PG8_SCHED; PG8_LDA(At, 1, 0); PG8_STAGE(PG8_SA(0, 1), a2 + hstep, voffA);
            PG8_WAIT_L(8); PG8_BAR; PG8_WAIT_L(0); PG8_MMA(0, 0, At, B0); PG8_BAR; PG8_SCHED;
            PG8_LDB(B1, 1, 1); PG8_STAGE(PG8_SB(1, 0), b3, voffB);
            PG8_BAR; PG8_WAIT_L(0); PG8_MMA(0, 1, At, B1); PG8_BAR;
            PG8_LDA(At, 1, 1); PG8_STAGE(PG8_SA(1, 0), a3, voffA);
            PG8_BAR; PG8_WAIT_L(0); PG8_MMA(1, 0, At, B0); PG8_BAR; PG8_SCHED;
            PG8_STAGE(PG8_SB(1, 1), b3 + hstep, voffB);
            PG8_WAIT_V(6); PG8_BAR; PG8_MMA(1, 1, At, B1); PG8_BAR;
            }
        }
        if constexpr (ALIGN_EPI) { if (wr == 0) PG8_BAR; }
        if constexpr (!Epi::AFTER_DRAIN) { E(acc, cur, wr, wc, fr, fq); S.done(cur); }
        if (!has_next) break;
#pragma unroll
        for (int a = 0; a < 2; ++a)
#pragma unroll
            for (int b = 0; b < 2; ++b)
#pragma unroll
                for (int m = 0; m < 4; ++m)
#pragma unroll
                    for (int n = 0; n < 2; ++n) acc[a][b][m][n] = (f32x4){0.f, 0.f, 0.f, 0.f};
        cur = nxt; cA = nA; cB = nB; ++ui;
        if constexpr (ALIGN_EPI) { if (wr == 1) PG8_BAR; }
    }
    PG8_WAIT_V(0);
    if constexpr (!ALIGN_EPI) { if (wr == 0) PG8_BAR; }
    PG8_BAR;
    if constexpr (Epi::AFTER_DRAIN) { E.fused(acc, cur, wr, wc, fr, fq, lds, wid, lane); S.done(cur); }
#undef PG8_SA
#undef PG8_SB
#undef PG8_STAGE
#undef PG8_LDA
#undef PG8_LDB
#undef PG8_MMA
#undef PG8_WAIT_V
#undef PG8_WAIT_L
#undef PG8_BAR
#undef PG8_SCHED
}
}

struct Ctx {
    LAS unsigned char* lds; int tid, lane, wave, vcu, G;
};
__device__ __forceinline__ Ctx fresh(const Ctx& F0) { Ctx F = F0; const int l = lane_id_fresh(); F.lane = l; F.tid = F0.wave * 64 + l; return F; }

template <bool PERMUTE>
__device__ __forceinline__ void p0_transpose_item(const float* W, int K, int N, bf16_t* WT, LAS float* scr, int item, int lane) {
    const int nblk = N / 32, kb = item / nblk, nb = item % nblk, k0 = 64 * kb, n0 = 32 * nb;
    const int r0 = PERMUTE ? ((n0 & ~255) + 128 * ((n0 >> 5) & 1) + 32 * ((n0 >> 6) & 3)) : n0;
#pragma unroll 8
    for (int i = 0; i < 32; ++i) { const int kk = 2 * i + (lane >> 5); scr[kk * 33 + (lane & 31)] = W[(size_t)(k0 + kk) * N + n0 + (lane & 31)]; }
    LDS_WAIT(); asm volatile("" ::: "memory");
    const int c = lane & 7;
#pragma unroll
    for (int j = 0; j < 4; ++j) { const int n = (lane >> 3) + 8 * j; const LAS float* s = scr + (8 * c) * 33 + n;
        u32x4 o; o.x = pk2(s[0 * 33], s[1 * 33]); o.y = pk2(s[2 * 33], s[3 * 33]); o.z = pk2(s[4 * 33], s[5 * 33]); o.w = pk2(s[6 * 33], s[7 * 33]);
        *(u32x4*)(WT + (size_t)(r0 + n) * K + k0 + 8 * c) = o; }
    LDS_WAIT(); asm volatile("" ::: "memory");
}

__device__ __forceinline__ void phase_prologue(const Ctx& F0, const float* w_in, const float* w_out, const float* c, const float* c_ctx, const float* ada_w, const float* ada_b,
                                               bf16_t* wtin, bf16_t* wtout, float* tab, float* mod) {
    const Ctx F = fresh(F0);
    LAS float* scr = (LAS float*)(F.lds + F.wave * 16384);
    const int gw = F.vcu * NWAVES + F.wave, NGW = F.G * NWAVES;
    constexpr int I_IN = (DM / 64) * (NIN / 32), I_OUT = (MIX / 64) * (DM / 32), NITEMS = 2 * (I_IN + I_OUT);
    for (int it = gw; it < NITEMS; it += NGW) {
        int r = it;
        if (r < I_IN) { p0_transpose_item<true>(w_in, DM, NIN, wtin, scr, r, F.lane); continue; } r -= I_IN;
        if (r < I_IN) { p0_transpose_item<true>(w_in + (size_t)DM * NIN, DM, NIN, wtin + (size_t)NIN * DM, scr, r, F.lane); continue; } r -= I_IN;
        if (r < I_OUT) { p0_transpose_item<false>(w_out, MIX, DM, wtout, scr, r, F.lane); continue; } r -= I_OUT;
        p0_transpose_item<false>(w_out + (size_t)MIX * DM, MIX, DM, wtout + (size_t)DM * MIX, scr, r, F.lane);
    }
    { const int idx = F.vcu * NTHREADS + F.tid;
      if (idx < 128 * 16) { const int pos = idx >> 4, i = idx & 15; const float freq = powf(10000.f, -(float)i / 16.f); const float ang = (float)pos * freq; tab[idx * 2] = cosf(ang); tab[idx * 2 + 1] = sinf(ang); } }
    { const int wk = F.vcu * 2 + (F.tid >> 8), NWK = F.G * 2, t = F.tid & 255;
      for (int it = wk; it < 2 * 16 * 12; it += NWK) {
          const int nb = it % 12, kc = (it / 12) % 16, l = it / 192; const int n = nb * 256 + t;
          float a0 = 0.f, a1 = 0.f, a2 = 0.f;
          const float* w = ada_w + ((size_t)l * DM + kc * 64) * 3072 + n;
#pragma unroll 8
          for (int k = 0; k < 64; ++k) { const float wv = w[(size_t)k * 3072]; const int kk = kc * 64 + k;
              a0 += silu_f(c[kk]) * wv; a1 += silu_f(c[DM + kk]) * wv; a2 += silu_f(c_ctx[kk]) * wv; }
          if (kc == 0) { const float bb = ada_b[l * 3072 + n]; a0 += bb; a1 += bb; a2 += bb; }
          float* p = mod + (size_t)l * 3 * 3072 + n;
          atomicAdd(p, a0); atomicAdd(p + 3072, a1); atomicAdd(p + 2 * 3072, a2);
      } }
}

__device__ __forceinline__ void phase_norm_mod(const Ctx& F0, const float* xlat, const float* xctx, const float* nw, const float* mod, bf16_t* HX) {
    const Ctx F = fresh(F0);
    const int gw = F.vcu * NWAVES + F.wave, NGW = F.G * NWAVES, lane = F.lane;
    for (int row = gw; row < MT; row += NGW) {
        const int v = row < ML ? row / SEQ : 2;
        const float* xr = row < ML ? xlat + (size_t)row * DM : xctx + (size_t)(row - ML) * DM;
        f32x4 xv[4]; float ss = 0.f;
#pragma unroll
        for (int j = 0; j < 4; ++j) { xv[j] = *(const f32x4*)(xr + 256 * j + 4 * lane); ss += xv[j][0] * xv[j][0] + xv[j][1] * xv[j][1] + xv[j][2] * xv[j][2] + xv[j][3] * xv[j][3]; }
        const float rstd = rsqrtf(wave_sum(ss) * (1.f / DM) + EPS);
        const float* shift = mod + (size_t)v * 3072; const float* scale = shift + 1024;
#pragma unroll
        for (int j = 0; j < 4; ++j) {
            const int k = 256 * j + 4 * lane;
            const f32x4 w = *(const f32x4*)(nw + k), sc = *(const f32x4*)(scale + k), sh = *(const f32x4*)(shift + k);
            float y[4];
#pragma unroll
            for (int e = 0; e < 4; ++e) y[e] = xv[j][e] * rstd * w[e] * (1.f + sc[e]) + sh[e];
            uint2 o; o.x = pk2(y[0], y[1]); o.y = pk2(y[2], y[3]);
            *(uint2*)(HX + (size_t)row * DM + k) = o;
        }
    }
}

namespace att {
typedef unsigned short bf16;
using bf16x8=__attribute__((ext_vector_type(8)))short;
using s16x4=__attribute__((ext_vector_type(4)))short;
using f32x16=__attribute__((ext_vector_type(16)))float;
using f32x4=__attribute__((ext_vector_type(4)))float;
using u32x4=__attribute__((ext_vector_type(4)))unsigned;
constexpr int PITCH=4608, UPITCH=1536, GCOL=3072;
constexpr int NW=8,QBLK=32,KVBLK=64;
constexpr int NSLOT=3, SLOTB=8192, OSTR=68  ;
constexpr int LDS_K=0, LDS_V=NSLOT*SLOTB, LDS_WS=2*NSLOT*SLOTB, LDS_OST=LDS_WS+NW*64*4, LDS_BYTES=LDS_OST+NW*32*OSTR*4;
constexpr int LDS_BETA=LDS_BYTES  , LDS_T=LDS_BETA+15*128*4  , LDS_TABLES_END=LDS_T+512;
static_assert(LDS_TABLES_END<=131072,"attention LDS map");
constexpr float L2E=1.4426950408889634f;
struct Unit {
  int type;
  int nt;
  int nlat;
  int ctx0, lat0;
  int first;
  int kcol, vcol;
  int qrow0, tq0;
  int h0, gqa;
};
__device__ __forceinline__ int crow(int r,int hi){return (r&3)+8*(r>>2)+4*hi;}
#define SBAR() __builtin_amdgcn_sched_barrier(0)
__device__ __forceinline__ void glds16(const void*gsrc,unsigned lds_dst){unsigned keep;
  asm volatile("s_mov_b32 %0, m0\n\ts_mov_b32 m0, %2\n\ts_nop 0\n\tglobal_load_lds_dwordx4 %1, off\n\ts_mov_b32 m0, %0":"=&s"(keep):"v"(gsrc),"s"(lds_dst):"memory");}
__device__ __forceinline__ float max3f(float a,float b,float c){float r;asm("v_max3_f32 %0, %1, %2, %3":"=v"(r):"v"(a),"v"(b),"v"(c));return r;}
__device__ __forceinline__ float max2f(float a,float b){float r;asm("v_max_f32_e32 %0, %1, %2":"=v"(r):"v"(a),"v"(b));return r;}
__device__ __forceinline__ float fadd_s(float a,float b){float r;asm("v_add_f32_e32 %0, %1, %2":"=v"(r):"v"(a),"v"(b));return r;}
__device__ __forceinline__ float fsub_s(float a,float b){float r;asm("v_sub_f32_e32 %0, %1, %2":"=v"(r):"v"(a),"v"(b));return r;}
typedef float f32x2_t __attribute__((ext_vector_type(2))); typedef __bf16 bf16x2_t __attribute__((ext_vector_type(2)));
__device__ __forceinline__ unsigned cvtpk_s(float lo,float hi){f32x2_t v={lo,hi};bf16x2_t b=__builtin_convertvector(v,bf16x2_t);return __builtin_bit_cast(unsigned,b);}
#define WAIT_BAR(N) asm volatile("s_waitcnt vmcnt(" #N ") lgkmcnt(0)\n\ts_barrier":::"memory")
__device__ __forceinline__ void qkt(f32x16&p0,f32x16&p1,const char*Kslot,const bf16x8*qr,const f32x16&negm,int r32,int hi){
  const char*kb=Kslot+hi*1024+r32*16;
  #pragma unroll
  for(int d0=0;d0<4;++d0){
    const bf16x8 b0=*reinterpret_cast<const bf16x8*>(kb+d0*2048);
    const bf16x8 b1=*reinterpret_cast<const bf16x8*>(kb+d0*2048+512);
    if(d0==0){p0=__builtin_amdgcn_mfma_f32_32x32x16_bf16(b0,qr[0],negm,0,0,0);p1=__builtin_amdgcn_mfma_f32_32x32x16_bf16(b1,qr[0],negm,0,0,0);}
    else{p0=__builtin_amdgcn_mfma_f32_32x32x16_bf16(b0,qr[d0],p0,0,0,0);p1=__builtin_amdgcn_mfma_f32_32x32x16_bf16(b1,qr[d0],p1,0,0,0);}}
}
typedef __attribute__((address_space(3))) const char* lds_cptr;
typedef short v4i16_t __attribute__((ext_vector_type(4)));
__device__ __forceinline__ void kload8(bf16x8*kf,lds_cptr kp){
  kf[0]=*(const __attribute__((address_space(3))) bf16x8*)(kp);      kf[1]=*(const __attribute__((address_space(3))) bf16x8*)(kp+512);
  kf[2]=*(const __attribute__((address_space(3))) bf16x8*)(kp+2048); kf[3]=*(const __attribute__((address_space(3))) bf16x8*)(kp+2560);
  kf[4]=*(const __attribute__((address_space(3))) bf16x8*)(kp+4096); kf[5]=*(const __attribute__((address_space(3))) bf16x8*)(kp+4608);
  kf[6]=*(const __attribute__((address_space(3))) bf16x8*)(kp+6144); kf[7]=*(const __attribute__((address_space(3))) bf16x8*)(kp+6656);
}
__device__ __forceinline__ void kload2(bf16x8*kf,lds_cptr kp,int j){ kf[2*j]=*(const __attribute__((address_space(3))) bf16x8*)(kp+j*2048); kf[2*j+1]=*(const __attribute__((address_space(3))) bf16x8*)(kp+j*2048+512); }
__device__ __forceinline__ s16x4 vtr(lds_cptr p){ return __builtin_bit_cast(s16x4,__builtin_amdgcn_ds_read_tr16_b64_v4i16((__attribute__((address_space(3))) v4i16_t*)p)); }
__device__ __forceinline__ float rowmax(const f32x16&p0,const f32x16&p1){
  float a=max3f(p0[0],p0[1],p1[0]),b=max3f(p0[2],p0[3],p1[1]);a=max3f(a,p1[2],p1[3]);
  #pragma unroll
  for(int r=4;r<16;r+=4){a=max3f(a,p0[r],p0[r+1]);b=max3f(b,p0[r+2],p0[r+3]);a=max3f(a,p1[r],p1[r+1]);b=max3f(b,p1[r+2],p1[r+3]);}
  const float m=max2f(a,b);
  float ma,mb; swap32(m,ma,mb); return max2f(ma,mb);
}
__device__ __forceinline__ void pv(f32x16*o,int vb,bf16x8 pa0,bf16x8 pa1,bf16x8 pa2,bf16x8 pa3){
  #pragma unroll
  for(int d0=0;d0<2;++d0){s16x4 lo[4],hi[4];
    #pragma unroll
    for(int ks=0;ks<4;++ks){
      asm volatile("ds_read_b64_tr_b16 %0,%1 offset:%c2":"=&v"(lo[ks]):"v"(vb),"i"(d0*4096+ks*1024):"memory");
      asm volatile("ds_read_b64_tr_b16 %0,%1 offset:%c2":"=&v"(hi[ks]):"v"(vb),"i"(d0*4096+ks*1024+512):"memory");}
    asm volatile("s_waitcnt lgkmcnt(0)":::"memory");SBAR();
    #define PK(k) (bf16x8){lo[k][0],lo[k][1],lo[k][2],lo[k][3],hi[k][0],hi[k][1],hi[k][2],hi[k][3]}
    o[d0]=__builtin_amdgcn_mfma_f32_32x32x16_bf16(pa0,PK(0),o[d0],0,0,0);
    o[d0]=__builtin_amdgcn_mfma_f32_32x32x16_bf16(pa1,PK(1),o[d0],0,0,0);
    o[d0]=__builtin_amdgcn_mfma_f32_32x32x16_bf16(pa2,PK(2),o[d0],0,0,0);
    o[d0]=__builtin_amdgcn_mfma_f32_32x32x16_bf16(pa3,PK(3),o[d0],0,0,0);
    #undef PK
  }
}
template<int TYPE> __device__ __forceinline__ void amask(f32x16&c0,f32x16&c1,int li,int nlat,int mA,int mB,int u0,int u1,const char*shm){
  const float NEG=-INFINITY;
  bool dead = li>=nlat;
  if(TYPE==1) dead = dead || (unsigned)(li-u0)>=8u;
  if(TYPE==2&&!dead){ const int d=64*li-u0; if(d>=-97&&d<=65) return; }
  if(dead){
    #pragma unroll
    for(int r=0;r<16;++r){c0[r]=NEG;c1[r]=NEG;}
    return; }
  if(TYPE==1){
    const float*brow=(const float*)(shm+LDS_BETA)+(li-u1+7)*128+mB;
    const float*trow=(const float*)(shm+LDS_T)+mA;
    #pragma unroll
    for(int r=0;r<16;++r){ const int kk0=(r&3)+8*(r>>2); c0[r]+=brow[kk0]+trow[kk0]; c1[r]+=brow[kk0+32]+trow[kk0+32]; }
  } else {
    const int base=mA+64*li;
    #pragma unroll
    for(int r=0;r<16;++r){ const int kk0=(r&3)+8*(r>>2);
      if((unsigned)(kk0+base)>256u)c0[r]=NEG; if((unsigned)(kk0+32+base)>256u)c1[r]=NEG; }
  }
}

template<int TYPE,int THRL,bool NOMAX> __device__ __forceinline__ void attn_unit(const Unit&ud,const bf16*__restrict__ P,bf16*__restrict__ U,const float*rpbl,const float*sinkl,char*shm,const int wid){
  int lane; asm volatile("v_mbcnt_lo_u32_b32 %0, -1, 0\n\tv_mbcnt_hi_u32_b32 %0, -1, %0":"=v"(lane));
  const int tid=wid*64+lane,r32=lane&31,hi=lane>>5;
  const int hq=ud.gqa?ud.h0+(wid&3):ud.h0, qoff=ud.gqa?32*(wid>>2):32*wid;
  const int qcol=(TYPE==0?0:TYPE==1?768:2304)+hq*64, ucol=TYPE*512+hq*64;
  const long qrow=ud.qrow0+qoff;
  const bf16*Qw=P+qrow*PITCH+qcol;
  const unsigned lds0=(unsigned)(uintptr_t)shm;
  float*wsf=(float*)(shm+LDS_WS)+wid*64;
  const bf16*ksrc=P+(long)lane*PITCH+ud.kcol+wid*8;
  const bf16*vsrc=P+(long)(16*(wid&3)+(lane>>2))*PITCH+ud.vcol+(wid>>2)*32+(lane&3)*8;
  const unsigned kdst=lds0+LDS_K+wid*1024, vdst=lds0+LDS_V+wid*1024;
  const int NT=ud.nt, nlat=ud.nlat;
  #define TROW(t) ((long)(((t)<4)?(ud.ctx0+64*(t)):(ud.lat0+64*((((t)-4)<nlat)?((t)-4):(nlat-1)))))
  #define DMA_K(t,slot) glds16(ksrc+TROW(t)*PITCH,(unsigned)__builtin_amdgcn_readfirstlane(kdst+(slot)))
  #define DMA_V(t,slot) glds16(vsrc+TROW(t)*PITCH,(unsigned)__builtin_amdgcn_readfirstlane(vdst+(slot)))
  const int vb0=(int)(lds0+LDS_V)+((lane>>4)&1)*32+(lane&3)*8+(4*hi+((lane&15)>>2))*64;
  const char*Kbase=shm+LDS_K; bf16x8 kf[8];
  const lds_cptr shm3=(lds_cptr)shm; const lds_cptr kp0=shm3+LDS_K+hi*1024+r32*16; const lds_cptr vp0=shm3+LDS_V+((lane>>4)&1)*32+(lane&3)*8+(4*hi+((lane&15)>>2))*64;
  int mA=0,mB=0,u0=0,u1=0;
  if(TYPE==1){ const int tqw=ud.tq0+qoff, qg=tqw>>6, qc=(tqw&63)+r32; int rs=qg-4; rs=rs<0?0:(rs>120?120:rs);
    int cs=qc-8; cs=cs<0?0:(cs>48?48:cs); mA=48-cs+4*hi; mB=63-qc+4*hi; u0=rs-ud.first; u1=qg-ud.first;
    float*btw=(float*)(shm+LDS_BETA); for(int i=tid;i<15*128;i+=512){ const int d=i>>7, ti=(i&127)-48; btw[i]=(ti>=0&&ti<=30)?rpbl[hq*465+d*31+ti]*L2E:0.f; } }
  if(TYPE==2){ const int tq=ud.tq0+qoff+r32; mA=4*hi-(tq-64*ud.first)+128; u0=ud.tq0+qoff-64*ud.first; }
  DMA_K(0,0);DMA_V(0,0);DMA_K(1,SLOTB);
  bf16x8 qr[4];
  #pragma unroll
  for(int d0=0;d0<4;++d0)qr[d0]=*reinterpret_cast<const bf16x8*>(&Qw[(long)r32*PITCH+d0*16+hi*8]);
  constexpr bool UNEG=(TYPE==0)&&!NOMAX;
  float mhat=0.f,l_reg=0.f;f32x16 o[2],negm; { float z=0.f; asm volatile("":"+v"(z));
    _Pragma("unroll") for(int r=0;r<16;++r){o[0][r]=z;o[1][r]=z;negm[r]=z;} }
  if(UNEG)asm volatile("":"+v"(negm));
  #define NEGM (UNEG?negm:(f32x16){})
  #define AMASK(P0,P1,t) do{ if(TYPE!=0){ if((t)>=4) amask<TYPE>(P0,P1,(t)-4,nlat,mA,mB,u0,u1,shm); _Pragma("unroll") for(int r=0;r<16;++r){P0[r]-=mhat;P1[r]-=mhat;} } }while(0)
  bool resc=false;
  #define START(P0,P1) do{ resc=false; if(!NOMAX){ const float rm=rowmax(P0,P1); \
    { const float dl=rm; mhat=fadd_s(mhat,dl); \
      _Pragma("unroll") for(int r=0;r<16;++r){P0[r]=fsub_s(P0[r],dl);P1[r]=fsub_s(P1[r],dl);} \
      if(UNEG){ _Pragma("unroll") for(int r=0;r<16;++r)negm[r]=-mhat; asm volatile("":"+v"(negm)); } } } \
    _Pragma("unroll") for(int r=0;r<16;++r)P0[r]=__builtin_amdgcn_exp2f(P0[r]); }while(0)
  #define RESC() do{ if(!NOMAX&&resc){ asm volatile("s_waitcnt lgkmcnt(0)":::"memory"); \
      _Pragma("unroll") for(int d_=0;d_<2;++d_) _Pragma("unroll") for(int r=0;r<16;++r)o[d_][r]*=wsf[crow(r,hi)]; } }while(0)
  f32x16 pA0,pA1,pB0,pB1;
  int sl_prev=0,sl_cur=0,sl_next=SLOTB;
  #define ROT() do{sl_prev=sl_cur;sl_cur=sl_next;sl_next=(sl_next==(NSLOT-1)*SLOTB)?0:sl_next+SLOTB;}while(0)
  DMA_K(2,2*SLOTB);
  WAIT_BAR(3);
  qkt(pA0,pA1,Kbase,qr,NEGM,r32,hi);asm volatile("s_nop 15\n\ts_nop 7":"+v"(pA0),"+v"(pA1));
  START(pA0,pA1);
  _Pragma("unroll") for(int r=0;r<16;++r)pA1[r]=__builtin_amdgcn_exp2f(pA1[r]);
  WAIT_BAR(0);
  DMA_K(3,0);DMA_V(1,SLOTB);
  ROT();
  kload8(kf,kp0+sl_cur);
  WAIT_BAR(2);
  s16x4 vlo[8],vhi[8]; u32x4 pw0,pw1,pw2,pw3;
  #define PKW(P,B) cvtpk_s(P[B],P[B+1])
  #define PAF(k) __builtin_bit_cast(bf16x8,pw##k)
  #define VFR(i) (bf16x8){vlo[i][0],vlo[i][1],vlo[i][2],vlo[i][3],vhi[i][0],vhi[i][1],vhi[i][2],vhi[i][3]}
  #define PIN(x) asm volatile("":"+v"(x))
  #define MX3(a,b,c) __builtin_fmaxf(__builtin_fmaxf((a),(b)),(c))
  #define GAPA(MF,A0,A1,A2,A3,W0,W1,PW) do{ MF; sacc+=A0; sacc+=A1; sacc+=A2; sacc+=A3; PIN(sacc); W0; W1; PIN(PW); SBAR(); }while(0)
  #define EX(v) __builtin_amdgcn_exp2f(v)
  #define GAPB(MF,X,B) do{ MF; X[B]=EX(X[B]); X[B+1]=EX(X[B+1]); X[B+2]=EX(X[B+2]); X[B+3]=EX(X[B+3]); PIN(X); SBAR(); }while(0)
  #define VRD(i) do{ vlo[i]=vtr(vp_+(((i)>>2)*4096+((i)&3)*1024)); vhi[i]=vtr(vp_+(((i)>>2)*4096+((i)&3)*1024+512)); }while(0)
  #define KRD(G,j) do{ if(G){ kload2(kf,kp0+sl_next,j); SBAR(); } }while(0)
  #define STEP(C0,C1,P0,P1,t,GK,GV,GL) do{ SBAR(); \
    const lds_cptr vp_=vp0+sl_prev; \
    VRD(0); SBAR(); float sacc=(P0[0]+P0[1]); \
    GAPA(C0=__builtin_amdgcn_mfma_f32_32x32x16_bf16(kf[0],qr[0],NEGM,0,0,0), P0[2],P0[3],P0[4],P0[5],     pw0[0]=PKW(P0,0), pw0[1]=PKW(P0,2), pw0); \
    VRD(4); SBAR(); GAPA(C1=__builtin_amdgcn_mfma_f32_32x32x16_bf16(kf[1],qr[0],NEGM,0,0,0), P0[6],P0[7],P0[8],P0[9],     pw0[2]=PKW(P0,4), pw0[3]=PKW(P0,6), pw0); \
    VRD(1); SBAR(); GAPA(C0=__builtin_amdgcn_mfma_f32_32x32x16_bf16(kf[2],qr[1],C0,0,0,0),   P0[10],P0[11],P0[12],P0[13], pw1[0]=PKW(P0,8), pw1[1]=PKW(P0,10), pw1); \
    VRD(5); SBAR(); GAPA(C1=__builtin_amdgcn_mfma_f32_32x32x16_bf16(kf[3],qr[1],C1,0,0,0),   P0[14],P0[15],P1[0],P1[1],   pw1[2]=PKW(P0,12),pw1[3]=PKW(P0,14), pw1); \
    VRD(2); SBAR(); GAPA(C0=__builtin_amdgcn_mfma_f32_32x32x16_bf16(kf[4],qr[2],C0,0,0,0),   P1[2],P1[3],P1[4],P1[5],     pw2[0]=PKW(P1,0), pw2[1]=PKW(P1,2), pw2); \
    VRD(6); SBAR(); GAPA(C1=__builtin_amdgcn_mfma_f32_32x32x16_bf16(kf[5],qr[2],C1,0,0,0),   P1[6],P1[7],P1[8],P1[9],     pw2[2]=PKW(P1,4), pw2[3]=PKW(P1,6), pw2); \
    VRD(3); SBAR(); GAPA(C0=__builtin_amdgcn_mfma_f32_32x32x16_bf16(kf[6],qr[3],C0,0,0,0),   P1[10],P1[11],P1[12],P1[13], pw3[0]=PKW(P1,8), pw3[1]=PKW(P1,10), pw3); \
    VRD(7); SBAR(); GAPA(C1=__builtin_amdgcn_mfma_f32_32x32x16_bf16(kf[7],qr[3],C1,0,0,0),   P1[14],P1[15],0.f,0.f,       pw3[2]=PKW(P1,12),pw3[3]=PKW(P1,14), pw3); \
    l_reg+=sacc; \
    if(GK){DMA_K((t)+3,sl_cur);} if(GV){DMA_V((t)+1,sl_next);} \
    AMASK(C0,C1,t); \
    if(!NOMAX){ float a=MX3(C0[0],C0[1],C1[0]),b=MX3(C0[2],C0[3],C1[1]); a=MX3(a,C1[2],C1[3]); \
      _Pragma("unroll") for(int r=4;r<16;r+=4){a=MX3(a,C0[r],C0[r+1]);b=MX3(b,C0[r+2],C0[r+3]);a=MX3(a,C1[r],C1[r+1]);b=MX3(b,C1[r+2],C1[r+3]);} \
      float rm=__builtin_fmaxf(a,b); { float ma_,mb_; swap32(rm,ma_,mb_); rm=__builtin_fmaxf(ma_,mb_); } \
      resc=false; \
      if(__builtin_expect(__any(rm>(float)THRL),0)){ const float dl=__builtin_fmaxf(rm,0.f); mhat+=dl; \
        _Pragma("unroll") for(int r=0;r<16;++r){C0[r]-=dl;C1[r]-=dl;} \
        if(UNEG){ _Pragma("unroll") for(int r=0;r<16;++r)negm[r]=-mhat; asm volatile("":"+v"(negm)); } \
        const float f=__builtin_amdgcn_exp2f(-dl); l_reg*=f; if(hi==0)wsf[r32]=f; resc=true; } } \
    SBAR(); \
    GAPB(o[0]=__builtin_amdgcn_mfma_f32_32x32x16_bf16(PAF(0),VFR(0),o[0],0,0,0), C0,0); \
    GAPB(o[1]=__builtin_amdgcn_mfma_f32_32x32x16_bf16(PAF(0),VFR(4),o[1],0,0,0), C0,4); \
    KRD(GL,0); GAPB(o[0]=__builtin_amdgcn_mfma_f32_32x32x16_bf16(PAF(1),VFR(1),o[0],0,0,0), C0,8); \
    KRD(GL,1); GAPB(o[1]=__builtin_amdgcn_mfma_f32_32x32x16_bf16(PAF(1),VFR(5),o[1],0,0,0), C0,12); \
    KRD(GL,2); GAPB(o[0]=__builtin_amdgcn_mfma_f32_32x32x16_bf16(PAF(2),VFR(2),o[0],0,0,0), C1,0); \
    KRD(GL,3); GAPB(o[1]=__builtin_amdgcn_mfma_f32_32x32x16_bf16(PAF(2),VFR(6),o[1],0,0,0), C1,4); \
    GAPB(o[0]=__builtin_amdgcn_mfma_f32_32x32x16_bf16(PAF(3),VFR(3),o[0],0,0,0), C1,8); \
    GAPB(o[1]=__builtin_amdgcn_mfma_f32_32x32x16_bf16(PAF(3),VFR(7),o[1],0,0,0), C1,12); \
    }while(0)
  int t=1;
  if(TYPE==0){
    for(;t+5<NT;t+=2){
      STEP(pB0,pB1,pA0,pA1,t,true,true,true);     WAIT_BAR(2); RESC(); ROT();
      STEP(pA0,pA1,pB0,pB1,t+1,true,true,true);   WAIT_BAR(2); RESC(); ROT();
    }
  }
  #define ENDW(tt) do{ if((tt)+3<NT){WAIT_BAR(2);} else if((tt)+2<NT){WAIT_BAR(1);} else {WAIT_BAR(0);} }while(0)
  for(;t+1<NT;t+=2){
    STEP(pB0,pB1,pA0,pA1,t,(t+3<NT),(t+1<NT),(t+1<NT));       ENDW(t);   RESC(); ROT();
    STEP(pA0,pA1,pB0,pB1,t+1,(t+4<NT),(t+2<NT),(t+2<NT));     ENDW(t+1); RESC(); ROT();
  }
  STEP(pB0,pB1,pA0,pA1,NT-1,false,false,false); RESC();
  { float sacc=pB0[0]+pB0[1]; _Pragma("unroll") for(int r=2;r<16;++r)sacc+=pB0[r]; _Pragma("unroll") for(int r=0;r<16;++r)sacc+=pB1[r]; l_reg+=sacc;
    pw0=(u32x4){PKW(pB0,0),PKW(pB0,2),PKW(pB0,4),PKW(pB0,6)};pw1=(u32x4){PKW(pB0,8),PKW(pB0,10),PKW(pB0,12),PKW(pB0,14)};pw2=(u32x4){PKW(pB1,0),PKW(pB1,2),PKW(pB1,4),PKW(pB1,6)};pw3=(u32x4){PKW(pB1,8),PKW(pB1,10),PKW(pB1,12),PKW(pB1,14)};
    SBAR(); pv(o,vb0+sl_cur,PAF(0),PAF(1),PAF(2),PAF(3)); }
  #undef PKW
  #undef PAF
  #undef VFR
  #undef PIN
  #undef MX3
  #undef GAPA
  #undef GAPB
  #undef EX
  #undef VRD
  #undef KRD
  #undef STEP
  #undef ENDW
  { float la,lb; swap32(l_reg,la,lb); l_reg=la+lb; }
  if(TYPE==2) l_reg+=__builtin_amdgcn_exp2f(sinkl[hq]*L2E-mhat);
  if(hi==0)wsf[32+r32]=l_reg;asm volatile("s_waitcnt lgkmcnt(0)":::"memory");
  float rli[16];
  #pragma unroll
  for(int r=0;r<16;++r)rli[r]=__builtin_amdgcn_rcpf(wsf[32+crow(r,hi)]);
  { float*stg=(float*)(shm+LDS_OST)+wid*(32*OSTR);
    #pragma unroll
    for(int r=0;r<16;++r){const int orow=crow(r,hi);
      #pragma unroll
      for(int d0=0;d0<2;++d0)stg[orow*OSTR+d0*32+r32]=o[d0][r]*rli[r];}
    asm volatile("s_waitcnt lgkmcnt(0)":::"memory");
    #pragma unroll
    for(int i=0;i<4;++i){const int row=i*8+(lane>>3),ch=lane&7;
      const f32x4 a=*(const f32x4*)(stg+row*OSTR+ch*8), b=*(const f32x4*)(stg+row*OSTR+ch*8+4);
      const u32x4 g=*(const u32x4*)(P+(qrow+row)*PITCH+GCOL+ucol+ch*8);
      u32x4 w;
      w.x=cvtpk_s(a[0]*__uint_as_float(g.x<<16),a[1]*__uint_as_float(g.x&0xffff0000u)); w.y=cvtpk_s(a[2]*__uint_as_float(g.y<<16),a[3]*__uint_as_float(g.y&0xffff0000u));
      w.z=cvtpk_s(b[0]*__uint_as_float(g.z<<16),b[1]*__uint_as_float(g.z&0xffff0000u)); w.w=cvtpk_s(b[2]*__uint_as_float(g.w<<16),b[3]*__uint_as_float(g.w&0xffff0000u));
      *(u32x4*)(U+(qrow+row)*UPITCH+ucol+ch*8)=w; } }
  asm volatile("s_waitcnt lgkmcnt(0)\n\ts_barrier":::"memory");
  #undef TROW
  #undef DMA_K
  #undef DMA_V
  #undef AMASK
  #undef START
  #undef NEGM
  #undef RESC
  #undef ROT
}
constexpr int THRL_DEFAULT=8;
__device__ __forceinline__ Unit unit_A(int ua){ Unit u; const int b=ua>>8,h=(ua>>5)&7,qb=ua&31; u.type=0; u.nt=132; u.nlat=128; u.ctx0=16384+256*b; u.lat0=8192*b; u.first=0;
  u.kcol=512+64*(h>>2); u.vcol=640+64*(h>>2); u.qrow0=8192*b+256*qb; u.tq0=256*qb; u.h0=h; u.gqa=0; return u; }
__device__ __forceinline__ Unit unit_B(int ub){ Unit u; const int b=ub>>8,h=(ub>>5)&7,qb=ub&31; u.type=1;
  int f=4*qb-4; f=f<0?0:(f>120?120:f); int l=4*qb+3-4; l=l<0?0:(l>120?120:l); l+=7;
  u.first=f; u.nlat=l-f+1; u.nt=(4+u.nlat+1)&~1; u.ctx0=16384+256*b; u.lat0=8192*b+64*f;
  u.kcol=1280+64*h; u.vcol=1792+64*h; u.qrow0=8192*b+256*qb; u.tq0=256*qb; u.h0=h; u.gqa=0; return u; }
__device__ __forceinline__ Unit unit_C(int uc){ Unit u; const int b=uc>>8,kvh=(uc>>7)&1,qb=uc&127; u.type=2;
  const int f=qb-2<0?0:qb-2, l=qb+2>127?127:qb+2;
  u.first=f; u.nlat=l-f+1; u.nt=(4+u.nlat+1)&~1; u.ctx0=16384+256*b; u.lat0=8192*b+64*f;
  u.kcol=2816+64*kvh; u.vcol=2944+64*kvh; u.qrow0=8192*b+64*qb; u.tq0=64*qb; u.h0=4*kvh; u.gqa=1; return u; }
__device__ __forceinline__ Unit unit_ctx(int ux){ Unit u; const int type=ux>>4,b=(ux>>3)&1,h=ux&7; u.type=type; u.nt=4; u.nlat=0; u.ctx0=16384+256*b; u.lat0=0; u.first=0;
  const int kvh=(type==1)?h:(h>>2); u.kcol=(type==0?512:type==1?1280:2816)+64*kvh; u.vcol=(type==0?640:type==1?1792:2944)+64*kvh;
  u.qrow0=16384+256*b; u.tq0=0; u.h0=h; u.gqa=0; return u; }
__device__ __forceinline__ void run_unit(const Unit&u,const bf16*P,bf16*U,const float*rpbl,const float*sinkl,char*lds,const int wid,const bool nomaxA){
  if(u.type==0){ if(nomaxA) attn_unit<0,THRL_DEFAULT,true>(u,P,U,rpbl,sinkl,lds,wid); else attn_unit<0,THRL_DEFAULT,false>(u,P,U,rpbl,sinkl,lds,wid); }
  else if(u.type==1) attn_unit<1,THRL_DEFAULT,false>(u,P,U,rpbl,sinkl,lds,wid);
  else attn_unit<2,THRL_DEFAULT,false>(u,P,U,rpbl,sinkl,lds,wid);
}
__device__ __forceinline__ void attn_phase(int vcu,int G,const bf16*P,bf16*U,const float*rpbl,const float*sinkl,const float*qnl,const float*knl,bool need_ctx,char*lds,const int wid){
  bool nomaxA; { const int l=lane_id_fresh(); float a=fabsf(qnl[l]),b=fabsf(knl[l]);
    a=wave_max(a); b=wave_max(b);
    nomaxA=__builtin_amdgcn_readfirstlane((int)(11.6f*a*b<80.f))!=0;
    float*tt=(float*)(lds+LDS_T); { const int i=wid*64+l; if(i<128){ const int x=i-48; tt[i]=(x>=0&&x<16)?0.f:-INFINITY; } }
    __syncthreads(); }
  for(int rep=0;rep<((PROBE_REP&16)?2:1);++rep) for(int ua=2*vcu;ua<512;ua+=2*G){ run_unit(unit_A(ua),P,U,rpbl,sinkl,lds,wid,nomaxA); run_unit(unit_A(ua+1),P,U,rpbl,sinkl,lds,wid,nomaxA); }
  for(int rep=0;rep<((PROBE_REP&32)?2:1);++rep) for(int ub=2*vcu;ub<512;ub+=2*G){ run_unit(unit_B(ub),P,U,rpbl,sinkl,lds,wid,nomaxA); run_unit(unit_B(ub+1),P,U,rpbl,sinkl,lds,wid,nomaxA); }
  for(int rep=0;rep<((PROBE_REP&64)?2:1);++rep) for(int uc=2*vcu;uc<512;uc+=2*G){ run_unit(unit_C(uc),P,U,rpbl,sinkl,lds,wid,nomaxA); run_unit(unit_C(uc+1),P,U,rpbl,sinkl,lds,wid,nomaxA); }
  if(need_ctx) for(int ux=vcu;ux<48;ux+=G) run_unit(unit_ctx(ux),P,U,rpbl,sinkl,lds,wid,nomaxA);
}
#undef SBAR
#undef WAIT_BAR
}

__device__ __forceinline__ void phase_final_norm(const Ctx& F0, float* x, const float* w) {
    const Ctx F = fresh(F0);
    const int gw = F.vcu * NWAVES + F.wave, NGW = F.G * NWAVES, lane = F.lane;
    for (int row = gw; row < ML; row += NGW) {
        float* xr = x + (size_t)row * DM;
        f32x4 xv[4]; float ss = 0.f;
#pragma unroll
        for (int j = 0; j < 4; ++j) { xv[j] = *(const f32x4*)(xr + 256 * j + 4 * lane); ss += xv[j][0] * xv[j][0] + xv[j][1] * xv[j][1] + xv[j][2] * xv[j][2] + xv[j][3] * xv[j][3]; }
        const float rstd = rsqrtf(wave_sum(ss) * (1.f / DM) + EPS);
#pragma unroll
        for (int j = 0; j < 4; ++j) { const f32x4 wv = *(const f32x4*)(w + 256 * j + 4 * lane); f32x4 y = xv[j] * rstd * wv; *(f32x4*)(xr + 256 * j + 4 * lane) = y; }
    }
}

__device__ __forceinline__ void ctx_out_proj(const Ctx& F0, const bf16_t* U, const bf16_t* WT, const float* mod, const float* xctx_in, float* xctx_out) {
    const Ctx F = fresh(F0);
    const int lane = F.lane, fr = lane & 15, fq = lane >> 4, w = F.wave;
    LAS float* red = (LAS float*)F.lds;
    for (int it = F.vcu; it < 256; it += F.G) {
        const int row0 = ML + (it >> 4) * 32, col0 = (it & 15) * 64;
        f32x4 acc[2][4];
#pragma unroll
        for (int m = 0; m < 2; ++m)
#pragma unroll
            for (int n = 0; n < 4; ++n) acc[m][n] = (f32x4){0.f, 0.f, 0.f, 0.f};
        const bf16_t* ap = U + (size_t)(row0 + fr) * MIX + w * 192 + 8 * fq;
        const bf16_t* bp = WT + (size_t)(col0 + fr) * MIX + w * 192 + 8 * fq;
#pragma unroll
        for (int k0 = 0; k0 < 192; k0 += 32) {
            bf16x8 a[2], b[4];
#pragma unroll
            for (int m = 0; m < 2; ++m) a[m] = *(const bf16x8*)(ap + (size_t)(16 * m) * MIX + k0);
#pragma unroll
            for (int n = 0; n < 4; ++n) b[n] = *(const bf16x8*)(bp + (size_t)(16 * n) * MIX + k0);
#pragma unroll
            for (int m = 0; m < 2; ++m)
#pragma unroll
                for (int n = 0; n < 4; ++n) acc[m][n] = __builtin_amdgcn_mfma_f32_16x16x32_bf16(a[m], b[n], acc[m][n], 0, 0, 0);
        }
#pragma unroll
        for (int m = 0; m < 2; ++m)
#pragma unroll
            for (int n = 0; n < 4; ++n)
#pragma unroll
                for (int r = 0; r < 4; ++r) red[(w * 32 + 16 * m + 4 * fq + r) * 64 + 16 * n + fr] = acc[m][n][r];
        __syncthreads();
        const float* gate = mod + 2 * 3072 + 2048;
#pragma unroll
        for (int j = 0; j < 4; ++j) {
            const int idx = F.tid + 512 * j, row = idx >> 6, col = idx & 63;
            float s = 0.f;
#pragma unroll
            for (int ww = 0; ww < 8; ++ww) s += red[(ww * 32 + row) * 64 + col];
            const size_t o = (size_t)(row0 - ML + row) * DM + col0 + col;
            xctx_out[o] = xctx_in[o] + gate[col0 + col] * s;
        }
        __syncthreads();
    }
}

struct Args { const float* in[14]; float* out; unsigned char* ws; int ph_lo, ph_hi; };
__global__ void __launch_bounds__(NTHREADS, 2) fwd_kernel(Args args) {
    extern __shared__ __attribute__((aligned(16))) unsigned char lds[];
    Ctx F;
    F.lds = (LAS unsigned char*)lds;
    F.wave = __builtin_amdgcn_readfirstlane((int)threadIdx.x >> 6); F.lane = lane_id_fresh(); F.tid = F.wave * 64 + F.lane;
    F.G = gridDim.x; { const int bx = blockIdx.x; F.vcu = (F.G % 8 == 0) ? (bx % 8) * (F.G / 8) + bx / 8 : bx; }
    volatile LAS unsigned* MISC = (volatile LAS unsigned*)(F.lds + MISC_OFF);
    for (int u = F.tid; u < (LDS_BYTES - LDSCTL_OFF) / 4; u += NTHREADS) ((LAS unsigned*)(F.lds + LDSCTL_OFF))[u] = 0u;
    __syncthreads();
    unsigned char* ws = args.ws;
    unsigned* ctl = (unsigned*)(ws + WS_CTL);
    XcdBarrier bar; bar.bar = ctl + CW_BAR; bar.x = 0; bar.st = nullptr;
    if (!MK_PER_PHASE) bar = xcd_barrier_post(ctl + CW_BAR, MISC + 8);
    const float* x = args.in[0]; const float* c = args.in[1]; const float* ctxin = args.in[2]; const float* c_ctx = args.in[3];
    const float* norm_w = args.in[4]; const float* ada_w = args.in[5]; const float* ada_b = args.in[6];
    const float* w_in = args.in[7]; const float* w_out = args.in[8]; const float* qn = args.in[9]; const float* kn = args.in[10];
    const float* rpb = args.in[11]; const float* sink = args.in[12]; const float* fnw = args.in[13];
    float* out = args.out;
    float* tab = (float*)(ws + WS_TAB); float* mod = (float*)(ws + WS_MOD);
    bf16_t* wtin = (bf16_t*)(ws + WS_WTIN); bf16_t* wtout = (bf16_t*)(ws + WS_WTOUT); float* xctx = (float*)(ws + WS_XCTX);
    bf16_t* HX = (bf16_t*)(ws + WS_HXU); bf16_t* U = (bf16_t*)(ws + WS_HXU); bf16_t* P = (bf16_t*)(ws + WS_P);
    const int lo = args.ph_lo, hi = args.ph_hi;
#define IN(k) (lo <= (k) && (k) < hi)
#define SEAM(k) do { if (IN(k) && IN((k) + 1)) xcd_barrier(bar, F.wave); } while (0)
    if (IN(0)) { phase_prologue(F, w_in, w_out, c, c_ctx, ada_w, ada_b, wtin, wtout, tab, mod); }
    SEAM(0);
#pragma unroll 1
    for (int l = 0; l < 2; ++l) {
        const float* xl = l == 0 ? x : out; const float* xc = l == 0 ? ctxin : xctx;
        const float* modl = mod + (size_t)l * 3 * 3072;
        const int pb = 1 + 4 * l;
        if (IN(pb)) { phase_norm_mod(F, xl, xc, norm_w + l * DM, modl, HX); if (PROBE_REP & 4) phase_norm_mod(F, xl, xc, norm_w + l * DM, modl, HX); }
        SEAM(pb);
        if (IN(pb + 1)) { pg8::Gemm g{HX, wtin + (size_t)l * NIN * DM, MT, NIN, DM}; pg8::StaticOrder S; S.init(MT, NIN, F.G, (int)blockIdx.x);
            pg8::EpiIn E{P, qn + l * 64, kn + l * 64, tab};
            pg8::gemm_phase<pg8::EpiIn, pg8::StaticOrder, true, true>(F.lds, g, S, E, F.wave);
            if (PROBE_REP & 2) pg8::gemm_phase<pg8::EpiIn, pg8::StaticOrder, true, true>(F.lds, g, S, E, F.wave); }
        SEAM(pb + 1);
        if (IN(pb + 2)) { att::attn_phase(F.vcu, F.G, P, U, rpb + (size_t)l * 8 * 465, sink + l * 8, qn + l * 64, kn + l * 64, l == 0, (char*)lds, F.wave);
            if (PROBE_REP & 1) att::attn_phase(F.vcu, F.G, P, U, rpb + (size_t)l * 8 * 465, sink + l * 8, qn + l * 64, kn + l * 64, l == 0, (char*)lds, F.wave); }
        SEAM(pb + 2);
        if (IN(pb + 3)) { if (l == 0) ctx_out_proj(F, U, wtout, modl, xc, xctx);
            const int mrows = ML; pg8::Gemm g{U, wtout + (size_t)l * DM * MIX, mrows, DM, MIX}; pg8::StaticOrder S; S.init(mrows, DM, F.G, (int)blockIdx.x);
            pg8::EpiOut E{modl, xl, xc, out, xctx};
            pg8::gemm_phase<pg8::EpiOut, pg8::StaticOrder, true, true>(F.lds, g, S, E, F.wave);
            if ((PROBE_REP & 8) && l == 0) pg8::gemm_phase<pg8::EpiOut, pg8::StaticOrder, true, true>(F.lds, g, S, E, F.wave); }
        SEAM(pb + 3);
    }
    if (IN(9)) phase_final_norm(F, out, fnw);
#undef IN
#undef SEAM
}

extern "C" void kernel_launch(void* const* d_in, const int* in_sizes, int n_in, void* d_out, int out_size, void* d_ws, size_t ws_size, hipStream_t stream) {
    static int grid = 0;
    if (grid == 0) {
        int dev = 0, cus = 0, per_cu = 0;
        if (n_in != 14 || ws_size < WS_END) { fprintf(stderr, "kernel_launch: unexpected inputs / workspace\n"); grid = -1; return; }
        if (hipGetDevice(&dev) != hipSuccess || hipDeviceGetAttribute(&cus, hipDeviceAttributeMultiprocessorCount, dev) != hipSuccess) { grid = -1; return; }
        if (hipFuncSetAttribute((const void*)fwd_kernel, hipFuncAttributeMaxDynamicSharedMemorySize, LDS_BYTES) != hipSuccess) { fprintf(stderr, "kernel_launch: hipFuncSetAttribute failed\n"); grid = -1; return; }
        if (hipOccupancyMaxActiveBlocksPerMultiprocessor(&per_cu, (const void*)fwd_kernel, NTHREADS, LDS_BYTES) != hipSuccess || per_cu < 1) { fprintf(stderr, "kernel_launch: occupancy query says %d\n", per_cu); }
        (void)hipGetLastError();
        grid = cus;
    }
    if (grid < 0) return;
    (void)hipMemsetAsync((char*)d_ws + WS_CTL, 0, CTL_ZERO_BYTES, stream);
    Args a{};
    for (int i = 0; i < 14; ++i) a.in[i] = (const float*)d_in[i];
    a.out = (float*)d_out; a.ws = (unsigned char*)d_ws;
#if MK_PER_PHASE
    for (int p = 0; p < NPHASES; ++p) { a.ph_lo = p; a.ph_hi = p + 1; hipLaunchKernelGGL(fwd_kernel, dim3(grid), dim3(NTHREADS), LDS_BYTES, stream, a); }
#else
    a.ph_lo = 0; a.ph_hi = NPHASES;
    hipLaunchKernelGGL(fwd_kernel, dim3(grid), dim3(NTHREADS), LDS_BYTES, stream, a);
#endif
}
```

```cpp
#include <hip/hip_runtime.h>
#include <cstdint>
#include <cstdio>

typedef unsigned short bf16_t;
typedef short bf16x8 __attribute__((ext_vector_type(8)));
typedef float f32x4 __attribute__((ext_vector_type(4)));
typedef unsigned u32x4 __attribute__((ext_vector_type(4)));
#define GAS __attribute__((address_space(1)))
#define LAS __attribute__((address_space(3)))

constexpr int DM = 1024, NB = 2, SEQ = 8192, CTX = 256;
constexpr int ML = NB * SEQ;
constexpr int MT = ML + NB * CTX;
constexpr int NIN = 4608, MIX = 1536;
constexpr int C_QA = 0, C_KA = 512, C_VA = 640, C_QB = 768, C_KB = 1280, C_VB = 1792, C_QC = 2304, C_KC = 2816, C_VC = 2944, C_G = 3072;
constexpr float LOG2E = 1.4426950408889634f;
constexpr float QSCALE = 0.125f * LOG2E;
constexpr float EPS = 1e-6f;
constexpr int NWAVES = 8, NTHREADS = 512;
#ifndef MK_PER_PHASE
#define MK_PER_PHASE 0
#endif
#ifndef PROBE_REP
#define PROBE_REP 0
#endif
constexpr int NPHASES = 10;

constexpr size_t MiB = 1u << 20;
constexpr size_t WS_CTL = 0, CTL_ZERO_BYTES = 1 * MiB;
constexpr size_t WS_MOD = 65536;
constexpr size_t WS_TAB = 1 * MiB;
constexpr size_t WS_WTIN = 4 * MiB;
constexpr size_t WS_WTOUT = 22 * MiB;
constexpr size_t WS_XCTX = 28 * MiB;
constexpr size_t WS_HXU = 32 * MiB;
constexpr size_t WS_P = 82 * MiB;
constexpr size_t WS_END = WS_P + (size_t)MT * NIN * 2;
static_assert(WS_END <= 256 * MiB, "ws map");
constexpr int CW_BAR = 4096;
constexpr int RING_BYTES = 131072, LDSCTL_OFF = RING_BYTES, MISC_OFF = LDSCTL_OFF + 320, LDS_BYTES = 147456;

__device__ __forceinline__ unsigned f2bf(float f) { unsigned u = __builtin_bit_cast(unsigned, f); return (u + 0x7fffu + ((u >> 16) & 1u)) >> 16; }
__device__ __forceinline__ float bf2f(unsigned h) { return __builtin_bit_cast(float, h << 16); }
__device__ __forceinline__ unsigned pk2(float lo, float hi) { return f2bf(lo) | (f2bf(hi) << 16); }
__device__ __forceinline__ float silu_f(float v) { return v / (1.f + __expf(-v)); }
template <int M> __device__ __forceinline__ float swz_xor(float v) { return __builtin_bit_cast(float, __builtin_amdgcn_ds_swizzle(__builtin_bit_cast(int, v), (M << 10) | 0x1f)); }
__device__ __forceinline__ void swap32(float v, float& lo, float& hi) { float a = v, b = v; asm volatile("s_nop 1\n\tv_permlane32_swap_b32 %0, %1" : "+v"(a), "+v"(b)); lo = a; hi = b; }
__device__ __forceinline__ float half_sum(float v) { float a, b; swap32(v, a, b); return a + b; }
__device__ __forceinline__ float half_max(float v) { float a, b; swap32(v, a, b); return fmaxf(a, b); }
__device__ __forceinline__ float wave_sum(float v) {
    v += swz_xor<1>(v); v += swz_xor<2>(v); v += swz_xor<4>(v); v += swz_xor<8>(v); v += swz_xor<16>(v);
    return half_sum(v);
}
__device__ __forceinline__ float wave_max(float v) {
    v = fmaxf(v, swz_xor<1>(v)); v = fmaxf(v, swz_xor<2>(v)); v = fmaxf(v, swz_xor<4>(v)); v = fmaxf(v, swz_xor<8>(v)); v = fmaxf(v, swz_xor<16>(v));
    return half_max(v);
}
#define LDS_WAIT() asm volatile("s_waitcnt lgkmcnt(0)" ::: "memory")
__device__ __forceinline__ int lane_id_fresh() { int l; asm volatile("v_mbcnt_lo_u32_b32 %0, -1, 0\n\tv_mbcnt_hi_u32_b32 %0, -1, %0" : "=v"(l)); return l; }

#define XB_TMO      128
#define XB_XCNT(j)  (256  + 64 * (j))
#define XB_XSUB(j)  (1280 + 64 * (j))
#define XB_XGEN(j)  (2304 + 64 * (j))
#define XB_TOP      3328
#define XB_TOPGEN   3392
#define XCD_BAR_WORDS 3456
#define XB_SPIN_CAP (1u << 18)
__device__ __forceinline__ unsigned xb_ld(unsigned* p)              { return __hip_atomic_load(p, __ATOMIC_RELAXED, __HIP_MEMORY_SCOPE_AGENT); }
__device__ __forceinline__ unsigned xb_add(unsigned* p, unsigned v) { return __hip_atomic_fetch_add(p, v, __ATOMIC_RELAXED, __HIP_MEMORY_SCOPE_AGENT); }
__device__ __forceinline__ unsigned xb_xcc_id() { return (unsigned)__builtin_amdgcn_s_getreg((3 << 11) | 20) & 0xFu; }
#define XB_SPIN(cond, bar) do { unsigned _sp = 0; while (cond) { __builtin_amdgcn_s_sleep(1); \
    if ((++_sp & 255u) == 0u) { if (xb_ld(&(bar)[XB_TMO])) break; if (_sp > XB_SPIN_CAP) { atomicAdd(&(bar)[XB_TMO], 1u); break; } } } } while (0)
struct XcdBarrier { unsigned* bar; unsigned x; volatile LAS unsigned* st; };
__device__ __forceinline__ XcdBarrier xcd_barrier_post(unsigned* bar, volatile LAS unsigned* st) {
    XcdBarrier b; b.bar = bar; b.x = xb_xcc_id(); b.st = st;
    if (threadIdx.x == 0) (void)xb_add(&bar[XB_XCNT(b.x)], 1u);
    return b;
}
__device__ __forceinline__ void xcd_barrier_complete(unsigned* bar, unsigned x, unsigned& nloc, unsigned& nx) {
    const unsigned G = gridDim.x * gridDim.y * gridDim.z;
    unsigned sum, cnt, mine, sp = 0u;
    for (;;) {
        sum = 0u; cnt = 0u; mine = 0u;
#pragma unroll
        for (unsigned j = 0; j < 16; ++j) { const unsigned c = xb_ld(&bar[XB_XCNT(j)]); sum += c; cnt += (c > 0u) ? 1u : 0u; mine = (j == x) ? c : mine; }
        if (sum == G) break;
        __builtin_amdgcn_s_sleep(1);
        if ((++sp & 255u) == 0u) { if (xb_ld(&bar[XB_TMO])) break; if (sp > XB_SPIN_CAP) { atomicAdd(&bar[XB_TMO], 1u); break; } }
    }
    nloc = mine > 0u ? mine : 1u; nx = cnt > 0u ? cnt : 1u;
}
__device__ __forceinline__ void xcd_barrier(const XcdBarrier& b, const int wave) {
    asm volatile("s_waitcnt vmcnt(0)" ::: "memory");
    __syncthreads();
    if (wave == 0 && lane_id_fresh() == 0) {
        unsigned* bar = b.bar; asm volatile("" : "+s"(bar));
        __builtin_amdgcn_s_waitcnt(0);
        unsigned nloc = b.st[0], nx = b.st[1];
        if (nloc == 0u) { xcd_barrier_complete(bar, b.x, nloc, nx); b.st[0] = nloc; b.st[1] = nx; }
        const unsigned old = xb_add(&bar[XB_XSUB(b.x)], 1u);
        const unsigned gen = old / nloc;
        if (old + 1u == (gen + 1u) * nloc) {
            __builtin_amdgcn_fence(__ATOMIC_RELEASE, "agent");
            asm volatile("s_waitcnt vmcnt(0)" ::: "memory");
            const unsigned og = xb_add(&bar[XB_TOP], 1u);
            const unsigned tg = og / nx;
            if (og + 1u == (tg + 1u) * nx) xb_add(&bar[XB_TOPGEN], 1u);
            else XB_SPIN(xb_ld(&bar[XB_TOPGEN]) == tg, bar);
            __builtin_amdgcn_fence(__ATOMIC_ACQUIRE, "agent");
            xb_add(&bar[XB_XGEN(b.x)], 1u);
            asm volatile("s_waitcnt vmcnt(0)" ::: "memory");
        } else {
            XB_SPIN(xb_ld(&bar[XB_XGEN(b.x)]) == gen, bar);
            __builtin_amdgcn_fence(__ATOMIC_ACQUIRE, "agent");
            asm volatile("s_waitcnt vmcnt(0)" ::: "memory");
        }
    }
    __syncthreads();
}

namespace pg8 {
#define PG8_LAS __attribute__((address_space(3)))
typedef unsigned short bf16_t;
typedef short bf16x8 __attribute__((ext_vector_type(8)));
typedef float f32x4 __attribute__((ext_vector_type(4)));
typedef unsigned u32x4 __attribute__((ext_vector_type(4)));
constexpr int BM = 256, BK = 64, HALF = 128, HTB = HALF * BK * 2  , STAGE_BYTES = 8 * HTB, NXCD = 8, WGM = 8;

__host__ __device__ __forceinline__ int lds_byte(int r, int c) { const int st = (r >> 4) * 2 + (c >> 5), rr = r & 15, cc = c & 31, ob = rr * 64 + cc * 2; return st * 1024 + (ob ^ (((ob >> 9) & 1) << 5)); }
__host__ __device__ __forceinline__ void stage_rc(int b, int& R, int& C) { const int st = b / 1024, sb = b % 1024, swz = sb ^ (((sb >> 9) & 1) << 5); R = (st >> 1) * 16 + swz / 64; C = (st & 1) * 32 + (swz % 64) / 2; }
__host__ __device__ __forceinline__ int perm32(int rho) { const int n = rho >> 4, i = rho & 15; return 8 * (i >> 2) + 4 * n + (i & 3); }

struct Unit { int pm, pn; };
struct Gemm { const bf16_t* A; const bf16_t* Bt; int M, N, K; };

struct StaticOrder {
    int nM, nN, nwg, G, c;
    __host__ __device__ void init(int M, int N, int G_, int c_) { nM = M / BM; nN = N / BM; nwg = nM * nN; G = G_; c = c_; }
    __host__ __device__ bool next(int i, Unit& u) const {
        const long L = (long)i * G + c; if (L >= nwg) return false;
        int wgid = (int)L; { const int q = nwg / NXCD, r = nwg % NXCD, xcd = wgid % NXCD, off = wgid / NXCD; wgid = (xcd < r ? xcd * (q + 1) : r * (q + 1) + (xcd - r) * q) + off; }
        const int nig = WGM * nN, gid = wgid / nig, fm = gid * WGM, gsz = (nM - fm) < WGM ? (nM - fm) : WGM;
        u.pm = fm + ((wgid % nig) % gsz); u.pn = (wgid % nig) / gsz; return true;
    }
    __device__ __forceinline__ void a_ready(const Unit&) const {}
    __device__ __forceinline__ void done(const Unit&) const {}
};
__device__ __forceinline__ unsigned cvt_pk_bf16(float lo, float hi) { unsigned r; asm volatile("v_cvt_pk_bf16_f32 %0, %1, %2" : "=v"(r) : "v"(lo), "v"(hi)); return r; }
typedef float f32x2 __attribute__((ext_vector_type(2)));
struct EpiIn {
    static constexpr bool PERM = true, AFTER_DRAIN = false;
    bf16_t* P; const float* qn; const float* kn; const float* tab;
    __device__ __forceinline__ void operator()(const f32x4 (&acc)[2][2][4][2], const Unit& u, int wr, int wc, int fr, int fq) const {
        const int col0 = u.pn * BM + wc * 64;
        int kind;
        if (col0 < 512) kind = 1; else if (col0 < 640) kind = 2; else if (col0 < 768) kind = 0; else if (col0 < 1280) kind = 3; else if (col0 < 2304) kind = 0;
        else if (col0 < 2816) kind = 4; else if (col0 < 2944) kind = 5; else if (col0 < 3072) kind = 0; else kind = 6;
        kind = __builtin_amdgcn_readfirstlane(kind);
        const bool latent = u.pm < 64;
        const bool do_norm = kind == 1 || kind == 2, do_rope = (kind == 1 || kind == 2 || kind == 4 || kind == 5) && latent, do_scale = kind == 1 || kind == 3 || kind == 4;
        f32x4 wlo[2], whi[2];
        if (do_norm) { const float* w = kind == 1 ? qn : kn;
#pragma unroll
            for (int n = 0; n < 2; ++n) { wlo[n] = *(const f32x4*)(w + 8 * fq + 4 * n); whi[n] = *(const f32x4*)(w + 32 + 8 * fq + 4 * n); } }
#pragma unroll
        for (int ai = 0; ai < 2; ++ai)
#pragma unroll
            for (int m = 0; m < 4; ++m) {
                const int row = u.pm * BM + ai * HALF + wr * 64 + m * 16 + fr;
                f32x4 lo[2], hi[2];
#pragma unroll
                for (int n = 0; n < 2; ++n) { lo[n] = acc[ai][0][m][n]; hi[n] = acc[ai][1][m][n]; }
                if (do_norm) {
                    float ss = 0.f;
#pragma unroll
                    for (int n = 0; n < 2; ++n)
#pragma unroll
                        for (int j = 0; j < 4; ++j) ss += lo[n][j] * lo[n][j] + hi[n][j] * hi[n][j];
                    ss += swz_xor<16>(ss); ss = half_sum(ss);
                    const float rstd = rsqrtf(ss * (1.f / 64.f) + 1e-6f);
#pragma unroll
                    for (int n = 0; n < 2; ++n) { lo[n] = lo[n] * rstd * wlo[n]; hi[n] = hi[n] * rstd * whi[n]; }
                }
                if (do_rope) {
                    const int pr = (4 * u.pm + 2 * ai + wr) & 127, pc = 16 * m + fr;
                    const int pos = fq < 2 ? pr : pc;
                    const float* tp = tab + (pos * 16 + 8 * (fq & 1)) * 2;
#pragma unroll
                    for (int n = 0; n < 2; ++n) {
                        const f32x4 t0 = *(const f32x4*)(tp + 8 * n), t1 = *(const f32x4*)(tp + 8 * n + 4);
                        const float cs[4] = {t0[0], t0[2], t1[0], t1[2]}, sn[4] = {t0[1], t0[3], t1[1], t1[3]};
#pragma unroll
                        for (int j = 0; j < 4; ++j) { const float a = lo[n][j], b = hi[n][j]; lo[n][j] = a * cs[j] - b * sn[j]; hi[n][j] = a * sn[j] + b * cs[j]; }
                    }
                }
                if (do_scale) {
#pragma unroll
                    for (int n = 0; n < 2; ++n) { lo[n] = lo[n] * (0.125f * 1.4426950408889634f); hi[n] = hi[n] * (0.125f * 1.4426950408889634f); }
                }
                if (kind == 6) {
#pragma unroll
                    for (int n = 0; n < 2; ++n)
#pragma unroll
                        for (int j = 0; j < 4; ++j) { lo[n][j] = lo[n][j] / (1.f + __expf(-lo[n][j])); hi[n][j] = hi[n][j] / (1.f + __expf(-hi[n][j])); }
                }
                bf16_t* rowp = P + (size_t)row * 4608 + col0 + 8 * fq;
                u32x4 w0, w1;
                w0.x = cvt_pk_bf16(lo[0][0], lo[0][1]); w0.y = cvt_pk_bf16(lo[0][2], lo[0][3]); w0.z = cvt_pk_bf16(lo[1][0], lo[1][1]); w0.w = cvt_pk_bf16(lo[1][2], lo[1][3]);
                w1.x = cvt_pk_bf16(hi[0][0], hi[0][1]); w1.y = cvt_pk_bf16(hi[0][2], hi[0][3]); w1.z = cvt_pk_bf16(hi[1][0], hi[1][1]); w1.w = cvt_pk_bf16(hi[1][2], hi[1][3]);
                *(u32x4*)rowp = w0; *(u32x4*)(rowp + 32) = w1;
            }
    }
};
struct EpiOut {
    static constexpr bool PERM = false, AFTER_DRAIN = false;
    const float* mod; const float* xlat_in; const float* xctx_in; float* xlat_out; float* xctx_out;
    __device__ __forceinline__ void operator()(const f32x4 (&acc)[2][2][4][2], const Unit& u, int wr, int wc, int fr, int fq) const {
        const bool latent = u.pm < 64;
        const int v = latent ? (u.pm >> 5) : 2;
        const float* gate = mod + (size_t)v * 3072 + 2048;
        const float* xin = latent ? xlat_in : xctx_in - (size_t)16384 * 1024;
        float* xout = latent ? xlat_out : xctx_out - (size_t)16384 * 1024;
        const int col0 = u.pn * BM + wc * 32 + 4 * fq;
        f32x4 g[2][2];
#pragma unroll
        for (int bj = 0; bj < 2; ++bj)
#pragma unroll
            for (int n = 0; n < 2; ++n) g[bj][n] = *(const f32x4*)(gate + col0 + bj * HALF + n * 16);
#pragma unroll
        for (int ai = 0; ai < 2; ++ai)
#pragma unroll
            for (int m = 0; m < 4; ++m) { const size_t off = (size_t)(u.pm * BM + ai * HALF + wr * 64 + m * 16 + fr) * 1024 + col0;
#pragma unroll
                for (int bj = 0; bj < 2; ++bj)
#pragma unroll
                    for (int n = 0; n < 2; ++n) { const f32x4 xo = *(const f32x4*)(xin + off + bj * HALF + n * 16); *(f32x4*)(xout + off + bj * HALF + n * 16) = xo + g[bj][n] * acc[ai][bj][m][n]; }
            }
    }
};
template <class Epi, class Sched, bool ALIGN_EPI = false, bool SP2 = false>
__device__ __forceinline__ void gemm_phase(PG8_LAS unsigned char* lds, const Gemm g, const Sched& S, const Epi& E, const int wid  ) {
    int lane; asm volatile("v_mbcnt_lo_u32_b32 %0, -1, 0\n\tv_mbcnt_hi_u32_b32 %0, -1, %0" : "=v"(lane));
    const int tid = wid * 64 + lane, wr = wid >> 2, wc = wid & 3, fr = lane & 15, fq = lane >> 4;
    const int K = g.K, nt = K / BK;
    unsigned voffA[2], voffB[2];
#pragma unroll
    for (int i = 0; i < 2; ++i) { int R, C; stage_rc(tid * 16 + i * 8192, R, C); const int Rb = Epi::PERM ? ((R & ~31) + perm32(R & 31)) : R;
        voffA[i] = (unsigned)(R * K + C) * 2u; voffB[i] = (unsigned)(Rb * K + C) * 2u; }
    const size_t kstep = (size_t)(BK * 2);
    const size_t hstep = (size_t)HALF * K * 2;
    const size_t tstep = 2 * hstep;
    const unsigned ldsw = (unsigned)wid * 1024u;
    const int aoff = lds_byte(wr * 64 + fr, fq * 8), boff = lds_byte(wc * 32 + fr, fq * 8);
#define PG8_SA(b, h) (((b) * 2 + (h)) * HTB)
#define PG8_SB(b, h) ((4 + (b) * 2 + (h)) * HTB)
#define PG8_STAGE(bufoff, gbase, voff) do { _Pragma("unroll") for (int _i = 0; _i < 2; ++_i) \
        __builtin_amdgcn_global_load_lds((const unsigned*)((const char*)(gbase) + (voff)[_i]), (PG8_LAS unsigned*)(lds + (bufoff) + ldsw + _i * 8192), 16, 0, 0); } while (0)
#define PG8_LDA(dst, b, h) do { _Pragma("unroll") for (int m = 0; m < 4; ++m) _Pragma("unroll") for (int k = 0; k < 2; ++k) dst[m][k] = *(const PG8_LAS bf16x8*)(lds + PG8_SA(b, h) + aoff + m * 2048 + k * 1024); } while (0)
#define PG8_LDB(dst, b, h) do { _Pragma("unroll") for (int n = 0; n < 2; ++n) _Pragma("unroll") for (int k = 0; k < 2; ++k) dst[n][k] = *(const PG8_LAS bf16x8*)(lds + PG8_SB(b, h) + boff + n * 2048 + k * 1024); } while (0)
#define PG8_MMA(ai, bj, At, Bt) do { __builtin_amdgcn_s_setprio(1); _Pragma("unroll") for (int m = 0; m < 4; ++m) _Pragma("unroll") for (int n = 0; n < 2; ++n) _Pragma("unroll") for (int k = 0; k < 2; ++k) \
        acc[ai][bj][m][n] = __builtin_amdgcn_mfma_f32_16x16x32_bf16(Bt[n][k], At[m][k], acc[ai][bj][m][n], 0, 0, 0); __builtin_amdgcn_s_setprio(0); } while (0)
#define PG8_WAIT_V(n) asm volatile("s_waitcnt vmcnt(" #n ")" ::: "memory")
#define PG8_WAIT_L(n) asm volatile("s_waitcnt lgkmcnt(" #n ")" ::: "memory")
#define PG8_BAR __builtin_amdgcn_s_barrier()
#define PG8_SCHED __builtin_amdgcn_sched_barrier(0)
    Unit cur, nxt; int ui = 0;
    if (!S.next(0, cur)) return;
    f32x4 acc[2][2][4][2];
#pragma unroll
    for (int a = 0; a < 2; ++a)
#pragma unroll
        for (int b = 0; b < 2; ++b)
#pragma unroll
            for (int m = 0; m < 4; ++m)
#pragma unroll
                for (int n = 0; n < 2; ++n) acc[a][b][m][n] = (f32x4){0.f, 0.f, 0.f, 0.f};
    bf16x8 At[4][2], B0[2][2], B1[2][2];
    const char* cA = (const char*)g.A + (size_t)cur.pm * tstep; const char* cB = (const char*)g.Bt + (size_t)cur.pn * tstep;
    S.a_ready(cur);
    if constexpr (SP2) {
        PG8_STAGE(PG8_SB(0, 0), cB, voffB); PG8_STAGE(PG8_SB(0, 1), cB + hstep, voffB); PG8_STAGE(PG8_SA(0, 0), cA, voffA); PG8_STAGE(PG8_SA(0, 1), cA + hstep, voffA);
        if (wr == 1) PG8_BAR;
        PG8_WAIT_V(2); PG8_BAR;
        PG8_STAGE(PG8_SB(1, 0), cB + kstep, voffB); PG8_STAGE(PG8_SA(1, 0), cA + kstep, voffA); PG8_STAGE(PG8_SB(1, 1), cB + hstep + kstep, voffB);
        PG8_WAIT_V(6); PG8_BAR;
    } else {
        PG8_STAGE(PG8_SB(0, 0), cB, voffB); PG8_STAGE(PG8_SA(0, 0), cA, voffA); PG8_STAGE(PG8_SB(0, 1), cB + hstep, voffB); PG8_STAGE(PG8_SA(0, 1), cA + hstep, voffA);
        if (wr == 1) PG8_BAR;
        PG8_WAIT_V(4); PG8_BAR;
        PG8_STAGE(PG8_SB(1, 0), cB + kstep, voffB); PG8_STAGE(PG8_SA(1, 0), cA + kstep, voffA); PG8_STAGE(PG8_SB(1, 1), cB + hstep + kstep, voffB);
        PG8_WAIT_V(6); PG8_BAR;
    }
    for (;;) {
        const bool has_next = S.next(ui + 1, nxt);
        const char* nA = has_next ? (const char*)g.A + (size_t)nxt.pm * tstep : cA; const char* nB = has_next ? (const char*)g.Bt + (size_t)nxt.pn * tstep : cB;
        for (int t = 0; t < nt; t += 2) {
            const bool last = (t == nt - 2);
            const char* a1 = cA + (size_t)(t + 1) * kstep;
            const char* a2 = last ? nA : cA + (size_t)(t + 2) * kstep; const char* b2 = last ? nB : cB + (size_t)(t + 2) * kstep;
            const char* a3 = a2 + kstep; const char* b3 = b2 + kstep;
            if (last && has_next) S.a_ready(nxt);
            if constexpr (SP2) {
            PG8_LDB(B0, 0, 0); PG8_LDB(B1, 0, 1); PG8_SCHED; PG8_LDA(At, 0, 0); PG8_STAGE(PG8_SA(1, 1), a1 + hstep, voffA);
            PG8_WAIT_V(8); PG8_WAIT_L(0); PG8_BAR; PG8_MMA(0, 0, At, B0); PG8_MMA(0, 1, At, B1); PG8_BAR; PG8_SCHED;
            PG8_LDA(At, 0, 1); PG8_STAGE(PG8_SB(0, 0), b2, voffB); PG8_STAGE(PG8_SB(0, 1), b2 + hstep, voffB); PG8_STAGE(PG8_SA(0, 0), a2, voffA);
            PG8_WAIT_V(8); PG8_WAIT_L(0); PG8_BAR; PG8_MMA(1, 0, At, B0); PG8_MMA(1, 1, At, B1); PG8_BAR; PG8_SCHED;
            PG8_LDB(B0, 1, 0); PG8_LDB(B1, 1, 1); PG8_SCHED; PG8_LDA(At, 1, 0); PG8_STAGE(PG8_SA(0, 1), a2 + hstep, voffA);
            PG8_WAIT_V(8); PG8_WAIT_L(0); PG8_BAR; PG8_MMA(0, 0, At, B0); PG8_MMA(0, 1, At, B1); PG8_BAR; PG8_SCHED;
            PG8_LDA(At, 1, 1); PG8_STAGE(PG8_SB(1, 0), b3, voffB); PG8_STAGE(PG8_SB(1, 1), b3 + hstep, voffB); PG8_STAGE(PG8_SA(1, 0), a3, voffA);
            PG8_WAIT_V(8); PG8_WAIT_L(0); PG8_BAR; PG8_MMA(1, 0, At, B0); PG8_MMA(1, 1, At, B1); PG8_BAR; PG8_SCHED;
            } else {
            PG8_LDB(B0, 0, 0); PG8_SCHED; PG8_LDA(At, 0, 0); PG8_STAGE(PG8_SA(1, 1), a1 + hstep, voffA);
            PG8_WAIT_L(8); PG8_BAR; PG8_WAIT_L(0); PG8_MMA(0, 0, At, B0); PG8_BAR; PG8_SCHED;
            PG8_LDB(B1, 0, 1); PG8_STAGE(PG8_SB(0, 0), b2, voffB);
            PG8_BAR; PG8_WAIT_L(0); PG8_MMA(0, 1, At, B1); PG8_BAR;
            PG8_LDA(At, 0, 1); PG8_STAGE(PG8_SA(0, 0), a2, voffA);
            PG8_BAR; PG8_WAIT_L(0); PG8_MMA(1, 0, At, B0); PG8_BAR; PG8_SCHED;
            PG8_STAGE(PG8_SB(0, 1), b2 + hstep, voffB);
            PG8_WAIT_V(6); PG8_BAR; PG8_MMA(1, 1, At, B1); PG8_BAR;
            PG8_LDB(B0, 1, 0); PG8_SCHED; PG8_LDA(At, 1, 0); PG8_STAGE(PG8_SA(0, 1), a2 + hstep, voffA);
            PG8_WAIT_L(8); PG8_BAR; PG8_WAIT_L(0); PG8_MMA(0, 0, At, B0); PG8_BAR; PG8_SCHED;
            PG8_LDB(B1, 1, 1); PG8_STAGE(PG8_SB(1, 0), b3, voffB);
            PG8_BAR; PG8_WAIT_L(0); PG8_MMA(0, 1, At, B1); PG8_BAR;
            PG8_LDA(At, 1, 1); PG8_STAGE(PG8_SA(1, 0), a3, voffA);
            PG8_BAR; PG8_WAIT_L(0); PG8_MMA(1, 0, At, B0); PG8_BAR; PG8_SCHED;
            PG8_STAGE(PG8_SB(1, 1), b3 + hstep, voffB);
            PG8_WAIT_V(6); PG8_BAR; PG8_MMA(1, 1, At, B1); PG8_BAR;
            }
        }
        if constexpr (ALIGN_EPI) { if (wr == 0) PG8_BAR; }
        if constexpr (!Epi::AFTER_DRAIN) { E(acc, cur, wr, wc, fr, fq); S.done(cur); }
        if (!has_next) break;
#pragma unroll
        for (int a = 0; a < 2; ++a)
#pragma unroll
            for (int b = 0; b < 2; ++b)
#pragma unroll
                for (int m = 0; m < 4; ++m)
#pragma unroll
                    for (int n = 0; n < 2; ++n) acc[a][b][m][n] = (f32x4){0.f, 0.f, 0.f, 0.f};
        cur = nxt; cA = nA; cB = nB; ++ui;
        if constexpr (ALIGN_EPI) { if (wr == 1) PG8_BAR; }
    }
    PG8_WAIT_V(0);
    if constexpr (!ALIGN_EPI) { if (wr == 0) PG8_BAR; }
    PG8_BAR;
    if constexpr (Epi::AFTER_DRAIN) { E.fused(acc, cur, wr, wc, fr, fq, lds, wid, lane); S.done(cur); }
#undef PG8_SA
#undef PG8_SB
#undef PG8_STAGE
#undef PG8_LDA
#undef PG8_LDB
#undef PG8_MMA
#undef PG8_WAIT_V
#undef PG8_WAIT_L
#undef PG8_BAR
#undef PG8_SCHED
}
}

struct Ctx {
    LAS unsigned char* lds; int tid, lane, wave, vcu, G;
};
__device__ __forceinline__ Ctx fresh(const Ctx& F0) { Ctx F = F0; const int l = lane_id_fresh(); F.lane = l; F.tid = F0.wave * 64 + l; return F; }

template <bool PERMUTE>
__device__ __forceinline__ void p0_transpose_item(const float* W, int K, int N, bf16_t* WT, LAS float* scr, int item, int lane) {
    const int nblk = N / 32, kb = item / nblk, nb = item % nblk, k0 = 64 * kb, n0 = 32 * nb;
    const int r0 = PERMUTE ? ((n0 & ~255) + 128 * ((n0 >> 5) & 1) + 32 * ((n0 >> 6) & 3)) : n0;
#pragma unroll 8
    for (int i = 0; i < 32; ++i) { const int kk = 2 * i + (lane >> 5); scr[kk * 33 + (lane & 31)] = W[(size_t)(k0 + kk) * N + n0 + (lane & 31)]; }
    LDS_WAIT(); asm volatile("" ::: "memory");
    const int c = lane & 7;
#pragma unroll
    for (int j = 0; j < 4; ++j) { const int n = (lane >> 3) + 8 * j; const LAS float* s = scr + (8 * c) * 33 + n;
        u32x4 o; o.x = pk2(s[0 * 33], s[1 * 33]); o.y = pk2(s[2 * 33], s[3 * 33]); o.z = pk2(s[4 * 33], s[5 * 33]); o.w = pk2(s[6 * 33], s[7 * 33]);
        *(u32x4*)(WT + (size_t)(r0 + n) * K + k0 + 8 * c) = o; }
    LDS_WAIT(); asm volatile("" ::: "memory");
}

__device__ __forceinline__ void phase_prologue(const Ctx& F0, const float* w_in, const float* w_out, const float* c, const float* c_ctx, const float* ada_w, const float* ada_b,
                                               bf16_t* wtin, bf16_t* wtout, float* tab, float* mod) {
    const Ctx F = fresh(F0);
    LAS float* scr = (LAS float*)(F.lds + F.wave * 16384);
    const int gw = F.vcu * NWAVES + F.wave, NGW = F.G * NWAVES;
    constexpr int I_IN = (DM / 64) * (NIN / 32), I_OUT = (MIX / 64) * (DM / 32), NITEMS = 2 * (I_IN + I_OUT);
    for (int it = gw; it < NITEMS; it += NGW) {
        int r = it;
        if (r < I_IN) { p0_transpose_item<true>(w_in, DM, NIN, wtin, scr, r, F.lane); continue; } r -= I_IN;
        if (r < I_IN) { p0_transpose_item<true>(w_in + (size_t)DM * NIN, DM, NIN, wtin + (size_t)NIN * DM, scr, r, F.lane); continue; } r -= I_IN;
        if (r < I_OUT) { p0_transpose_item<false>(w_out, MIX, DM, wtout, scr, r, F.lane); continue; } r -= I_OUT;
        p0_transpose_item<false>(w_out + (size_t)MIX * DM, MIX, DM, wtout + (size_t)DM * MIX, scr, r, F.lane);
    }
    { const int idx = F.vcu * NTHREADS + F.tid;
      if (idx < 128 * 16) { const int pos = idx >> 4, i = idx & 15; const float freq = powf(10000.f, -(float)i / 16.f); const float ang = (float)pos * freq; tab[idx * 2] = cosf(ang); tab[idx * 2 + 1] = sinf(ang); } }
    { const int wk = F.vcu * 2 + (F.tid >> 8), NWK = F.G * 2, t = F.tid & 255;
      for (int it = wk; it < 2 * 16 * 12; it += NWK) {
          const int nb = it % 12, kc = (it / 12) % 16, l = it / 192; const int n = nb * 256 + t;
          float a0 = 0.f, a1 = 0.f, a2 = 0.f;
          const float* w = ada_w + ((size_t)l * DM + kc * 64) * 3072 + n;
#pragma unroll 8
          for (int k = 0; k < 64; ++k) { const float wv = w[(size_t)k * 3072]; const int kk = kc * 64 + k;
              a0 += silu_f(c[kk]) * wv; a1 += silu_f(c[DM + kk]) * wv; a2 += silu_f(c_ctx[kk]) * wv; }
          if (kc == 0) { const float bb = ada_b[l * 3072 + n]; a0 += bb; a1 += bb; a2 += bb; }
          float* p = mod + (size_t)l * 3 * 3072 + n;
          atomicAdd(p, a0); atomicAdd(p + 3072, a1); atomicAdd(p + 2 * 3072, a2);
      } }
}

__device__ __forceinline__ void phase_norm_mod(const Ctx& F0, const float* xlat, const float* xctx, const float* nw, const float* mod, bf16_t* HX) {
    const Ctx F = fresh(F0);
    const int gw = F.vcu * NWAVES + F.wave, NGW = F.G * NWAVES, lane = F.lane;
    for (int row = gw; row < MT; row += NGW) {
        const int v = row < ML ? row / SEQ : 2;
        const float* xr = row < ML ? xlat + (size_t)row * DM : xctx + (size_t)(row - ML) * DM;
        f32x4 xv[4]; float ss = 0.f;
#pragma unroll
        for (int j = 0; j < 4; ++j) { xv[j] = *(const f32x4*)(xr + 256 * j + 4 * lane); ss += xv[j][0] * xv[j][0] + xv[j][1] * xv[j][1] + xv[j][2] * xv[j][2] + xv[j][3] * xv[j][3]; }
        const float rstd = rsqrtf(wave_sum(ss) * (1.f / DM) + EPS);
        const float* shift = mod + (size_t)v * 3072; const float* scale = shift + 1024;
#pragma unroll
        for (int j = 0; j < 4; ++j) {
            const int k = 256 * j + 4 * lane;
            const f32x4 w = *(const f32x4*)(nw + k), sc = *(const f32x4*)(scale + k), sh = *(const f32x4*)(shift + k);
            float y[4];
#pragma unroll
            for (int e = 0; e < 4; ++e) y[e] = xv[j][e] * rstd * w[e] * (1.f + sc[e]) + sh[e];
            uint2 o; o.x = pk2(y[0], y[1]); o.y = pk2(y[2], y[3]);
            *(uint2*)(HX + (size_t)row * DM + k) = o;
        }
    }
}

namespace att {
typedef unsigned short bf16;
using bf16x8=__attribute__((ext_vector_type(8)))short;
using s16x4=__attribute__((ext_vector_type(4)))short;
using f32x16=__attribute__((ext_vector_type(16)))float;
using f32x4=__attribute__((ext_vector_type(4)))float;
using u32x4=__attribute__((ext_vector_type(4)))unsigned;
constexpr int PITCH=4608, UPITCH=1536, GCOL=3072;
constexpr int NW=8,QBLK=32,KVBLK=64;
constexpr int NSLOT=3, SLOTB=8192, OSTR=68  ;
constexpr int LDS_K=0, LDS_V=NSLOT*SLOTB, LDS_WS=2*NSLOT*SLOTB, LDS_OST=LDS_WS+NW*64*4, LDS_BYTES=LDS_OST+NW*32*OSTR*4;
constexpr int LDS_BETA=LDS_BYTES  , LDS_T=LDS_BETA+15*128*4  , LDS_TABLES_END=LDS_T+512;
static_assert(LDS_TABLES_END<=131072,"attention LDS map");
constexpr float L2E=1.4426950408889634f;
struct Unit {
  int type;
  int nt;
  int nlat;
  int ctx0, lat0;
  int first;
  int kcol, vcol;
  int qrow0, tq0;
  int h0, gqa;
  int bias_build;
};
__device__ __forceinline__ int crow(int r,int hi){return (r&3)+8*(r>>2)+4*hi;}
#define SBAR() __builtin_amdgcn_sched_barrier(0)
__device__ __forceinline__ void glds16(const void*gsrc,unsigned lds_dst){unsigned keep;
  asm volatile("s_mov_b32 %0, m0\n\ts_mov_b32 m0, %2\n\ts_nop 0\n\tglobal_load_lds_dwordx4 %1, off\n\ts_mov_b32 m0, %0":"=&s"(keep):"v"(gsrc),"s"(lds_dst):"memory");}
__device__ __forceinline__ float max3f(float a,float b,float c){float r;asm("v_max3_f32 %0, %1, %2, %3":"=v"(r):"v"(a),"v"(b),"v"(c));return r;}
__device__ __forceinline__ float max2f(float a,float b){float r;asm("v_max_f32_e32 %0, %1, %2":"=v"(r):"v"(a),"v"(b));return r;}
__device__ __forceinline__ float fadd_s(float a,float b){float r;asm("v_add_f32_e32 %0, %1, %2":"=v"(r):"v"(a),"v"(b));return r;}
__device__ __forceinline__ float fsub_s(float a,float b){float r;asm("v_sub_f32_e32 %0, %1, %2":"=v"(r):"v"(a),"v"(b));return r;}
typedef float f32x2_t __attribute__((ext_vector_type(2))); typedef __bf16 bf16x2_t __attribute__((ext_vector_type(2)));
__device__ __forceinline__ unsigned cvtpk_s(float lo,float hi){f32x2_t v={lo,hi};bf16x2_t b=__builtin_convertvector(v,bf16x2_t);return __builtin_bit_cast(unsigned,b);}
#define WAIT_BAR(N) asm volatile("s_waitcnt vmcnt(" #N ") lgkmcnt(0)\n\ts_barrier":::"memory")
__device__ __forceinline__ void qkt(f32x16&p0,f32x16&p1,const char*Kslot,const bf16x8*qr,const f32x16&negm,int r32,int hi){
  const char*kb=Kslot+hi*1024+r32*16;
  #pragma unroll
  for(int d0=0;d0<4;++d0){
    const bf16x8 b0=*reinterpret_cast<const bf16x8*>(kb+d0*2048);
    const bf16x8 b1=*reinterpret_cast<const bf16x8*>(kb+d0*2048+512);
    if(d0==0){p0=__builtin_amdgcn_mfma_f32_32x32x16_bf16(b0,qr[0],negm,0,0,0);p1=__builtin_amdgcn_mfma_f32_32x32x16_bf16(b1,qr[0],negm,0,0,0);}
    else{p0=__builtin_amdgcn_mfma_f32_32x32x16_bf16(b0,qr[d0],p0,0,0,0);p1=__builtin_amdgcn_mfma_f32_32x32x16_bf16(b1,qr[d0],p1,0,0,0);}}
}
typedef __attribute__((address_space(3))) const char* lds_cptr;
typedef short v4i16_t __attribute__((ext_vector_type(4)));
__device__ __forceinline__ void kload8(bf16x8*kf,lds_cptr kp){
  kf[0]=*(const __attribute__((address_space(3))) bf16x8*)(kp);      kf[1]=*(const __attribute__((address_space(3))) bf16x8*)(kp+512);
  kf[2]=*(const __attribute__((address_space(3))) bf16x8*)(kp+2048); kf[3]=*(const __attribute__((address_space(3))) bf16x8*)(kp+2560);
  kf[4]=*(const __attribute__((address_space(3))) bf16x8*)(kp+4096); kf[5]=*(const __attribute__((address_space(3))) bf16x8*)(kp+4608);
  kf[6]=*(const __attribute__((address_space(3))) bf16x8*)(kp+6144); kf[7]=*(const __attribute__((address_space(3))) bf16x8*)(kp+6656);
}
__device__ __forceinline__ void kload2(bf16x8*kf,lds_cptr kp,int j){ kf[2*j]=*(const __attribute__((address_space(3))) bf16x8*)(kp+j*2048); kf[2*j+1]=*(const __attribute__((address_space(3))) bf16x8*)(kp+j*2048+512); }
__device__ __forceinline__ s16x4 vtr(lds_cptr p){ return __builtin_bit_cast(s16x4,__builtin_amdgcn_ds_read_tr16_b64_v4i16((__attribute__((address_space(3))) v4i16_t*)p)); }
__device__ __forceinline__ float rowmax(const f32x16&p0,const f32x16&p1){
  float a=max3f(p0[0],p0[1],p1[0]),b=max3f(p0[2],p0[3],p1[1]);a=max3f(a,p1[2],p1[3]);
  #pragma unroll
  for(int r=4;r<16;r+=4){a=max3f(a,p0[r],p0[r+1]);b=max3f(b,p0[r+2],p0[r+3]);a=max3f(a,p1[r],p1[r+1]);b=max3f(b,p1[r+2],p1[r+3]);}
  const float m=max2f(a,b);
  float ma,mb; swap32(m,ma,mb); return max2f(ma,mb);
}
__device__ __forceinline__ void pv(f32x16*o,int vb,bf16x8 pa0,bf16x8 pa1,bf16x8 pa2,bf16x8 pa3){
  #pragma unroll
  for(int d0=0;d0<2;++d0){s16x4 lo[4],hi[4];
    #pragma unroll
    for(int ks=0;ks<4;++ks){
      asm volatile("ds_read_b64_tr_b16 %0,%1 offset:%c2":"=&v"(lo[ks]):"v"(vb),"i"(d0*4096+ks*1024):"memory");
      asm volatile("ds_read_b64_tr_b16 %0,%1 offset:%c2":"=&v"(hi[ks]):"v"(vb),"i"(d0*4096+ks*1024+512):"memory");}
    asm volatile("s_waitcnt lgkmcnt(0)":::"memory");SBAR();
    #define PK(k) (bf16x8){lo[k][0],lo[k][1],lo[k][2],lo[k][3],hi[k][0],hi[k][1],hi[k][2],hi[k][3]}
    o[d0]=__builtin_amdgcn_mfma_f32_32x32x16_bf16(pa0,PK(0),o[d0],0,0,0);
    o[d0]=__builtin_amdgcn_mfma_f32_32x32x16_bf16(pa1,PK(1),o[d0],0,0,0);
    o[d0]=__builtin_amdgcn_mfma_f32_32x32x16_bf16(pa2,PK(2),o[d0],0,0,0);
    o[d0]=__builtin_amdgcn_mfma_f32_32x32x16_bf16(pa3,PK(3),o[d0],0,0,0);
    #undef PK
  }
}
template<int TYPE> __device__ __forceinline__ void amask(f32x16&c0,f32x16&c1,int li,int nlat,int mA,int mB,int u0,int u1,const char*shm){
  const float NEG=-INFINITY;
  bool dead = li>=nlat;
  if(TYPE==1) dead = dead || (unsigned)(li-u0)>=8u;
  if(TYPE==2&&!dead){ const int d=64*li-u0; if(d>=-97&&d<=65) return; }
  if(dead){
    #pragma unroll
    for(int r=0;r<16;++r){c0[r]=NEG;c1[r]=NEG;}
    return; }
  if(TYPE==1){
    const float*brow=(const float*)(shm+LDS_BETA)+(li-u1+7)*128+mB;
    const float*trow=(const float*)(shm+LDS_T)+mA;
    #pragma unroll
    for(int r=0;r<16;++r){ const int kk0=(r&3)+8*(r>>2); c0[r]+=brow[kk0]+trow[kk0]; c1[r]+=brow[kk0+32]+trow[kk0+32]; }
  } else {
    const int base=mA+64*li;
    #pragma unroll
    for(int r=0;r<16;++r){ const int kk0=(r&3)+8*(r>>2);
      if((unsigned)(kk0+base)>256u)c0[r]=NEG; if((unsigned)(kk0+32+base)>256u)c1[r]=NEG; }
  }
}

template<int TYPE,int THRL,bool NOMAX> __device__ __forceinline__ void attn_unit(const Unit&ud,const Unit&nx,const bool has_nx,const bool pre,int&ring,const bf16*__restrict__ P,bf16*__restrict__ U,const float*rpbl,const float*sinkl,char*shm,const int wid){
  int lane; asm volatile("v_mbcnt_lo_u32_b32 %0, -1, 0\n\tv_mbcnt_hi_u32_b32 %0, -1, %0":"=v"(lane));
  const int tid=wid*64+lane,r32=lane&31,hi=lane>>5;
  const int hq=ud.gqa?ud.h0+(wid&3):ud.h0, qoff=ud.gqa?32*(wid>>2):32*wid;
  const int qcol=(TYPE==0?0:TYPE==1?768:2304)+hq*64, ucol=TYPE*512+hq*64;
  const long qrow=ud.qrow0+qoff;
  const bf16*Qw=P+qrow*PITCH+qcol;
  const unsigned lds0=(unsigned)(uintptr_t)shm;
  float*wsf=(float*)(shm+LDS_WS)+wid*64;
  const bf16*ksrc=P+(long)lane*PITCH+ud.kcol+wid*8;
  const bf16*vsrc=P+(long)(16*(wid&3)+(lane>>2))*PITCH+ud.vcol+(wid>>2)*32+(lane&3)*8;
  const unsigned kdst=lds0+LDS_K+wid*1024, vdst=lds0+LDS_V+wid*1024;
  const int NT=ud.nt, nlat=ud.nlat;
  #define TROW(t) ((long)(((t)<4)?(ud.ctx0+64*(t)):(ud.lat0+64*((((t)-4)<nlat)?((t)-4):(nlat-1)))))
  #define DMA_K(t,slot) glds16(ksrc+TROW(t)*PITCH,(unsigned)__builtin_amdgcn_readfirstlane(kdst+(slot)))
  #define DMA_V(t,slot) glds16(vsrc+TROW(t)*PITCH,(unsigned)__builtin_amdgcn_readfirstlane(vdst+(slot)))
  const int vb0=(int)(lds0+LDS_V)+((lane>>4)&1)*32+(lane&3)*8+(4*hi+((lane&15)>>2))*64;
  const char*Kbase=shm+LDS_K; bf16x8 kf[8];
  const lds_cptr shm3=(lds_cptr)shm; const lds_cptr kp0=shm3+LDS_K+hi*1024+r32*16; const lds_cptr vp0=shm3+LDS_V+((lane>>4)&1)*32+(lane&3)*8+(4*hi+((lane&15)>>2))*64;
  int mA=0,mB=0,u0=0,u1=0;
  if(TYPE==1){ const int tqw=ud.tq0+qoff, qg=tqw>>6, qc=(tqw&63)+r32; int rs=qg-4; rs=rs<0?0:(rs>120?120:rs);
    int cs=qc-8; cs=cs<0?0:(cs>48?48:cs); mA=48-cs+4*hi; mB=63-qc+4*hi; u0=rs-ud.first; u1=qg-ud.first;
    float*btw=(float*)(shm+LDS_BETA); if(ud.bias_build) for(int i=tid;i<15*128;i+=512){ const int d=i>>7, ti=(i&127)-48; btw[i]=(ti>=0&&ti<=30)?rpbl[hq*465+d*31+ti]*L2E:0.f; } }
  if(TYPE==2){ const int tq=ud.tq0+qoff+r32; mA=4*hi-(tq-64*ud.first)+128; u0=ud.tq0+qoff-64*ud.first; }
  const int r0=ring, r1=(r0==(NSLOT-1)*SLOTB)?0:r0+SLOTB, r2=(r1==(NSLOT-1)*SLOTB)?0:r1+SLOTB;
  if(!pre){DMA_K(0,r0);DMA_V(0,r0);DMA_K(1,r1);}
  bf16x8 qr[4];
  #pragma unroll
  for(int d0=0;d0<4;++d0)qr[d0]=*reinterpret_cast<const bf16x8*>(&Qw[(long)r32*PITCH+d0*16+hi*8]);
  constexpr bool UNEG=(TYPE==0)&&!NOMAX;
  float mhat=0.f,l_reg=0.f;f32x16 o[2],negm; { float z=0.f; asm volatile("":"+v"(z));
    _Pragma("unroll") for(int r=0;r<16;++r){o[0][r]=z;o[1][r]=z;negm[r]=z;} }
  if(UNEG)asm volatile("":"+v"(negm));
  #define NEGM (UNEG?negm:(f32x16){})
  #define AMASK(P0,P1,t) do{ if(TYPE!=0){ if((t)>=4) amask<TYPE>(P0,P1,(t)-4,nlat,mA,mB,u0,u1,shm); _Pragma("unroll") for(int r=0;r<16;++r){P0[r]-=mhat;P1[r]-=mhat;} } }while(0)
  bool resc=false;
  #define START(P0,P1) do{ resc=false; if(!NOMAX){ const float rm=rowmax(P0,P1); \
    { const float dl=rm; mhat=fadd_s(mhat,dl); \
      _Pragma("unroll") for(int r=0;r<16;++r){P0[r]=fsub_s(P0[r],dl);P1[r]=fsub_s(P1[r],dl);} \
      if(UNEG){ _Pragma("unroll") for(int r=0;r<16;++r)negm[r]=-mhat; asm volatile("":"+v"(negm)); } } } \
    _Pragma("unroll") for(int r=0;r<16;++r)P0[r]=__builtin_amdgcn_exp2f(P0[r]); }while(0)
  #define RESC() do{ if(!NOMAX&&resc){ asm volatile("s_waitcnt lgkmcnt(0)":::"memory"); \
      _Pragma("unroll") for(int d_=0;d_<2;++d_) _Pragma("unroll") for(int r=0;r<16;++r)o[d_][r]*=wsf[crow(r,hi)]; } }while(0)
  f32x16 pA0,pA1,pB0,pB1;
  int sl_prev=r0,sl_cur=r0,sl_next=r1;
  #define ROT() do{sl_prev=sl_cur;sl_cur=sl_next;sl_next=(sl_next==(NSLOT-1)*SLOTB)?0:sl_next+SLOTB;}while(0)
  if(!pre)DMA_K(2,r2);
  WAIT_BAR(3);
  qkt(pA0,pA1,Kbase+r0,qr,NEGM,r32,hi);asm volatile("s_nop 15\n\ts_nop 7":"+v"(pA0),"+v"(pA1));
  START(pA0,pA1);
  _Pragma("unroll") for(int r=0;r<16;++r)pA1[r]=__builtin_amdgcn_exp2f(pA1[r]);
  WAIT_BAR(0);
  DMA_K(3,r0);DMA_V(1,r1);
  ROT();
  kload8(kf,kp0+sl_cur);
  WAIT_BAR(2);
  s16x4 vlo[8],vhi[8]; u32x4 pw0,pw1,pw2,pw3;
  #define PKW(P,B) cvtpk_s(P[B],P[B+1])
  #define PAF(k) __builtin_bit_cast(bf16x8,pw##k)
  #define VFR(i) (bf16x8){vlo[i][0],vlo[i][1],vlo[i][2],vlo[i][3],vhi[i][0],vhi[i][1],vhi[i][2],vhi[i][3]}
  #define PIN(x) asm volatile("":"+v"(x))
  #define MX3(a,b,c) __builtin_fmaxf(__builtin_fmaxf((a),(b)),(c))
  #define GAPA(MF,A0,A1,A2,A3,W0,W1,PW) do{ MF; sacc+=A0; sacc+=A1; sacc+=A2; sacc+=A3; PIN(sacc); W0; W1; PIN(PW); SBAR(); }while(0)
  #define EX(v) __builtin_amdgcn_exp2f(v)
  #define GAPB(MF,X,B) do{ MF; X[B]=EX(X[B]); X[B+1]=EX(X[B+1]); X[B+2]=EX(X[B+2]); X[B+3]=EX(X[B+3]); PIN(X); SBAR(); }while(0)
  #define VRD(i) do{ vlo[i]=vtr(vp_+(((i)>>2)*4096+((i)&3)*1024)); vhi[i]=vtr(vp_+(((i)>>2)*4096+((i)&3)*1024+512)); }while(0)
  #define KRD(G,j) do{ if(G){ kload2(kf,kp0+sl_next,j); SBAR(); } }while(0)
  #define STEP(C0,C1,P0,P1,t,GK,GV,GL) do{ SBAR(); \
    const lds_cptr vp_=vp0+sl_prev; \
    VRD(0); SBAR(); float sacc=(P0[0]+P0[1]); \
    GAPA(C0=__builtin_amdgcn_mfma_f32_32x32x16_bf16(kf[0],qr[0],NEGM,0,0,0), P0[2],P0[3],P0[4],P0[5],     pw0[0]=PKW(P0,0), pw0[1]=PKW(P0,2), pw0); \
    VRD(4); SBAR(); GAPA(C1=__builtin_amdgcn_mfma_f32_32x32x16_bf16(kf[1],qr[0],NEGM,0,0,0), P0[6],P0[7],P0[8],P0[9],     pw0[2]=PKW(P0,4), pw0[3]=PKW(P0,6), pw0); \
    VRD(1); SBAR(); GAPA(C0=__builtin_amdgcn_mfma_f32_32x32x16_bf16(kf[2],qr[1],C0,0,0,0),   P0[10],P0[11],P0[12],P0[13], pw1[0]=PKW(P0,8), pw1[1]=PKW(P0,10), pw1); \
    VRD(5); SBAR(); GAPA(C1=__builtin_amdgcn_mfma_f32_32x32x16_bf16(kf[3],qr[1],C1,0,0,0),   P0[14],P0[15],P1[0],P1[1],   pw1[2]=PKW(P0,12),pw1[3]=PKW(P0,14), pw1); \
    VRD(2); SBAR(); GAPA(C0=__builtin_amdgcn_mfma_f32_32x32x16_bf16(kf[4],qr[2],C0,0,0,0),   P1[2],P1[3],P1[4],P1[5],     pw2[0]=PKW(P1,0), pw2[1]=PKW(P1,2), pw2); \
    VRD(6); SBAR(); GAPA(C1=__builtin_amdgcn_mfma_f32_32x32x16_bf16(kf[5],qr[2],C1,0,0,0),   P1[6],P1[7],P1[8],P1[9],     pw2[2]=PKW(P1,4), pw2[3]=PKW(P1,6), pw2); \
    VRD(3); SBAR(); GAPA(C0=__builtin_amdgcn_mfma_f32_32x32x16_bf16(kf[6],qr[3],C0,0,0,0),   P1[10],P1[11],P1[12],P1[13], pw3[0]=PKW(P1,8), pw3[1]=PKW(P1,10), pw3); \
    VRD(7); SBAR(); GAPA(C1=__builtin_amdgcn_mfma_f32_32x32x16_bf16(kf[7],qr[3],C1,0,0,0),   P1[14],P1[15],0.f,0.f,       pw3[2]=PKW(P1,12),pw3[3]=PKW(P1,14), pw3); \
    l_reg+=sacc; \
    if(GK){DMA_K((t)+3,sl_cur);} if(GV){DMA_V((t)+1,sl_next);} \
    AMASK(C0,C1,t); \
    if(!NOMAX){ float a=MX3(C0[0],C0[1],C1[0]),b=MX3(C0[2],C0[3],C1[1]); a=MX3(a,C1[2],C1[3]); \
      _Pragma("unroll") for(int r=4;r<16;r+=4){a=MX3(a,C0[r],C0[r+1]);b=MX3(b,C0[r+2],C0[r+3]);a=MX3(a,C1[r],C1[r+1]);b=MX3(b,C1[r+2],C1[r+3]);} \
      float rm=__builtin_fmaxf(a,b); { float ma_,mb_; swap32(rm,ma_,mb_); rm=__builtin_fmaxf(ma_,mb_); } \
      resc=false; \
      if(__builtin_expect(__any(rm>(float)THRL),0)){ const float dl=__builtin_fmaxf(rm,0.f); mhat+=dl; \
        _Pragma("unroll") for(int r=0;r<16;++r){C0[r]-=dl;C1[r]-=dl;} \
        if(UNEG){ _Pragma("unroll") for(int r=0;r<16;++r)negm[r]=-mhat; asm volatile("":"+v"(negm)); } \
        const float f=__builtin_amdgcn_exp2f(-dl); l_reg*=f; if(hi==0)wsf[r32]=f; resc=true; } } \
    SBAR(); \
    GAPB(o[0]=__builtin_amdgcn_mfma_f32_32x32x16_bf16(PAF(0),VFR(0),o[0],0,0,0), C0,0); \
    GAPB(o[1]=__builtin_amdgcn_mfma_f32_32x32x16_bf16(PAF(0),VFR(4),o[1],0,0,0), C0,4); \
    KRD(GL,0); GAPB(o[0]=__builtin_amdgcn_mfma_f32_32x32x16_bf16(PAF(1),VFR(1),o[0],0,0,0), C0,8); \
    KRD(GL,1); GAPB(o[1]=__builtin_amdgcn_mfma_f32_32x32x16_bf16(PAF(1),VFR(5),o[1],0,0,0), C0,12); \
    KRD(GL,2); GAPB(o[0]=__builtin_amdgcn_mfma_f32_32x32x16_bf16(PAF(2),VFR(2),o[0],0,0,0), C1,0); \
    KRD(GL,3); GAPB(o[1]=__builtin_amdgcn_mfma_f32_32x32x16_bf16(PAF(2),VFR(6),o[1],0,0,0), C1,4); \
    GAPB(o[0]=__builtin_amdgcn_mfma_f32_32x32x16_bf16(PAF(3),VFR(3),o[0],0,0,0), C1,8); \
    GAPB(o[1]=__builtin_amdgcn_mfma_f32_32x32x16_bf16(PAF(3),VFR(7),o[1],0,0,0), C1,12); \
    }while(0)
  int t=1;
  if(TYPE==0){
    for(;t+5<NT;t+=2){
      STEP(pB0,pB1,pA0,pA1,t,true,true,true);     WAIT_BAR(2); RESC(); ROT();
      STEP(pA0,pA1,pB0,pB1,t+1,true,true,true);   WAIT_BAR(2); RESC(); ROT();
    }
  }
  #define ENDW(tt) do{ if((tt)+3<NT){WAIT_BAR(2);} else if((tt)+2<NT){WAIT_BAR(1);} else {WAIT_BAR(0);} }while(0)
  for(;t+1<NT;t+=2){
    STEP(pB0,pB1,pA0,pA1,t,(t+3<NT),(t+1<NT),(t+1<NT));       ENDW(t);   RESC(); ROT();
    STEP(pA0,pA1,pB0,pB1,t+1,(t+4<NT),(t+2<NT),(t+2<NT));     ENDW(t+1); RESC(); ROT();
  }
  { const int n0=sl_next, n1=(n0==(NSLOT-1)*SLOTB)?0:n0+SLOTB, n2=(n1==(NSLOT-1)*SLOTB)?0:n1+SLOTB;
    if(has_nx){ const bf16*nk=P+(long)lane*PITCH+nx.kcol+wid*8+(long)nx.ctx0*PITCH; const bf16*nv=P+(long)(16*(wid&3)+(lane>>2))*PITCH+nx.vcol+(wid>>2)*32+(lane&3)*8+(long)nx.ctx0*PITCH;
      glds16(nk,(unsigned)__builtin_amdgcn_readfirstlane(kdst+n0)); glds16(nv,(unsigned)__builtin_amdgcn_readfirstlane(vdst+n0));
      glds16(nk+64L*PITCH,(unsigned)__builtin_amdgcn_readfirstlane(kdst+n1)); glds16(nk+128L*PITCH,(unsigned)__builtin_amdgcn_readfirstlane(kdst+n2)); }
    ring=n0; }
  STEP(pB0,pB1,pA0,pA1,NT-1,false,false,false); RESC();
  u32x4 gq[4];
  #pragma unroll
  for(int i=0;i<4;++i) gq[i]=*(const u32x4*)(P+(qrow+i*8+(lane>>3))*PITCH+GCOL+ucol+(lane&7)*8);
  { float sacc=pB0[0]+pB0[1]; _Pragma("unroll") for(int r=2;r<16;++r)sacc+=pB0[r]; _Pragma("unroll") for(int r=0;r<16;++r)sacc+=pB1[r]; l_reg+=sacc;
    pw0=(u32x4){PKW(pB0,0),PKW(pB0,2),PKW(pB0,4),PKW(pB0,6)};pw1=(u32x4){PKW(pB0,8),PKW(pB0,10),PKW(pB0,12),PKW(pB0,14)};pw2=(u32x4){PKW(pB1,0),PKW(pB1,2),PKW(pB1,4),PKW(pB1,6)};pw3=(u32x4){PKW(pB1,8),PKW(pB1,10),PKW(pB1,12),PKW(pB1,14)};
    SBAR(); pv(o,vb0+sl_cur,PAF(0),PAF(1),PAF(2),PAF(3)); }
  #undef PKW
  #undef PAF
  #undef VFR
  #undef PIN
  #undef MX3
  #undef GAPA
  #undef GAPB
  #undef EX
  #undef VRD
  #undef KRD
  #undef STEP
  #undef ENDW
  { float la,lb; swap32(l_reg,la,lb); l_reg=la+lb; }
  if(TYPE==2) l_reg+=__builtin_amdgcn_exp2f(sinkl[hq]*L2E-mhat);
  if(hi==0)wsf[32+r32]=l_reg;asm volatile("s_waitcnt lgkmcnt(0)":::"memory");
  float rli[16];
  #pragma unroll
  for(int r=0;r<16;++r)rli[r]=__builtin_amdgcn_rcpf(wsf[32+crow(r,hi)]);
  { float*stg=(float*)(shm+LDS_OST)+wid*(32*OSTR);
    #pragma unroll
    for(int r=0;r<16;++r){const int orow=crow(r,hi);
      #pragma unroll
      for(int d0=0;d0<2;++d0)stg[orow*OSTR+d0*32+r32]=o[d0][r]*rli[r];}
    asm volatile("s_waitcnt lgkmcnt(0)":::"memory");
    #pragma unroll
    for(int i=0;i<4;++i){const int row=i*8+(lane>>3),ch=lane&7;
      const f32x4 a=*(const f32x4*)(stg+row*OSTR+ch*8), b=*(const f32x4*)(stg+row*OSTR+ch*8+4);
      const u32x4 g=gq[i];
      u32x4 w;
      w.x=cvtpk_s(a[0]*__uint_as_float(g.x<<16),a[1]*__uint_as_float(g.x&0xffff0000u)); w.y=cvtpk_s(a[2]*__uint_as_float(g.y<<16),a[3]*__uint_as_float(g.y&0xffff0000u));
      w.z=cvtpk_s(b[0]*__uint_as_float(g.z<<16),b[1]*__uint_as_float(g.z&0xffff0000u)); w.w=cvtpk_s(b[2]*__uint_as_float(g.w<<16),b[3]*__uint_as_float(g.w&0xffff0000u));
      *(u32x4*)(U+(qrow+row)*UPITCH+ucol+ch*8)=w; } }
  asm volatile("s_waitcnt lgkmcnt(0)\n\ts_barrier":::"memory");
  #undef TROW
  #undef DMA_K
  #undef DMA_V
  #undef AMASK
  #undef START
  #undef NEGM
  #undef RESC
  #undef ROT
}
constexpr int THRL_DEFAULT=8;
__device__ __forceinline__ Unit unit_A(int ua){ Unit u; const int b=ua>>8,h=(ua>>5)&7,qb=ua&31; u.type=0; u.nt=132; u.nlat=128; u.ctx0=16384+256*b; u.lat0=8192*b; u.first=0;
  u.kcol=512+64*(h>>2); u.vcol=640+64*(h>>2); u.qrow0=8192*b+256*qb; u.tq0=256*qb; u.h0=h; u.gqa=0; u.bias_build=0; return u; }
__device__ __forceinline__ Unit unit_B(int ub){ Unit u; const int b=ub>>8,h=(ub>>5)&7,qb=ub&31; u.type=1;
  int f=4*qb-4; f=f<0?0:(f>120?120:f); int l=4*qb+3-4; l=l<0?0:(l>120?120:l); l+=7;
  u.first=f; u.nlat=l-f+1; u.nt=(4+u.nlat+1)&~1; u.ctx0=16384+256*b; u.lat0=8192*b+64*f;
  u.kcol=1280+64*h; u.vcol=1792+64*h; u.qrow0=8192*b+256*qb; u.tq0=256*qb; u.h0=h; u.gqa=0; u.bias_build=1; return u; }
__device__ __forceinline__ Unit unit_C(int uc){ Unit u; const int b=uc>>8,kvh=(uc>>7)&1,qb=uc&127; u.type=2;
  const int f=qb-2<0?0:qb-2, l=qb+2>127?127:qb+2;
  u.first=f; u.nlat=l-f+1; u.nt=(4+u.nlat+1)&~1; u.ctx0=16384+256*b; u.lat0=8192*b+64*f;
  u.kcol=2816+64*kvh; u.vcol=2944+64*kvh; u.qrow0=8192*b+64*qb; u.tq0=64*qb; u.h0=4*kvh; u.gqa=1; u.bias_build=0; return u; }
__device__ __forceinline__ Unit unit_ctx(int ux){ Unit u; const int type=ux>>4,b=(ux>>3)&1,h=ux&7; u.type=type; u.nt=4; u.nlat=0; u.ctx0=16384+256*b; u.lat0=0; u.first=0;
  const int kvh=(type==1)?h:(h>>2); u.kcol=(type==0?512:type==1?1280:2816)+64*kvh; u.vcol=(type==0?640:type==1?1792:2944)+64*kvh;
  u.qrow0=16384+256*b; u.tq0=0; u.h0=h; u.gqa=0; u.bias_build=1; return u; }
__device__ __forceinline__ void run_unit(const Unit&u,const Unit&nx,const bool has_nx,const bool pre,int&ring,const bf16*P,bf16*U,const float*rpbl,const float*sinkl,char*lds,const int wid,const bool nomaxA){
  if(u.type==0){ if(nomaxA) attn_unit<0,THRL_DEFAULT,true>(u,nx,has_nx,pre,ring,P,U,rpbl,sinkl,lds,wid); else attn_unit<0,THRL_DEFAULT,false>(u,nx,has_nx,pre,ring,P,U,rpbl,sinkl,lds,wid); }
  else if(u.type==1) attn_unit<1,THRL_DEFAULT,false>(u,nx,has_nx,pre,ring,P,U,rpbl,sinkl,lds,wid);
  else attn_unit<2,THRL_DEFAULT,false>(u,nx,has_nx,pre,ring,P,U,rpbl,sinkl,lds,wid);
}
__device__ __forceinline__ Unit get_unit(int vv,int i){ if(i<2) return unit_A(2*vv+i); if(i<4){ Unit u=unit_B(2*vv+i-2); u.bias_build=(i==2)?1:0; return u; } if(i<6) return unit_C(2*vv+i-4); return unit_ctx(vv); }
__device__ __forceinline__ void attn_phase(int vcu,int G,const bf16*P,bf16*U,const float*rpbl,const float*sinkl,const float*qnl,const float*knl,bool need_ctx,char*lds,const int wid){
  bool nomaxA; { const int l=lane_id_fresh(); float a=fabsf(qnl[l]),b=fabsf(knl[l]);
    a=wave_max(a); b=wave_max(b);
    nomaxA=__builtin_amdgcn_readfirstlane((int)(11.6f*a*b<80.f))!=0;
    float*tt=(float*)(lds+LDS_T); { const int i=wid*64+l; if(i<128){ const int x=i-48; tt[i]=(x>=0&&x<16)?0.f:-INFINITY; } }
    __syncthreads(); }
  int ring=0; bool pre=false;
  for(int vv=vcu;vv<256;vv+=G){
    const int n=6+((need_ctx&&vv<48)?1:0);
    for(int i=0;i<n;++i){
      const Unit cur=get_unit(vv,i); const bool has_nx=i+1<n; const Unit nx=get_unit(vv,has_nx?i+1:i);
      run_unit(cur,nx,has_nx,pre,ring,P,U,rpbl,sinkl,lds,wid,nomaxA); pre=has_nx; } }
}
#undef SBAR
#undef WAIT_BAR
}

__device__ __forceinline__ void phase_final_norm(const Ctx& F0, float* x, const float* w) {
    const Ctx F = fresh(F0);
    const int gw = F.vcu * NWAVES + F.wave, NGW = F.G * NWAVES, lane = F.lane;
    for (int row = gw; row < ML; row += NGW) {
        float* xr = x + (size_t)row * DM;
        f32x4 xv[4]; float ss = 0.f;
#pragma unroll
        for (int j = 0; j < 4; ++j) { xv[j] = *(const f32x4*)(xr + 256 * j + 4 * lane); ss += xv[j][0] * xv[j][0] + xv[j][1] * xv[j][1] + xv[j][2] * xv[j][2] + xv[j][3] * xv[j][3]; }
        const float rstd = rsqrtf(wave_sum(ss) * (1.f / DM) + EPS);
#pragma unroll
        for (int j = 0; j < 4; ++j) { const f32x4 wv = *(const f32x4*)(w + 256 * j + 4 * lane); f32x4 y = xv[j] * rstd * wv; *(f32x4*)(xr + 256 * j + 4 * lane) = y; }
    }
}

__device__ __forceinline__ void ctx_out_proj(const Ctx& F0, const bf16_t* U, const bf16_t* WT, const float* mod, const float* xctx_in, float* xctx_out) {
    const Ctx F = fresh(F0);
    const int lane = F.lane, fr = lane & 15, fq = lane >> 4, w = F.wave;
    LAS float* red = (LAS float*)F.lds;
    for (int it = F.vcu; it < 256; it += F.G) {
        const int row0 = ML + (it >> 4) * 32, col0 = (it & 15) * 64;
        f32x4 acc[2][4];
#pragma unroll
        for (int m = 0; m < 2; ++m)
#pragma unroll
            for (int n = 0; n < 4; ++n) acc[m][n] = (f32x4){0.f, 0.f, 0.f, 0.f};
        const bf16_t* ap = U + (size_t)(row0 + fr) * MIX + w * 192 + 8 * fq;
        const bf16_t* bp = WT + (size_t)(col0 + fr) * MIX + w * 192 + 8 * fq;
#pragma unroll
        for (int k0 = 0; k0 < 192; k0 += 32) {
            bf16x8 a[2], b[4];
#pragma unroll
            for (int m = 0; m < 2; ++m) a[m] = *(const bf16x8*)(ap + (size_t)(16 * m) * MIX + k0);
#pragma unroll
            for (int n = 0; n < 4; ++n) b[n] = *(const bf16x8*)(bp + (size_t)(16 * n) * MIX + k0);
#pragma unroll
            for (int m = 0; m < 2; ++m)
#pragma unroll
                for (int n = 0; n < 4; ++n) acc[m][n] = __builtin_amdgcn_mfma_f32_16x16x32_bf16(a[m], b[n], acc[m][n], 0, 0, 0);
        }
#pragma unroll
        for (int m = 0; m < 2; ++m)
#pragma unroll
            for (int n = 0; n < 4; ++n)
#pragma unroll
                for (int r = 0; r < 4; ++r) red[(w * 32 + 16 * m + 4 * fq + r) * 64 + 16 * n + fr] = acc[m][n][r];
        __syncthreads();
        const float* gate = mod + 2 * 3072 + 2048;
#pragma unroll
        for (int j = 0; j < 4; ++j) {
            const int idx = F.tid + 512 * j, row = idx >> 6, col = idx & 63;
            float s = 0.f;
#pragma unroll
            for (int ww = 0; ww < 8; ++ww) s += red[(ww * 32 + row) * 64 + col];
            const size_t o = (size_t)(row0 - ML + row) * DM + col0 + col;
            xctx_out[o] = xctx_in[o] + gate[col0 + col] * s;
        }
        __syncthreads();
    }
}

struct Args { const float* in[14]; float* out; unsigned char* ws; int ph_lo, ph_hi; };
__global__ void __launch_bounds__(NTHREADS, 2) fwd_kernel(Args args) {
    extern __shared__ __attribute__((aligned(16))) unsigned char lds[];
    Ctx F;
    F.lds = (LAS unsigned char*)lds;
    F.wave = __builtin_amdgcn_readfirstlane((int)threadIdx.x >> 6); F.lane = lane_id_fresh(); F.tid = F.wave * 64 + F.lane;
    F.G = gridDim.x; { const int bx = blockIdx.x; F.vcu = (F.G % 8 == 0) ? (bx % 8) * (F.G / 8) + bx / 8 : bx; }
    volatile LAS unsigned* MISC = (volatile LAS unsigned*)(F.lds + MISC_OFF);
    for (int u = F.tid; u < (LDS_BYTES - LDSCTL_OFF) / 4; u += NTHREADS) ((LAS unsigned*)(F.lds + LDSCTL_OFF))[u] = 0u;
    __syncthreads();
    unsigned char* ws = args.ws;
    unsigned* ctl = (unsigned*)(ws + WS_CTL);
    XcdBarrier bar; bar.bar = ctl + CW_BAR; bar.x = 0; bar.st = nullptr;
    if (!MK_PER_PHASE) bar = xcd_barrier_post(ctl + CW_BAR, MISC + 8);
    const float* x = args.in[0]; const float* c = args.in[1]; const float* ctxin = args.in[2]; const float* c_ctx = args.in[3];
    const float* norm_w = args.in[4]; const float* ada_w = args.in[5]; const float* ada_b = args.in[6];
    const float* w_in = args.in[7]; const float* w_out = args.in[8]; const float* qn = args.in[9]; const float* kn = args.in[10];
    const float* rpb = args.in[11]; const float* sink = args.in[12]; const float* fnw = args.in[13];
    float* out = args.out;
    float* tab = (float*)(ws + WS_TAB); float* mod = (float*)(ws + WS_MOD);
    bf16_t* wtin = (bf16_t*)(ws + WS_WTIN); bf16_t* wtout = (bf16_t*)(ws + WS_WTOUT); float* xctx = (float*)(ws + WS_XCTX);
    bf16_t* HX = (bf16_t*)(ws + WS_HXU); bf16_t* U = (bf16_t*)(ws + WS_HXU); bf16_t* P = (bf16_t*)(ws + WS_P);
    const int lo = args.ph_lo, hi = args.ph_hi;
#define IN(k) (lo <= (k) && (k) < hi)
#define SEAM(k) do { if (IN(k) && IN((k) + 1)) xcd_barrier(bar, F.wave); } while (0)
    if (IN(0)) { phase_prologue(F, w_in, w_out, c, c_ctx, ada_w, ada_b, wtin, wtout, tab, mod); }
    SEAM(0);
#pragma unroll 1
    for (int l = 0; l < 2; ++l) {
        const float* xl = l == 0 ? x : out; const float* xc = l == 0 ? ctxin : xctx;
        const float* modl = mod + (size_t)l * 3 * 3072;
        const int pb = 1 + 4 * l;
        if (IN(pb)) { phase_norm_mod(F, xl, xc, norm_w + l * DM, modl, HX); if (PROBE_REP & 4) phase_norm_mod(F, xl, xc, norm_w + l * DM, modl, HX); }
        SEAM(pb);
        if (IN(pb + 1)) { pg8::Gemm g{HX, wtin + (size_t)l * NIN * DM, MT, NIN, DM}; pg8::StaticOrder S; S.init(MT, NIN, F.G, (int)blockIdx.x);
            pg8::EpiIn E{P, qn + l * 64, kn + l * 64, tab};
            pg8::gemm_phase<pg8::EpiIn, pg8::StaticOrder, true, true>(F.lds, g, S, E, F.wave);
            if (PROBE_REP & 2) pg8::gemm_phase<pg8::EpiIn, pg8::StaticOrder, true, true>(F.lds, g, S, E, F.wave); }
        SEAM(pb + 1);
        if (IN(pb + 2)) { att::attn_phase(F.vcu, F.G, P, U, rpb + (size_t)l * 8 * 465, sink + l * 8, qn + l * 64, kn + l * 64, l == 0, (char*)lds, F.wave);
            if (PROBE_REP & 1) att::attn_phase(F.vcu, F.G, P, U, rpb + (size_t)l * 8 * 465, sink + l * 8, qn + l * 64, kn + l * 64, l == 0, (char*)lds, F.wave); }
        SEAM(pb + 2);
        if (IN(pb + 3)) { if (l == 0) ctx_out_proj(F, U, wtout, modl, xc, xctx);
            const int mrows = ML; pg8::Gemm g{U, wtout + (size_t)l * DM * MIX, mrows, DM, MIX}; pg8::StaticOrder S; S.init(mrows, DM, F.G, (int)blockIdx.x);
            pg8::EpiOut E{modl, xl, xc, out, xctx};
            pg8::gemm_phase<pg8::EpiOut, pg8::StaticOrder, true, true>(F.lds, g, S, E, F.wave);
            if ((PROBE_REP & 8) && l == 0) pg8::gemm_phase<pg8::EpiOut, pg8::StaticOrder, true, true>(F.lds, g, S, E, F.wave); }
        SEAM(pb + 3);
    }
    if (IN(9)) phase_final_norm(F, out, fnw);
#undef IN
#undef SEAM
}

extern "C" void kernel_launch(void* const* d_in, const int* in_sizes, int n_in, void* d_out, int out_size, void* d_ws, size_t ws_size, hipStream_t stream) {
    static int grid = 0;
    if (grid == 0) {
        int dev = 0, cus = 0, per_cu = 0;
        if (n_in != 14 || ws_size < WS_END) { fprintf(stderr, "kernel_launch: unexpected inputs / workspace\n"); grid = -1; return; }
        if (hipGetDevice(&dev) != hipSuccess || hipDeviceGetAttribute(&cus, hipDeviceAttributeMultiprocessorCount, dev) != hipSuccess) { grid = -1; return; }
        if (hipFuncSetAttribute((const void*)fwd_kernel, hipFuncAttributeMaxDynamicSharedMemorySize, LDS_BYTES) != hipSuccess) { fprintf(stderr, "kernel_launch: hipFuncSetAttribute failed\n"); grid = -1; return; }
        if (hipOccupancyMaxActiveBlocksPerMultiprocessor(&per_cu, (const void*)fwd_kernel, NTHREADS, LDS_BYTES) != hipSuccess || per_cu < 1) { fprintf(stderr, "kernel_launch: occupancy query says %d\n", per_cu); }
        (void)hipGetLastError();
        grid = cus;
    }
    if (grid < 0) return;
    (void)hipMemsetAsync((char*)d_ws + WS_CTL, 0, CTL_ZERO_BYTES, stream);
    Args a{};
    for (int i = 0; i < 14; ++i) a.in[i] = (const float*)d_in[i];
    a.out = (float*)d_out; a.ws = (unsigned char*)d_ws;
#if MK_PER_PHASE
    for (int p = 0; p < NPHASES; ++p) { a.ph_lo = p; a.ph_hi = p + 1; hipLaunchKernelGGL(fwd_kernel, dim3(grid), dim3(NTHREADS), LDS_BYTES, stream, a); }
#else
    a.ph_lo = 0; a.ph_hi = NPHASES;
    hipLaunchKernelGGL(fwd_kernel, dim3(grid), dim3(NTHREADS), LDS_BYTES, stream, a);
#endif
}
```

```cpp
#include <hip/hip_runtime.h>
#include <cstdint>
#include <cstdio>

typedef unsigned short bf16_t;
typedef short bf16x8 __attribute__((ext_vector_type(8)));
typedef float f32x4 __attribute__((ext_vector_type(4)));
typedef unsigned u32x4 __attribute__((ext_vector_type(4)));
#define GAS __attribute__((address_space(1)))
#define LAS __attribute__((address_space(3)))

constexpr int DM = 1024, NB = 2, SEQ = 8192, CTX = 256;
constexpr int ML = NB * SEQ;
constexpr int MT = ML + NB * CTX;
constexpr int NIN = 4608, MIX = 1536;
constexpr int C_QA = 0, C_KA = 512, C_VA = 640, C_QB = 768, C_KB = 1280, C_VB = 1792, C_QC = 2304, C_KC = 2816, C_VC = 2944, C_G = 3072;
constexpr float LOG2E = 1.4426950408889634f;
constexpr float QSCALE = 0.125f * LOG2E;
constexpr float EPS = 1e-6f;
constexpr int NWAVES = 8, NTHREADS = 512;
#ifndef MK_PER_PHASE
#define MK_PER_PHASE 0
#endif
#ifndef PROBE_REP
#define PROBE_REP 0
#endif
constexpr int NPHASES = 9;

constexpr size_t MiB = 1u << 20;
constexpr size_t WS_CTL = 0, CTL_ZERO_BYTES = 1 * MiB;
constexpr size_t WS_MOD = 65536;
constexpr size_t WS_SS = 262144;
constexpr size_t WS_TAB = 524288;
constexpr size_t WS_SW = 589824;
constexpr size_t WS_WTIN = 1 * MiB;
constexpr size_t WS_WTOUT = 19 * MiB;
constexpr size_t WS_HX = 25 * MiB;
constexpr size_t WS_U = 58 * MiB;
constexpr size_t WS_P = WS_U + (size_t)MT * MIX * 2;
constexpr size_t WS_END = WS_P + (size_t)MT * NIN * 2;
static_assert(WS_SW + 3 * 4608 * 4 <= CTL_ZERO_BYTES && WS_SS + MT * 4 <= WS_TAB && WS_HX + (size_t)MT * DM * 2 <= WS_U, "ws map");
static_assert(WS_END <= 256 * MiB, "ws map");
constexpr int CW_BAR = 4096;
constexpr int RING_BYTES = 131072, LDSCTL_OFF = RING_BYTES, MISC_OFF = LDSCTL_OFF + 320, LDS_BYTES = 147456;

__device__ __forceinline__ unsigned f2bf(float f) { unsigned u = __builtin_bit_cast(unsigned, f); return (u + 0x7fffu + ((u >> 16) & 1u)) >> 16; }
__device__ __forceinline__ float bf2f(unsigned h) { return __builtin_bit_cast(float, h << 16); }
__device__ __forceinline__ unsigned pk2(float lo, float hi) { return f2bf(lo) | (f2bf(hi) << 16); }
__device__ __forceinline__ float silu_f(float v) { return v / (1.f + __expf(-v)); }
template <int M> __device__ __forceinline__ float swz_xor(float v) { return __builtin_bit_cast(float, __builtin_amdgcn_ds_swizzle(__builtin_bit_cast(int, v), (M << 10) | 0x1f)); }
__device__ __forceinline__ void swap32(float v, float& lo, float& hi) { float a = v, b = v; asm volatile("s_nop 1\n\tv_permlane32_swap_b32 %0, %1" : "+v"(a), "+v"(b)); lo = a; hi = b; }
__device__ __forceinline__ float half_sum(float v) { float a, b; swap32(v, a, b); return a + b; }
__device__ __forceinline__ float half_max(float v) { float a, b; swap32(v, a, b); return fmaxf(a, b); }
__device__ __forceinline__ float wave_sum(float v) {
    v += swz_xor<1>(v); v += swz_xor<2>(v); v += swz_xor<4>(v); v += swz_xor<8>(v); v += swz_xor<16>(v);
    return half_sum(v);
}
__device__ __forceinline__ float wave_max(float v) {
    v = fmaxf(v, swz_xor<1>(v)); v = fmaxf(v, swz_xor<2>(v)); v = fmaxf(v, swz_xor<4>(v)); v = fmaxf(v, swz_xor<8>(v)); v = fmaxf(v, swz_xor<16>(v));
    return half_max(v);
}
#define LDS_WAIT() asm volatile("s_waitcnt lgkmcnt(0)" ::: "memory")
__device__ __forceinline__ int lane_id_fresh() { int l; asm volatile("v_mbcnt_lo_u32_b32 %0, -1, 0\n\tv_mbcnt_hi_u32_b32 %0, -1, %0" : "=v"(l)); return l; }

#define XB_TMO      128
#define XB_XCNT(j)  (256  + 64 * (j))
#define XB_XSUB(j)  (1280 + 64 * (j))
#define XB_XGEN(j)  (2304 + 64 * (j))
#define XB_TOP      3328
#define XB_TOPGEN   3392
#define XCD_BAR_WORDS 3456
#define XB_SPIN_CAP (1u << 18)
__device__ __forceinline__ unsigned xb_ld(unsigned* p)              { return __hip_atomic_load(p, __ATOMIC_RELAXED, __HIP_MEMORY_SCOPE_AGENT); }
__device__ __forceinline__ unsigned xb_add(unsigned* p, unsigned v) { return __hip_atomic_fetch_add(p, v, __ATOMIC_RELAXED, __HIP_MEMORY_SCOPE_AGENT); }
__device__ __forceinline__ unsigned xb_xcc_id() { return (unsigned)__builtin_amdgcn_s_getreg((3 << 11) | 20) & 0xFu; }
#define XB_SPIN(cond, bar) do { unsigned _sp = 0; while (cond) { __builtin_amdgcn_s_sleep(1); \
    if ((++_sp & 255u) == 0u) { if (xb_ld(&(bar)[XB_TMO])) break; if (_sp > XB_SPIN_CAP) { atomicAdd(&(bar)[XB_TMO], 1u); break; } } } } while (0)
struct XcdBarrier { unsigned* bar; unsigned x; volatile LAS unsigned* st; };
__device__ __forceinline__ XcdBarrier xcd_barrier_post(unsigned* bar, volatile LAS unsigned* st) {
    XcdBarrier b; b.bar = bar; b.x = xb_xcc_id(); b.st = st;
    if (threadIdx.x == 0) (void)xb_add(&bar[XB_XCNT(b.x)], 1u);
    return b;
}
__device__ __forceinline__ void xcd_barrier_complete(unsigned* bar, unsigned x, unsigned& nloc, unsigned& nx) {
    const unsigned G = gridDim.x * gridDim.y * gridDim.z;
    unsigned sum, cnt, mine, sp = 0u;
    for (;;) {
        sum = 0u; cnt = 0u; mine = 0u;
#pragma unroll
        for (unsigned j = 0; j < 16; ++j) { const unsigned c = xb_ld(&bar[XB_XCNT(j)]); sum += c; cnt += (c > 0u) ? 1u : 0u; mine = (j == x) ? c : mine; }
        if (sum == G) break;
        __builtin_amdgcn_s_sleep(1);
        if ((++sp & 255u) == 0u) { if (xb_ld(&bar[XB_TMO])) break; if (sp > XB_SPIN_CAP) { atomicAdd(&bar[XB_TMO], 1u); break; } }
    }
    nloc = mine > 0u ? mine : 1u; nx = cnt > 0u ? cnt : 1u;
}
__device__ __forceinline__ void xcd_barrier(const XcdBarrier& b, const int wave) {
    asm volatile("s_waitcnt vmcnt(0)" ::: "memory");
    __syncthreads();
    if (wave == 0 && lane_id_fresh() == 0) {
        unsigned* bar = b.bar; asm volatile("" : "+s"(bar));
        __builtin_amdgcn_s_waitcnt(0);
        unsigned nloc = b.st[0], nx = b.st[1];
        if (nloc == 0u) { xcd_barrier_complete(bar, b.x, nloc, nx); b.st[0] = nloc; b.st[1] = nx; }
        const unsigned old = xb_add(&bar[XB_XSUB(b.x)], 1u);
        const unsigned gen = old / nloc;
        if (old + 1u == (gen + 1u) * nloc) {
            __builtin_amdgcn_fence(__ATOMIC_RELEASE, "agent");
            asm volatile("s_waitcnt vmcnt(0)" ::: "memory");
            const unsigned og = xb_add(&bar[XB_TOP], 1u);
            const unsigned tg = og / nx;
            if (og + 1u == (tg + 1u) * nx) xb_add(&bar[XB_TOPGEN], 1u);
            else XB_SPIN(xb_ld(&bar[XB_TOPGEN]) == tg, bar);
            __builtin_amdgcn_fence(__ATOMIC_ACQUIRE, "agent");
            xb_add(&bar[XB_XGEN(b.x)], 1u);
            asm volatile("s_waitcnt vmcnt(0)" ::: "memory");
        } else {
            XB_SPIN(xb_ld(&bar[XB_XGEN(b.x)]) == gen, bar);
            __builtin_amdgcn_fence(__ATOMIC_ACQUIRE, "agent");
            asm volatile("s_waitcnt vmcnt(0)" ::: "memory");
        }
    }
    __syncthreads();
}

namespace pg8 {
#define PG8_LAS __attribute__((address_space(3)))
typedef unsigned short bf16_t;
typedef short bf16x8 __attribute__((ext_vector_type(8)));
typedef float f32x4 __attribute__((ext_vector_type(4)));
typedef unsigned u32x4 __attribute__((ext_vector_type(4)));
constexpr int BM = 256, BK = 64, HALF = 128, HTB = HALF * BK * 2  , STAGE_BYTES = 8 * HTB, NXCD = 8, WGM = 8;

__host__ __device__ __forceinline__ int lds_byte(int r, int c) { const int st = (r >> 4) * 2 + (c >> 5), rr = r & 15, cc = c & 31, ob = rr * 64 + cc * 2; return st * 1024 + (ob ^ (((ob >> 9) & 1) << 5)); }
__host__ __device__ __forceinline__ void stage_rc(int b, int& R, int& C) { const int st = b / 1024, sb = b % 1024, swz = sb ^ (((sb >> 9) & 1) << 5); R = (st >> 1) * 16 + swz / 64; C = (st & 1) * 32 + (swz % 64) / 2; }
__host__ __device__ __forceinline__ int perm32(int rho) { const int n = rho >> 4, i = rho & 15; return 8 * (i >> 2) + 4 * n + (i & 3); }

struct Unit { int pm, pn; };
struct Gemm { const bf16_t* A; const bf16_t* Bt; int M, N, K; };

struct StaticOrder {
    int nM, nN, nwg, G, c;
    __host__ __device__ void init(int M, int N, int G_, int c_) { nM = M / BM; nN = N / BM; nwg = nM * nN; G = G_; c = c_; }
    __host__ __device__ bool next(int i, Unit& u) const {
        const long L = (long)i * G + c; if (L >= nwg) return false;
        int wgid = (int)L; { const int q = nwg / NXCD, r = nwg % NXCD, xcd = wgid % NXCD, off = wgid / NXCD; wgid = (xcd < r ? xcd * (q + 1) : r * (q + 1) + (xcd - r) * q) + off; }
        const int nig = WGM * nN, gid = wgid / nig, fm = gid * WGM, gsz = (nM - fm) < WGM ? (nM - fm) : WGM;
        u.pm = fm + ((wgid % nig) % gsz); u.pn = (wgid % nig) / gsz; return true;
    }
    __device__ __forceinline__ bool has(int i) const { return (long)i * G + c < nwg; }
    __device__ __forceinline__ void a_ready(const Unit&) const {}
    __device__ __forceinline__ void done(const Unit&) const {}
};
__device__ __forceinline__ unsigned cvt_pk_bf16(float lo, float hi) { unsigned r; asm volatile("v_cvt_pk_bf16_f32 %0, %1, %2" : "=v"(r) : "v"(lo), "v"(hi)); return r; }
typedef float f32x2 __attribute__((ext_vector_type(2)));
struct EpiIn {
    static constexpr bool PERM = true, AFTER_DRAIN = false;
    bf16_t* P; const float* qn; const float* kn; const float* tab;
    const float* ss; const float* sw; int defer;
    __device__ __forceinline__ void operator()(const f32x4 (&acc)[2][2][4][2], const Unit& u, int wr, int wc, int fr, int fq) const {
        const int col0 = u.pn * BM + wc * 64;
        f32x4 cl[2][2];
        if (defer) { const float* swv = sw + (size_t)(u.pm < 64 ? (u.pm >> 5) : 2) * 4608 + col0 + 8 * fq;
#pragma unroll
            for (int bj = 0; bj < 2; ++bj)
#pragma unroll
                for (int n = 0; n < 2; ++n) cl[bj][n] = *(const f32x4*)(swv + 32 * bj + 4 * n); }
        int kind;
        if (col0 < 512) kind = 1; else if (col0 < 640) kind = 2; else if (col0 < 768) kind = 0; else if (col0 < 1280) kind = 3; else if (col0 < 2304) kind = 0;
        else if (col0 < 2816) kind = 4; else if (col0 < 2944) kind = 5; else if (col0 < 3072) kind = 0; else kind = 6;
        kind = __builtin_amdgcn_readfirstlane(kind);
        const bool latent = u.pm < 64;
        const bool do_norm = kind == 1 || kind == 2, do_rope = (kind == 1 || kind == 2 || kind == 4 || kind == 5) && latent, do_scale = kind == 1 || kind == 3 || kind == 4;
        f32x4 wlo[2], whi[2];
        if (do_norm) { const float* w = kind == 1 ? qn : kn;
#pragma unroll
            for (int n = 0; n < 2; ++n) { wlo[n] = *(const f32x4*)(w + 8 * fq + 4 * n); whi[n] = *(const f32x4*)(w + 32 + 8 * fq + 4 * n); } }
#pragma unroll
        for (int ai = 0; ai < 2; ++ai)
#pragma unroll
            for (int m = 0; m < 4; ++m) {
                const int row = u.pm * BM + ai * HALF + wr * 64 + m * 16 + fr;
                f32x4 lo[2], hi[2];
#pragma unroll
                for (int n = 0; n < 2; ++n) { lo[n] = acc[ai][0][m][n]; hi[n] = acc[ai][1][m][n]; }
                if (defer) { const float rs = rsqrtf(ss[row] * (1.f / 1024.f) + 1e-6f);
#pragma unroll
                    for (int n = 0; n < 2; ++n) { lo[n] = lo[n] * rs + cl[0][n]; hi[n] = hi[n] * rs + cl[1][n]; } }
                if (do_norm) {
                    float ss = 0.f;
#pragma unroll
                    for (int n = 0; n < 2; ++n)
#pragma unroll
                        for (int j = 0; j < 4; ++j) ss += lo[n][j] * lo[n][j] + hi[n][j] * hi[n][j];
                    ss += swz_xor<16>(ss); ss = half_sum(ss);
                    const float rstd = rsqrtf(ss * (1.f / 64.f) + 1e-6f);
#pragma unroll
                    for (int n = 0; n < 2; ++n) { lo[n] = lo[n] * rstd * wlo[n]; hi[n] = hi[n] * rstd * whi[n]; }
                }
                if (do_rope) {
                    const int pr = (4 * u.pm + 2 * ai + wr) & 127, pc = 16 * m + fr;
                    const int pos = fq < 2 ? pr : pc;
                    const float* tp = tab + (pos * 16 + 8 * (fq & 1)) * 2;
#pragma unroll
                    for (int n = 0; n < 2; ++n) {
                        const f32x4 t0 = *(const f32x4*)(tp + 8 * n), t1 = *(const f32x4*)(tp + 8 * n + 4);
                        const float cs[4] = {t0[0], t0[2], t1[0], t1[2]}, sn[4] = {t0[1], t0[3], t1[1], t1[3]};
#pragma unroll
                        for (int j = 0; j < 4; ++j) { const float a = lo[n][j], b = hi[n][j]; lo[n][j] = a * cs[j] - b * sn[j]; hi[n][j] = a * sn[j] + b * cs[j]; }
                    }
                }
                if (do_scale) {
#pragma unroll
                    for (int n = 0; n < 2; ++n) { lo[n] = lo[n] * (0.125f * 1.4426950408889634f); hi[n] = hi[n] * (0.125f * 1.4426950408889634f); }
                }
                if (kind == 6) {
#pragma unroll
                    for (int n = 0; n < 2; ++n)
#pragma unroll
                        for (int j = 0; j < 4; ++j) { lo[n][j] = lo[n][j] / (1.f + __expf(-lo[n][j])); hi[n][j] = hi[n][j] / (1.f + __expf(-hi[n][j])); }
                }
                bf16_t* rowp = P + (size_t)row * 4608 + col0 + 8 * fq;
                u32x4 w0, w1;
                w0.x = cvt_pk_bf16(lo[0][0], lo[0][1]); w0.y = cvt_pk_bf16(lo[0][2], lo[0][3]); w0.z = cvt_pk_bf16(lo[1][0], lo[1][1]); w0.w = cvt_pk_bf16(lo[1][2], lo[1][3]);
                w1.x = cvt_pk_bf16(hi[0][0], hi[0][1]); w1.y = cvt_pk_bf16(hi[0][2], hi[0][3]); w1.z = cvt_pk_bf16(hi[1][0], hi[1][1]); w1.w = cvt_pk_bf16(hi[1][2], hi[1][3]);
                *(u32x4*)rowp = w0; *(u32x4*)(rowp + 32) = w1;
            }
    }
};
struct EpiOut {
    static constexpr bool PERM = false, AFTER_DRAIN = false;
    const float* mod; const float* xin; float* xout; int emit; const float* nw_next; const float* mod_next; bf16_t* An; float* ss;
    __device__ __forceinline__ void operator()(const f32x4 (&acc)[2][2][4][2], const Unit& u, int wr, int wc, int fr, int fq) const {
        const int v = u.pm >> 5;
        const float* gate = mod + (size_t)v * 3072 + 2048;
        const int col0 = u.pn * BM + wc * 32 + 4 * fq;
        f32x4 g[2][2], gn[2][2];
#pragma unroll
        for (int bj = 0; bj < 2; ++bj)
#pragma unroll
            for (int n = 0; n < 2; ++n) { g[bj][n] = *(const f32x4*)(gate + col0 + bj * HALF + n * 16);
                if (emit) gn[bj][n] = *(const f32x4*)(nw_next + col0 + bj * HALF + n * 16) * (*(const f32x4*)(mod_next + (size_t)v * 3072 + 1024 + col0 + bj * HALF + n * 16) + 1.0f); }
#pragma unroll
        for (int ai = 0; ai < 2; ++ai)
#pragma unroll
            for (int m = 0; m < 4; ++m) { const int row = u.pm * BM + ai * HALF + wr * 64 + m * 16 + fr; const size_t off = (size_t)row * 1024 + col0;
                float sq = 0.f;
#pragma unroll
                for (int bj = 0; bj < 2; ++bj)
#pragma unroll
                    for (int n = 0; n < 2; ++n) { const f32x4 xo = *(const f32x4*)(xin + off + bj * HALF + n * 16); const f32x4 xn = xo + g[bj][n] * acc[ai][bj][m][n];
                        *(f32x4*)(xout + off + bj * HALF + n * 16) = xn;
                        if (emit) { sq += (xn[0] * xn[0] + xn[1] * xn[1]) + (xn[2] * xn[2] + xn[3] * xn[3]); const f32x4 a = xn * gn[bj][n];
                            uint2 w; w.x = cvt_pk_bf16(a[0], a[1]); w.y = cvt_pk_bf16(a[2], a[3]); *(uint2*)(An + off + bj * HALF + n * 16) = w; } }
                if (emit) { sq += swz_xor<16>(sq); sq = half_sum(sq); if (fq == 0) atomicAdd(ss + row, sq); }
            }
    }
};
template <class Epi, class Sched, bool ALIGN_EPI = false, bool SP2 = false>
__device__ __forceinline__ void gemm_phase(PG8_LAS unsigned char* lds, const Gemm g, const Sched& S, const Epi& E, const int wid  ) {
    int lane; asm volatile("v_mbcnt_lo_u32_b32 %0, -1, 0\n\tv_mbcnt_hi_u32_b32 %0, -1, %0" : "=v"(lane));
    const int tid = wid * 64 + lane, wr = wid >> 2, wc = wid & 3, fr = lane & 15, fq = lane >> 4;
    const int K = g.K, nt = K / BK;
    unsigned voffA[2], voffB[2];
#pragma unroll
    for (int i = 0; i < 2; ++i) { int R, C; stage_rc(tid * 16 + i * 8192, R, C); const int Rb = Epi::PERM ? ((R & ~31) + perm32(R & 31)) : R;
        voffA[i] = (unsigned)(R * K + C) * 2u; voffB[i] = (unsigned)(Rb * K + C) * 2u; }
    const size_t kstep = (size_t)(BK * 2);
    const size_t hstep = (size_t)HALF * K * 2;
    const size_t tstep = 2 * hstep;
    const unsigned ldsw = (unsigned)wid * 1024u;
    const int aoff = lds_byte(wr * 64 + fr, fq * 8), boff = lds_byte(wc * 32 + fr, fq * 8);
#define PG8_SA(b, h) (((b) * 2 + (h)) * HTB)
#define PG8_SB(b, h) ((4 + (b) * 2 + (h)) * HTB)
#define PG8_STAGE(bufoff, gbase, voff) do { _Pragma("unroll") for (int _i = 0; _i < 2; ++_i) \
        __builtin_amdgcn_global_load_lds((const unsigned*)((const char*)(gbase) + (voff)[_i]), (PG8_LAS unsigned*)(lds + (bufoff) + ldsw + _i * 8192), 16, 0, 0); } while (0)
#define PG8_LDA(dst, b, h) do { _Pragma("unroll") for (int m = 0; m < 4; ++m) _Pragma("unroll") for (int k = 0; k < 2; ++k) dst[m][k] = *(const PG8_LAS bf16x8*)(lds + PG8_SA(b, h) + aoff + m * 2048 + k * 1024); } while (0)
#define PG8_LDB(dst, b, h) do { _Pragma("unroll") for (int n = 0; n < 2; ++n) _Pragma("unroll") for (int k = 0; k < 2; ++k) dst[n][k] = *(const PG8_LAS bf16x8*)(lds + PG8_SB(b, h) + boff + n * 2048 + k * 1024); } while (0)
#define PG8_MMA(ai, bj, At, Bt) do { __builtin_amdgcn_s_setprio(1); _Pragma("unroll") for (int m = 0; m < 4; ++m) _Pragma("unroll") for (int n = 0; n < 2; ++n) _Pragma("unroll") for (int k = 0; k < 2; ++k) \
        acc[ai][bj][m][n] = __builtin_amdgcn_mfma_f32_16x16x32_bf16(Bt[n][k], At[m][k], acc[ai][bj][m][n], 0, 0, 0); __builtin_amdgcn_s_setprio(0); } while (0)
#define PG8_WAIT_V(n) asm volatile("s_waitcnt vmcnt(" #n ")" ::: "memory")
#define PG8_WAIT_L(n) asm volatile("s_waitcnt lgkmcnt(" #n ")" ::: "memory")
#define PG8_BAR __builtin_amdgcn_s_barrier()
#define PG8_SCHED __builtin_amdgcn_sched_barrier(0)
    Unit cur, nxt; int ui = 0;
    if (!S.next(0, cur)) return;
    f32x4 acc[2][2][4][2];
#pragma unroll
    for (int a = 0; a < 2; ++a)
#pragma unroll
        for (int b = 0; b < 2; ++b)
#pragma unroll
            for (int m = 0; m < 4; ++m)
#pragma unroll
                for (int n = 0; n < 2; ++n) acc[a][b][m][n] = (f32x4){0.f, 0.f, 0.f, 0.f};
    bf16x8 At[4][2], B0[2][2], B1[2][2];
    const char* cA = (const char*)g.A + (size_t)cur.pm * tstep; const char* cB = (const char*)g.Bt + (size_t)cur.pn * tstep;
    S.a_ready(cur);
    if constexpr (SP2) {
        PG8_STAGE(PG8_SB(0, 0), cB, voffB); PG8_STAGE(PG8_SB(0, 1), cB + hstep, voffB); PG8_STAGE(PG8_SA(0, 0), cA, voffA); PG8_STAGE(PG8_SA(0, 1), cA + hstep, voffA);
        if (wr == 1) PG8_BAR;
        PG8_WAIT_V(2); PG8_BAR;
        PG8_STAGE(PG8_SB(1, 0), cB + kstep, voffB); PG8_STAGE(PG8_SA(1, 0), cA + kstep, voffA); PG8_STAGE(PG8_SB(1, 1), cB + hstep + kstep, voffB);
        PG8_WAIT_V(6); PG8_BAR;
    } else {
        PG8_STAGE(PG8_SB(0, 0), cB, voffB); PG8_STAGE(PG8_SA(0, 0), cA, voffA); PG8_STAGE(PG8_SB(0, 1), cB + hstep, voffB); PG8_STAGE(PG8_SA(0, 1), cA + hstep, voffA);
        if (wr == 1) PG8_BAR;
        PG8_WAIT_V(4); PG8_BAR;
        PG8_STAGE(PG8_SB(1, 0), cB + kstep, voffB); PG8_STAGE(PG8_SA(1, 0), cA + kstep, voffA); PG8_STAGE(PG8_SB(1, 1), cB + hstep + kstep, voffB);
        PG8_WAIT_V(6); PG8_BAR;
    }
    for (;;) {
        const bool has_next = S.next(ui + 1, nxt);
        const char* nA = has_next ? (const char*)g.A + (size_t)nxt.pm * tstep : cA; const char* nB = has_next ? (const char*)g.Bt + (size_t)nxt.pn * tstep : cB;
        for (int t = 0; t < nt; t += 2) {
            const bool last = (t == nt - 2);
            const char* a1 = cA + (size_t)(t + 1) * kstep;
            const char* a2 = last ? nA : cA + (size_t)(t + 2) * kstep; const char* b2 = last ? nB : cB + (size_t)(t + 2) * kstep;
            const char* a3 = a2 + kstep; const char* b3 = b2 + kstep;
            if (last && has_next) S.a_ready(nxt);
            if constexpr (SP2) {
            PG8_LDB(B0, 0, 0); PG8_LDB(B1, 0, 1); PG8_SCHED; PG8_LDA(At, 0, 0); PG8_STAGE(PG8_SA(1, 1), a1 + hstep, voffA);
            PG8_WAIT_V(8); PG8_WAIT_L(0); PG8_BAR; PG8_MMA(0, 0, At, B0); PG8_MMA(0, 1, At, B1); PG8_BAR; PG8_SCHED;
            PG8_LDA(At, 0, 1); PG8_STAGE(PG8_SB(0, 0), b2, voffB); PG8_STAGE(PG8_SB(0, 1), b2 + hstep, voffB); PG8_STAGE(PG8_SA(0, 0), a2, voffA);
            PG8_WAIT_V(8); PG8_WAIT_L(0); PG8_BAR; PG8_MMA(1, 0, At, B0); PG8_MMA(1, 1, At, B1); PG8_BAR; PG8_SCHED;
            PG8_LDB(B0, 1, 0); PG8_LDB(B1, 1, 1); PG8_SCHED; PG8_LDA(At, 1, 0); PG8_STAGE(PG8_SA(0, 1), a2 + hstep, voffA);
            PG8_WAIT_V(8); PG8_WAIT_L(0); PG8_BAR; PG8_MMA(0, 0, At, B0); PG8_MMA(0, 1, At, B1); PG8_BAR; PG8_SCHED;
            PG8_LDA(At, 1, 1); PG8_STAGE(PG8_SB(1, 0), b3, voffB); PG8_STAGE(PG8_SB(1, 1), b3 + hstep, voffB); PG8_STAGE(PG8_SA(1, 0), a3, voffA);
            PG8_WAIT_V(8); PG8_WAIT_L(0); PG8_BAR; PG8_MMA(1, 0, At, B0); PG8_MMA(1, 1, At, B1); PG8_BAR; PG8_SCHED;
            } else {
            PG8_LDB(B0, 0, 0); PG8_SCHED; PG8_LDA(At, 0, 0); PG8_STAGE(PG8_SA(1, 1), a1 + hstep, voffA);
            PG8_WAIT_L(8); PG8_BAR; PG8_WAIT_L(0); PG8_MMA(0, 0, At, B0); PG8_BAR; PG8_SCHED;
            PG8_LDB(B1, 0, 1); PG8_STAGE(PG8_SB(0, 0), b2, voffB);
            PG8_BAR; PG8_WAIT_L(0); PG8_MMA(0, 1, At, B1); PG8_BAR;
            PG8_LDA(At, 0, 1); PG8_STAGE(PG8_SA(0, 0), a2, voffA);
            PG8_BAR; PG8_WAIT_L(0); PG8_MMA(1, 0, At, B0); PG8_BAR; PG8_SCHED;
            PG8_STAGE(PG8_SB(0, 1), b2 + hstep, voffB);
            PG8_WAIT_V(6); PG8_BAR; PG8_MMA(1, 1, At, B1); PG8_BAR;
            PG8_LDB(B0, 1, 0); PG8_SCHED; PG8_LDA(At, 1, 0); PG8_STAGE(PG8_SA(0, 1), a2 + hstep, voffA);
            PG8_WAIT_L(8); PG8_BAR; PG8_WAIT_L(0); PG8_MMA(0, 0, At, B0); PG8_BAR; PG8_SCHED;
            PG8_LDB(B1, 1, 1); PG8_STAGE(PG8_SB(1, 0), b3, voffB);
            PG8_BAR; PG8_WAIT_L(0); PG8_MMA(0, 1, At, B1); PG8_BAR;
            PG8_LDA(At, 1, 1); PG8_STAGE(PG8_SA(1, 0), a3, voffA);
            PG8_BAR; PG8_WAIT_L(0); PG8_MMA(1, 0, At, B0); PG8_BAR; PG8_SCHED;
            PG8_STAGE(PG8_SB(1, 1), b3 + hstep, voffB);
            PG8_WAIT_V(6); PG8_BAR; PG8_MMA(1, 1, At, B1); PG8_BAR;
            }
        }
        if constexpr (ALIGN_EPI) { if (wr == 0) PG8_BAR; }
        if constexpr (!Epi::AFTER_DRAIN) { E(acc, cur, wr, wc, fr, fq); S.done(cur); }
        if (!S.has(ui + 1)) break;
#pragma unroll
        for (int a = 0; a < 2; ++a)
#pragma unroll
            for (int b = 0; b < 2; ++b)
#pragma unroll
                for (int m = 0; m < 4; ++m)
#pragma unroll
                    for (int n = 0; n < 2; ++n) acc[a][b][m][n] = (f32x4){0.f, 0.f, 0.f, 0.f};
        cur = nxt; cA = nA; cB = nB; ++ui;
        if constexpr (ALIGN_EPI) { if (wr == 1) PG8_BAR; }
    }
    PG8_WAIT_V(0);
    if constexpr (!ALIGN_EPI) { if (wr == 0) PG8_BAR; }
    PG8_BAR;
    if constexpr (Epi::AFTER_DRAIN) { E.fused(acc, cur, wr, wc, fr, fq, lds, wid, lane); S.done(cur); }
#undef PG8_SA
#undef PG8_SB
#undef PG8_STAGE
#undef PG8_LDA
#undef PG8_LDB
#undef PG8_MMA
#undef PG8_WAIT_V
#undef PG8_WAIT_L
#undef PG8_BAR
#undef PG8_SCHED
}
}

struct Ctx {
    LAS unsigned char* lds; int tid, lane, wave, vcu, G;
};
__device__ __forceinline__ Ctx fresh(const Ctx& F0) { Ctx F = F0; const int l = lane_id_fresh(); F.lane = l; F.tid = F0.wave * 64 + l; return F; }

template <bool PERMUTE>
__device__ __forceinline__ void p0_transpose_item(const float* W, int K, int N, bf16_t* WT, LAS float* scr, int item, int lane) {
    const int nblk = N / 32, kb = item / nblk, nb = item % nblk, k0 = 64 * kb, n0 = 32 * nb;
    const int r0 = PERMUTE ? ((n0 & ~255) + 128 * ((n0 >> 5) & 1) + 32 * ((n0 >> 6) & 3)) : n0;
#pragma unroll 8
    for (int i = 0; i < 32; ++i) { const int kk = 2 * i + (lane >> 5); scr[kk * 33 + (lane & 31)] = W[(size_t)(k0 + kk) * N + n0 + (lane & 31)]; }
    LDS_WAIT(); asm volatile("" ::: "memory");
    const int c = lane & 7;
#pragma unroll
    for (int j = 0; j < 4; ++j) { const int n = (lane >> 3) + 8 * j; const LAS float* s = scr + (8 * c) * 33 + n;
        u32x4 o; o.x = pk2(s[0 * 33], s[1 * 33]); o.y = pk2(s[2 * 33], s[3 * 33]); o.z = pk2(s[4 * 33], s[5 * 33]); o.w = pk2(s[6 * 33], s[7 * 33]);
        *(u32x4*)(WT + (size_t)(r0 + n) * K + k0 + 8 * c) = o; }
    LDS_WAIT(); asm volatile("" ::: "memory");
}

__device__ __forceinline__ void phase_prologue(const Ctx& F0, const float* w_in, const float* w_out, const float* c, const float* c_ctx, const float* ada_w, const float* ada_b,
                                               bf16_t* wtin, bf16_t* wtout, float* tab, float* mod) {
    const Ctx F = fresh(F0);
    LAS float* scr = (LAS float*)(F.lds + F.wave * 16384);
    const int gw = F.vcu * NWAVES + F.wave, NGW = F.G * NWAVES;
    constexpr int I_IN = (DM / 64) * (NIN / 32), I_OUT = (MIX / 64) * (DM / 32), NITEMS = 2 * (I_IN + I_OUT);
    for (int it = gw; it < NITEMS; it += NGW) {
        int r = it;
        if (r < I_IN) { p0_transpose_item<true>(w_in, DM, NIN, wtin, scr, r, F.lane); continue; } r -= I_IN;
        if (r < I_IN) { p0_transpose_item<true>(w_in + (size_t)DM * NIN, DM, NIN, wtin + (size_t)NIN * DM, scr, r, F.lane); continue; } r -= I_IN;
        if (r < I_OUT) { p0_transpose_item<false>(w_out, MIX, DM, wtout, scr, r, F.lane); continue; } r -= I_OUT;
        p0_transpose_item<false>(w_out + (size_t)MIX * DM, MIX, DM, wtout + (size_t)DM * MIX, scr, r, F.lane);
    }
    { const int idx = F.vcu * NTHREADS + F.tid;
      if (idx < 128 * 16) { const int pos = idx >> 4, i = idx & 15; const float freq = powf(10000.f, -(float)i / 16.f); const float ang = (float)pos * freq; tab[idx * 2] = cosf(ang); tab[idx * 2 + 1] = sinf(ang); } }
    { const int wk = F.vcu * 2 + (F.tid >> 8), NWK = F.G * 2, t = F.tid & 255;
      for (int it = wk; it < 2 * 16 * 12; it += NWK) {
          const int nb = it % 12, kc = (it / 12) % 16, l = it / 192; const int n = nb * 256 + t;
          float a0 = 0.f, a1 = 0.f, a2 = 0.f;
          const float* w = ada_w + ((size_t)l * DM + kc * 64) * 3072 + n;
#pragma unroll 8
          for (int k = 0; k < 64; ++k) { const float wv = w[(size_t)k * 3072]; const int kk = kc * 64 + k;
              a0 += silu_f(c[kk]) * wv; a1 += silu_f(c[DM + kk]) * wv; a2 += silu_f(c_ctx[kk]) * wv; }
          if (kc == 0) { const float bb = ada_b[l * 3072 + n]; a0 += bb; a1 += bb; a2 += bb; }
          float* p = mod + (size_t)l * 3 * 3072 + n;
          atomicAdd(p, a0); atomicAdd(p + 3072, a1); atomicAdd(p + 2 * 3072, a2);
      } }
}

__device__ __forceinline__ void phase_norm_mod(const Ctx& F0, const float* xlat, const float* xctx, const float* nw, const float* mod, bf16_t* HX) {
    const Ctx F = fresh(F0);
    const int gw = F.vcu * NWAVES + F.wave, NGW = F.G * NWAVES, lane = F.lane;
    for (int row = gw; row < MT; row += NGW) {
        const int v = row < ML ? row / SEQ : 2;
        const float* xr = row < ML ? xlat + (size_t)row * DM : xctx + (size_t)(row - ML) * DM;
        f32x4 xv[4]; float ss = 0.f;
#pragma unroll
        for (int j = 0; j < 4; ++j) { xv[j] = *(const f32x4*)(xr + 256 * j + 4 * lane); ss += xv[j][0] * xv[j][0] + xv[j][1] * xv[j][1] + xv[j][2] * xv[j][2] + xv[j][3] * xv[j][3]; }
        const float rstd = rsqrtf(wave_sum(ss) * (1.f / DM) + EPS);
        const float* shift = mod + (size_t)v * 3072; const float* scale = shift + 1024;
#pragma unroll
        for (int j = 0; j < 4; ++j) {
            const int k = 256 * j + 4 * lane;
            const f32x4 w = *(const f32x4*)(nw + k), sc = *(const f32x4*)(scale + k), sh = *(const f32x4*)(shift + k);
            float y[4];
#pragma unroll
            for (int e = 0; e < 4; ++e) y[e] = xv[j][e] * rstd * w[e] * (1.f + sc[e]) + sh[e];
            uint2 o; o.x = pk2(y[0], y[1]); o.y = pk2(y[2], y[3]);
            *(uint2*)(HX + (size_t)row * DM + k) = o;
        }
    }
}

namespace att {
typedef unsigned short bf16;
using bf16x8=__attribute__((ext_vector_type(8)))short;
using s16x4=__attribute__((ext_vector_type(4)))short;
using f32x16=__attribute__((ext_vector_type(16)))float;
using f32x4=__attribute__((ext_vector_type(4)))float;
using u32x4=__attribute__((ext_vector_type(4)))unsigned;
constexpr int PITCH=4608, UPITCH=1536, GCOL=3072;
constexpr int NW=8,QBLK=32,KVBLK=64;
constexpr int NSLOT=3, SLOTB=8192, OSTR=68  ;
constexpr int LDS_K=0, LDS_V=NSLOT*SLOTB, LDS_WS=2*NSLOT*SLOTB, LDS_OST=LDS_WS+NW*64*4, LDS_BYTES=LDS_OST+NW*32*OSTR*4;
constexpr int LDS_BETA=LDS_BYTES  , LDS_T=LDS_BETA+15*128*4  , LDS_TABLES_END=LDS_T+512;
static_assert(LDS_TABLES_END<=131072,"attention LDS map");
constexpr float L2E=1.4426950408889634f;
struct Unit {
  int type;
  int nt;
  int nlat;
  int ctx0, lat0;
  int first;
  int kcol, vcol;
  int qrow0, tq0;
  int h0, gqa;
  int bias_build;
};
__device__ __forceinline__ int crow(int r,int hi){return (r&3)+8*(r>>2)+4*hi;}
#define SBAR() __builtin_amdgcn_sched_barrier(0)
__device__ __forceinline__ void glds16(const void*gsrc,unsigned lds_dst){unsigned keep;
  asm volatile("s_mov_b32 %0, m0\n\ts_mov_b32 m0, %2\n\ts_nop 0\n\tglobal_load_lds_dwordx4 %1, off\n\ts_mov_b32 m0, %0":"=&s"(keep):"v"(gsrc),"s"(lds_dst):"memory");}
__device__ __forceinline__ float max3f(float a,float b,float c){float r;asm("v_max3_f32 %0, %1, %2, %3":"=v"(r):"v"(a),"v"(b),"v"(c));return r;}
__device__ __forceinline__ float max2f(float a,float b){float r;asm("v_max_f32_e32 %0, %1, %2":"=v"(r):"v"(a),"v"(b));return r;}
__device__ __forceinline__ float fadd_s(float a,float b){float r;asm("v_add_f32_e32 %0, %1, %2":"=v"(r):"v"(a),"v"(b));return r;}
__device__ __forceinline__ float fsub_s(float a,float b){float r;asm("v_sub_f32_e32 %0, %1, %2":"=v"(r):"v"(a),"v"(b));return r;}
typedef float f32x2_t __attribute__((ext_vector_type(2))); typedef __bf16 bf16x2_t __attribute__((ext_vector_type(2)));
__device__ __forceinline__ unsigned cvtpk_s(float lo,float hi){f32x2_t v={lo,hi};bf16x2_t b=__builtin_convertvector(v,bf16x2_t);return __builtin_bit_cast(unsigned,b);}
#define WAIT_BAR(N) asm volatile("s_waitcnt vmcnt(" #N ") lgkmcnt(0)\n\ts_barrier":::"memory")
__device__ __forceinline__ void qkt(f32x16&p0,f32x16&p1,const char*Kslot,const bf16x8*qr,const f32x16&negm,int r32,int hi){
  const char*kb=Kslot+hi*1024+r32*16;
  #pragma unroll
  for(int d0=0;d0<4;++d0){
    const bf16x8 b0=*reinterpret_cast<const bf16x8*>(kb+d0*2048);
    const bf16x8 b1=*reinterpret_cast<const bf16x8*>(kb+d0*2048+512);
    if(d0==0){p0=__builtin_amdgcn_mfma_f32_32x32x16_bf16(b0,qr[0],negm,0,0,0);p1=__builtin_amdgcn_mfma_f32_32x32x16_bf16(b1,qr[0],negm,0,0,0);}
    else{p0=__builtin_amdgcn_mfma_f32_32x32x16_bf16(b0,qr[d0],p0,0,0,0);p1=__builtin_amdgcn_mfma_f32_32x32x16_bf16(b1,qr[d0],p1,0,0,0);}}
}
typedef __attribute__((address_space(3))) const char* lds_cptr;
typedef short v4i16_t __attribute__((ext_vector_type(4)));
__device__ __forceinline__ void kload8(bf16x8*kf,lds_cptr kp){
  kf[0]=*(const __attribute__((address_space(3))) bf16x8*)(kp);      kf[1]=*(const __attribute__((address_space(3))) bf16x8*)(kp+512);
  kf[2]=*(const __attribute__((address_space(3))) bf16x8*)(kp+2048); kf[3]=*(const __attribute__((address_space(3))) bf16x8*)(kp+2560);
  kf[4]=*(const __attribute__((address_space(3))) bf16x8*)(kp+4096); kf[5]=*(const __attribute__((address_space(3))) bf16x8*)(kp+4608);
  kf[6]=*(const __attribute__((address_space(3))) bf16x8*)(kp+6144); kf[7]=*(const __attribute__((address_space(3))) bf16x8*)(kp+6656);
}
__device__ __forceinline__ void kload2(bf16x8*kf,lds_cptr kp,int j){ kf[2*j]=*(const __attribute__((address_space(3))) bf16x8*)(kp+j*2048); kf[2*j+1]=*(const __attribute__((address_space(3))) bf16x8*)(kp+j*2048+512); }
__device__ __forceinline__ s16x4 vtr(lds_cptr p){ return __builtin_bit_cast(s16x4,__builtin_amdgcn_ds_read_tr16_b64_v4i16((__attribute__((address_space(3))) v4i16_t*)p)); }
__device__ __forceinline__ float rowmax(const f32x16&p0,const f32x16&p1){
  float a=max3f(p0[0],p0[1],p1[0]),b=max3f(p0[2],p0[3],p1[1]);a=max3f(a,p1[2],p1[3]);
  #pragma unroll
  for(int r=4;r<16;r+=4){a=max3f(a,p0[r],p0[r+1]);b=max3f(b,p0[r+2],p0[r+3]);a=max3f(a,p1[r],p1[r+1]);b=max3f(b,p1[r+2],p1[r+3]);}
  const float m=max2f(a,b);
  float ma,mb; swap32(m,ma,mb); return max2f(ma,mb);
}
__device__ __forceinline__ void pv(f32x16*o,int vb,bf16x8 pa0,bf16x8 pa1,bf16x8 pa2,bf16x8 pa3){
  #pragma unroll
  for(int d0=0;d0<2;++d0){s16x4 lo[4],hi[4];
    #pragma unroll
    for(int ks=0;ks<4;++ks){
      asm volatile("ds_read_b64_tr_b16 %0,%1 offset:%c2":"=&v"(lo[ks]):"v"(vb),"i"(d0*4096+ks*1024):"memory");
      asm volatile("ds_read_b64_tr_b16 %0,%1 offset:%c2":"=&v"(hi[ks]):"v"(vb),"i"(d0*4096+ks*1024+512):"memory");}
    asm volatile("s_waitcnt lgkmcnt(0)":::"memory");SBAR();
    #define PK(k) (bf16x8){lo[k][0],lo[k][1],lo[k][2],lo[k][3],hi[k][0],hi[k][1],hi[k][2],hi[k][3]}
    o[d0]=__builtin_amdgcn_mfma_f32_32x32x16_bf16(pa0,PK(0),o[d0],0,0,0);
    o[d0]=__builtin_amdgcn_mfma_f32_32x32x16_bf16(pa1,PK(1),o[d0],0,0,0);
    o[d0]=__builtin_amdgcn_mfma_f32_32x32x16_bf16(pa2,PK(2),o[d0],0,0,0);
    o[d0]=__builtin_amdgcn_mfma_f32_32x32x16_bf16(pa3,PK(3),o[d0],0,0,0);
    #undef PK
  }
}
template<int TYPE> __device__ __forceinline__ void amask(f32x16&c0,f32x16&c1,int li,int nlat,int mA,int mB,int u0,int u1,const char*shm){
  const float NEG=-INFINITY;
  bool dead = li>=nlat;
  if(TYPE==1) dead = dead || (unsigned)(li-u0)>=8u;
  if(TYPE==2&&!dead){ const int d=64*li-u0; if(d>=-97&&d<=65) return; }
  if(dead){
    #pragma unroll
    for(int r=0;r<16;++r){c0[r]=NEG;c1[r]=NEG;}
    return; }
  if(TYPE==1){
    const float*brow=(const float*)(shm+LDS_BETA)+(li-u1+7)*128+mB;
    const float*trow=(const float*)(shm+LDS_T)+mA;
    #pragma unroll
    for(int r=0;r<16;++r){ const int kk0=(r&3)+8*(r>>2); c0[r]+=brow[kk0]+trow[kk0]; c1[r]+=brow[kk0+32]+trow[kk0+32]; }
  } else {
    const int base=mA+64*li;
    #pragma unroll
    for(int r=0;r<16;++r){ const int kk0=(r&3)+8*(r>>2);
      if((unsigned)(kk0+base)>256u)c0[r]=NEG; if((unsigned)(kk0+32+base)>256u)c1[r]=NEG; }
  }
}

template<int TYPE,int THRL,bool NOMAX> __device__ __forceinline__ void attn_unit(const Unit&ud,const Unit&nx,const bool has_nx,const bool pre,int&ring,const bf16*__restrict__ P,bf16*__restrict__ U,const float*rpbl,const float*sinkl,char*shm,const int wid){
  int lane; asm volatile("v_mbcnt_lo_u32_b32 %0, -1, 0\n\tv_mbcnt_hi_u32_b32 %0, -1, %0":"=v"(lane));
  const int tid=wid*64+lane,r32=lane&31,hi=lane>>5;
  const int hq=ud.gqa?ud.h0+(wid&3):ud.h0, qoff=ud.gqa?32*(wid>>2):32*wid;
  const int qcol=(TYPE==0?0:TYPE==1?768:2304)+hq*64, ucol=TYPE*512+hq*64;
  const long qrow=ud.qrow0+qoff;
  const bf16*Qw=P+qrow*PITCH+qcol;
  const unsigned lds0=(unsigned)(uintptr_t)shm;
  float*wsf=(float*)(shm+LDS_WS)+wid*64;
  const bf16*ksrc=P+(long)lane*PITCH+ud.kcol+wid*8;
  const bf16*vsrc=P+(long)(16*(wid&3)+(lane>>2))*PITCH+ud.vcol+(wid>>2)*32+(lane&3)*8;
  const unsigned kdst=lds0+LDS_K+wid*1024, vdst=lds0+LDS_V+wid*1024;
  const int NT=ud.nt, nlat=ud.nlat;
  #define TROW(t) ((long)(((t)<4)?(ud.ctx0+64*(t)):(ud.lat0+64*((((t)-4)<nlat)?((t)-4):(nlat-1)))))
  #define DMA_K(t,slot) glds16(ksrc+TROW(t)*PITCH,(unsigned)__builtin_amdgcn_readfirstlane(kdst+(slot)))
  #define DMA_V(t,slot) glds16(vsrc+TROW(t)*PITCH,(unsigned)__builtin_amdgcn_readfirstlane(vdst+(slot)))
  const int vb0=(int)(lds0+LDS_V)+((lane>>4)&1)*32+(lane&3)*8+(4*hi+((lane&15)>>2))*64;
  const char*Kbase=shm+LDS_K; bf16x8 kf[8];
  const lds_cptr shm3=(lds_cptr)shm; const lds_cptr kp0=shm3+LDS_K+hi*1024+r32*16; const lds_cptr vp0=shm3+LDS_V+((lane>>4)&1)*32+(lane&3)*8+(4*hi+((lane&15)>>2))*64;
  int mA=0,mB=0,u0=0,u1=0;
  if(TYPE==1){ const int tqw=ud.tq0+qoff, qg=tqw>>6, qc=(tqw&63)+r32; int rs=qg-4; rs=rs<0?0:(rs>120?120:rs);
    int cs=qc-8; cs=cs<0?0:(cs>48?48:cs); mA=48-cs+4*hi; mB=63-qc+4*hi; u0=rs-ud.first; u1=qg-ud.first;
    float*btw=(float*)(shm+LDS_BETA); if(ud.bias_build) for(int i=tid;i<15*128;i+=512){ const int d=i>>7, ti=(i&127)-48; btw[i]=(ti>=0&&ti<=30)?rpbl[hq*465+d*31+ti]*L2E:0.f; } }
  if(TYPE==2){ const int tq=ud.tq0+qoff+r32; mA=4*hi-(tq-64*ud.first)+128; u0=ud.tq0+qoff-64*ud.first; }
  const int r0=ring, r1=(r0==(NSLOT-1)*SLOTB)?0:r0+SLOTB, r2=(r1==(NSLOT-1)*SLOTB)?0:r1+SLOTB;
  if(!pre){DMA_K(0,r0);DMA_V(0,r0);DMA_K(1,r1);}
  bf16x8 qr[4];
  #pragma unroll
  for(int d0=0;d0<4;++d0)qr[d0]=*reinterpret_cast<const bf16x8*>(&Qw[(long)r32*PITCH+d0*16+hi*8]);
  constexpr bool UNEG=(TYPE==0)&&!NOMAX;
  float mhat=0.f,l_reg=0.f;f32x16 o[2],negm; { float z=0.f; asm volatile("":"+v"(z));
    _Pragma("unroll") for(int r=0;r<16;++r){o[0][r]=z;o[1][r]=z;negm[r]=z;} }
  if(UNEG)asm volatile("":"+v"(negm));
  #define NEGM (UNEG?negm:(f32x16){})
  #define AMASK(P0,P1,t) do{ if(TYPE!=0){ if((t)>=4) amask<TYPE>(P0,P1,(t)-4,nlat,mA,mB,u0,u1,shm); _Pragma("unroll") for(int r=0;r<16;++r){P0[r]-=mhat;P1[r]-=mhat;} } }while(0)
  bool resc=false;
  #define START(P0,P1) do{ resc=false; if(!NOMAX){ const float rm=rowmax(P0,P1); \
    { const float dl=rm; mhat=fadd_s(mhat,dl); \
      _Pragma("unroll") for(int r=0;r<16;++r){P0[r]=fsub_s(P0[r],dl);P1[r]=fsub_s(P1[r],dl);} \
      if(UNEG){ _Pragma("unroll") for(int r=0;r<16;++r)negm[r]=-mhat; asm volatile("":"+v"(negm)); } } } \
    _Pragma("unroll") for(int r=0;r<16;++r)P0[r]=__builtin_amdgcn_exp2f(P0[r]); }while(0)
  #define RESC() do{ if(!NOMAX&&resc){ asm volatile("s_waitcnt lgkmcnt(0)":::"memory"); \
      _Pragma("unroll") for(int d_=0;d_<2;++d_) _Pragma("unroll") for(int r=0;r<16;++r)o[d_][r]*=wsf[crow(r,hi)]; } }while(0)
  f32x16 pA0,pA1,pB0,pB1;
  int sl_prev=r0,sl_cur=r0,sl_next=r1;
  #define ROT() do{sl_prev=sl_cur;sl_cur=sl_next;sl_next=(sl_next==(NSLOT-1)*SLOTB)?0:sl_next+SLOTB;}while(0)
  if(!pre)DMA_K(2,r2);
  WAIT_BAR(3);
  qkt(pA0,pA1,Kbase+r0,qr,NEGM,r32,hi);asm volatile("s_nop 15\n\ts_nop 7":"+v"(pA0),"+v"(pA1));
  START(pA0,pA1);
  _Pragma("unroll") for(int r=0;r<16;++r)pA1[r]=__builtin_amdgcn_exp2f(pA1[r]);
  WAIT_BAR(0);
  DMA_K(3,r0);DMA_V(1,r1);
  ROT();
  kload8(kf,kp0+sl_cur);
  WAIT_BAR(2);
  s16x4 vlo[8],vhi[8]; u32x4 pw0,pw1,pw2,pw3;
  #define PKW(P,B) cvtpk_s(P[B],P[B+1])
  #define PAF(k) __builtin_bit_cast(bf16x8,pw##k)
  #define VFR(i) (bf16x8){vlo[i][0],vlo[i][1],vlo[i][2],vlo[i][3],vhi[i][0],vhi[i][1],vhi[i][2],vhi[i][3]}
  #define PIN(x) asm volatile("":"+v"(x))
  #define MX3(a,b,c) __builtin_fmaxf(__builtin_fmaxf((a),(b)),(c))
  #define GAPA(MF,A0,A1,A2,A3,W0,W1,PW) do{ MF; sacc+=A0; sacc+=A1; sacc+=A2; sacc+=A3; PIN(sacc); W0; W1; PIN(PW); SBAR(); }while(0)
  #define EX(v) __builtin_amdgcn_exp2f(v)
  #define GAPB(MF,X,B) do{ MF; X[B]=EX(X[B]); X[B+1]=EX(X[B+1]); X[B+2]=EX(X[B+2]); X[B+3]=EX(X[B+3]); PIN(X); SBAR(); }while(0)
  #define VRD(i) do{ vlo[i]=vtr(vp_+(((i)>>2)*4096+((i)&3)*1024)); vhi[i]=vtr(vp_+(((i)>>2)*4096+((i)&3)*1024+512)); }while(0)
  #define KRD(G,j) do{ if(G){ kload2(kf,kp0+sl_next,j); SBAR(); } }while(0)
  #define STEP(C0,C1,P0,P1,t,GK,GV,GL) do{ SBAR(); \
    const lds_cptr vp_=vp0+sl_prev; \
    VRD(0); SBAR(); float sacc=(P0[0]+P0[1]); \
    GAPA(C0=__builtin_amdgcn_mfma_f32_32x32x16_bf16(kf[0],qr[0],NEGM,0,0,0), P0[2],P0[3],P0[4],P0[5],     pw0[0]=PKW(P0,0), pw0[1]=PKW(P0,2), pw0); \
    VRD(4); SBAR(); GAPA(C1=__builtin_amdgcn_mfma_f32_32x32x16_bf16(kf[1],qr[0],NEGM,0,0,0), P0[6],P0[7],P0[8],P0[9],     pw0[2]=PKW(P0,4), pw0[3]=PKW(P0,6), pw0); \
    VRD(1); SBAR(); GAPA(C0=__builtin_amdgcn_mfma_f32_32x32x16_bf16(kf[2],qr[1],C0,0,0,0),   P0[10],P0[11],P0[12],P0[13], pw1[0]=PKW(P0,8), pw1[1]=PKW(P0,10), pw1); \
    VRD(5); SBAR(); GAPA(C1=__builtin_amdgcn_mfma_f32_32x32x16_bf16(kf[3],qr[1],C1,0,0,0),   P0[14],P0[15],P1[0],P1[1],   pw1[2]=PKW(P0,12),pw1[3]=PKW(P0,14), pw1); \
    VRD(2); SBAR(); GAPA(C0=__builtin_amdgcn_mfma_f32_32x32x16_bf16(kf[4],qr[2],C0,0,0,0),   P1[2],P1[3],P1[4],P1[5],     pw2[0]=PKW(P1,0), pw2[1]=PKW(P1,2), pw2); \
    VRD(6); SBAR(); GAPA(C1=__builtin_amdgcn_mfma_f32_32x32x16_bf16(kf[5],qr[2],C1,0,0,0),   P1[6],P1[7],P1[8],P1[9],     pw2[2]=PKW(P1,4), pw2[3]=PKW(P1,6), pw2); \
    VRD(3); SBAR(); GAPA(C0=__builtin_amdgcn_mfma_f32_32x32x16_bf16(kf[6],qr[3],C0,0,0,0),   P1[10],P1[11],P1[12],P1[13], pw3[0]=PKW(P1,8), pw3[1]=PKW(P1,10), pw3); \
    VRD(7); SBAR(); GAPA(C1=__builtin_amdgcn_mfma_f32_32x32x16_bf16(kf[7],qr[3],C1,0,0,0),   P1[14],P1[15],0.f,0.f,       pw3[2]=PKW(P1,12),pw3[3]=PKW(P1,14), pw3); \
    l_reg+=sacc; \
    if(GK){DMA_K((t)+3,sl_cur);} if(GV){DMA_V((t)+1,sl_next);} \
    AMASK(C0,C1,t); \
    if(!NOMAX){ float a=MX3(C0[0],C0[1],C1[0]),b=MX3(C0[2],C0[3],C1[1]); a=MX3(a,C1[2],C1[3]); \
      _Pragma("unroll") for(int r=4;r<16;r+=4){a=MX3(a,C0[r],C0[r+1]);b=MX3(b,C0[r+2],C0[r+3]);a=MX3(a,C1[r],C1[r+1]);b=MX3(b,C1[r+2],C1[r+3]);} \
      float rm=__builtin_fmaxf(a,b); { float ma_,mb_; swap32(rm,ma_,mb_); rm=__builtin_fmaxf(ma_,mb_); } \
      resc=false; \
      if(__builtin_expect(__any(rm>(float)THRL),0)){ const float dl=__builtin_fmaxf(rm,0.f); mhat+=dl; \
        _Pragma("unroll") for(int r=0;r<16;++r){C0[r]-=dl;C1[r]-=dl;} \
        if(UNEG){ _Pragma("unroll") for(int r=0;r<16;++r)negm[r]=-mhat; asm volatile("":"+v"(negm)); } \
        const float f=__builtin_amdgcn_exp2f(-dl); l_reg*=f; if(hi==0)wsf[r32]=f; resc=true; } } \
    SBAR(); \
    GAPB(o[0]=__builtin_amdgcn_mfma_f32_32x32x16_bf16(PAF(0),VFR(0),o[0],0,0,0), C0,0); \
    GAPB(o[1]=__builtin_amdgcn_mfma_f32_32x32x16_bf16(PAF(0),VFR(4),o[1],0,0,0), C0,4); \
    KRD(GL,0); GAPB(o[0]=__builtin_amdgcn_mfma_f32_32x32x16_bf16(PAF(1),VFR(1),o[0],0,0,0), C0,8); \
    KRD(GL,1); GAPB(o[1]=__builtin_amdgcn_mfma_f32_32x32x16_bf16(PAF(1),VFR(5),o[1],0,0,0), C0,12); \
    KRD(GL,2); GAPB(o[0]=__builtin_amdgcn_mfma_f32_32x32x16_bf16(PAF(2),VFR(2),o[0],0,0,0), C1,0); \
    KRD(GL,3); GAPB(o[1]=__builtin_amdgcn_mfma_f32_32x32x16_bf16(PAF(2),VFR(6),o[1],0,0,0), C1,4); \
    GAPB(o[0]=__builtin_amdgcn_mfma_f32_32x32x16_bf16(PAF(3),VFR(3),o[0],0,0,0), C1,8); \
    GAPB(o[1]=__builtin_amdgcn_mfma_f32_32x32x16_bf16(PAF(3),VFR(7),o[1],0,0,0), C1,12); \
    }while(0)
  int t=1;
  if(TYPE==0){
    for(;t+5<NT;t+=2){
      STEP(pB0,pB1,pA0,pA1,t,true,true,true);     WAIT_BAR(2); RESC(); ROT();
      STEP(pA0,pA1,pB0,pB1,t+1,true,true,true);   WAIT_BAR(2); RESC(); ROT();
    }
  }
  #define ENDW(tt) do{ if((tt)+3<NT){WAIT_BAR(2);} else if((tt)+2<NT){WAIT_BAR(1);} else {WAIT_BAR(0);} }while(0)
  for(;t+1<NT;t+=2){
    STEP(pB0,pB1,pA0,pA1,t,(t+3<NT),(t+1<NT),(t+1<NT));       ENDW(t);   RESC(); ROT();
    STEP(pA0,pA1,pB0,pB1,t+1,(t+4<NT),(t+2<NT),(t+2<NT));     ENDW(t+1); RESC(); ROT();
  }
  { const int n0=sl_next, n1=(n0==(NSLOT-1)*SLOTB)?0:n0+SLOTB, n2=(n1==(NSLOT-1)*SLOTB)?0:n1+SLOTB;
    if(has_nx){ const bf16*nk=P+(long)lane*PITCH+nx.kcol+wid*8+(long)nx.ctx0*PITCH; const bf16*nv=P+(long)(16*(wid&3)+(lane>>2))*PITCH+nx.vcol+(wid>>2)*32+(lane&3)*8+(long)nx.ctx0*PITCH;
      glds16(nk,(unsigned)__builtin_amdgcn_readfirstlane(kdst+n0)); glds16(nv,(unsigned)__builtin_amdgcn_readfirstlane(vdst+n0));
      glds16(nk+64L*PITCH,(unsigned)__builtin_amdgcn_readfirstlane(kdst+n1)); glds16(nk+128L*PITCH,(unsigned)__builtin_amdgcn_readfirstlane(kdst+n2)); }
    ring=n0; }
  STEP(pB0,pB1,pA0,pA1,NT-1,false,false,false); RESC();
  u32x4 gq[4];
  #pragma unroll
  for(int i=0;i<4;++i) gq[i]=*(const u32x4*)(P+(qrow+i*8+(lane>>3))*PITCH+GCOL+ucol+(lane&7)*8);
  { float sacc=pB0[0]+pB0[1]; _Pragma("unroll") for(int r=2;r<16;++r)sacc+=pB0[r]; _Pragma("unroll") for(int r=0;r<16;++r)sacc+=pB1[r]; l_reg+=sacc;
    pw0=(u32x4){PKW(pB0,0),PKW(pB0,2),PKW(pB0,4),PKW(pB0,6)};pw1=(u32x4){PKW(pB0,8),PKW(pB0,10),PKW(pB0,12),PKW(pB0,14)};pw2=(u32x4){PKW(pB1,0),PKW(pB1,2),PKW(pB1,4),PKW(pB1,6)};pw3=(u32x4){PKW(pB1,8),PKW(pB1,10),PKW(pB1,12),PKW(pB1,14)};
    SBAR(); pv(o,vb0+sl_cur,PAF(0),PAF(1),PAF(2),PAF(3)); }
  #undef PKW
  #undef PAF
  #undef VFR
  #undef PIN
  #undef MX3
  #undef GAPA
  #undef GAPB
  #undef EX
  #undef VRD
  #undef KRD
  #undef STEP
  #undef ENDW
  { float la,lb; swap32(l_reg,la,lb); l_reg=la+lb; }
  if(TYPE==2) l_reg+=__builtin_amdgcn_exp2f(sinkl[hq]*L2E-mhat);
  if(hi==0)wsf[32+r32]=l_reg;asm volatile("s_waitcnt lgkmcnt(0)":::"memory");
  float rli[16];
  #pragma unroll
  for(int r=0;r<16;++r)rli[r]=__builtin_amdgcn_rcpf(wsf[32+crow(r,hi)]);
  { float*stg=(float*)(shm+LDS_OST)+wid*(32*OSTR);
    #pragma unroll
    for(int r=0;r<16;++r){const int orow=crow(r,hi);
      #pragma unroll
      for(int d0=0;d0<2;++d0)stg[orow*OSTR+d0*32+r32]=o[d0][r]*rli[r];}
    asm volatile("s_waitcnt lgkmcnt(0)":::"memory");
    #pragma unroll
    for(int i=0;i<4;++i){const int row=i*8+(lane>>3),ch=lane&7;
      const f32x4 a=*(const f32x4*)(stg+row*OSTR+ch*8), b=*(const f32x4*)(stg+row*OSTR+ch*8+4);
      const u32x4 g=gq[i];
      u32x4 w;
      w.x=cvtpk_s(a[0]*__uint_as_float(g.x<<16),a[1]*__uint_as_float(g.x&0xffff0000u)); w.y=cvtpk_s(a[2]*__uint_as_float(g.y<<16),a[3]*__uint_as_float(g.y&0xffff0000u));
      w.z=cvtpk_s(b[0]*__uint_as_float(g.z<<16),b[1]*__uint_as_float(g.z&0xffff0000u)); w.w=cvtpk_s(b[2]*__uint_as_float(g.w<<16),b[3]*__uint_as_float(g.w&0xffff0000u));
      *(u32x4*)(U+(qrow+row)*UPITCH+ucol+ch*8)=w; } }
  asm volatile("s_waitcnt lgkmcnt(0)\n\ts_barrier":::"memory");
  #undef TROW
  #undef DMA_K
  #undef DMA_V
  #undef AMASK
  #undef START
  #undef NEGM
  #undef RESC
  #undef ROT
}
constexpr int THRL_DEFAULT=8;
__device__ __forceinline__ Unit unit_A(int ua){ Unit u; const int b=ua>>8,h=(ua>>5)&7,qb=ua&31; u.type=0; u.nt=132; u.nlat=128; u.ctx0=16384+256*b; u.lat0=8192*b; u.first=0;
  u.kcol=512+64*(h>>2); u.vcol=640+64*(h>>2); u.qrow0=8192*b+256*qb; u.tq0=256*qb; u.h0=h; u.gqa=0; u.bias_build=0; return u; }
__device__ __forceinline__ Unit unit_B(int ub){ Unit u; const int b=ub>>8,h=(ub>>5)&7,qb=ub&31; u.type=1;
  int f=4*qb-4; f=f<0?0:(f>120?120:f); int l=4*qb+3-4; l=l<0?0:(l>120?120:l); l+=7;
  u.first=f; u.nlat=l-f+1; u.nt=(4+u.nlat+1)&~1; u.ctx0=16384+256*b; u.lat0=8192*b+64*f;
  u.kcol=1280+64*h; u.vcol=1792+64*h; u.qrow0=8192*b+256*qb; u.tq0=256*qb; u.h0=h; u.gqa=0; u.bias_build=1; return u; }
__device__ __forceinline__ Unit unit_C(int uc){ Unit u; const int b=uc>>8,kvh=(uc>>7)&1,qb=uc&127; u.type=2;
  const int f=qb-2<0?0:qb-2, l=qb+2>127?127:qb+2;
  u.first=f; u.nlat=l-f+1; u.nt=(4+u.nlat+1)&~1; u.ctx0=16384+256*b; u.lat0=8192*b+64*f;
  u.kcol=2816+64*kvh; u.vcol=2944+64*kvh; u.qrow0=8192*b+64*qb; u.tq0=64*qb; u.h0=4*kvh; u.gqa=1; u.bias_build=0; return u; }
__device__ __forceinline__ Unit unit_ctx(int ux){ Unit u; const int type=ux>>4,b=(ux>>3)&1,h=ux&7; u.type=type; u.nt=4; u.nlat=0; u.ctx0=16384+256*b; u.lat0=0; u.first=0;
  const int kvh=(type==1)?h:(h>>2); u.kcol=(type==0?512:type==1?1280:2816)+64*kvh; u.vcol=(type==0?640:type==1?1792:2944)+64*kvh;
  u.qrow0=16384+256*b; u.tq0=0; u.h0=h; u.gqa=0; u.bias_build=1; return u; }
__device__ __forceinline__ void run_unit(const Unit&u,const Unit&nx,const bool has_nx,const bool pre,int&ring,const bf16*P,bf16*U,const float*rpbl,const float*sinkl,char*lds,const int wid,const bool nomaxA){
  if(u.type==0){ if(nomaxA) attn_unit<0,THRL_DEFAULT,true>(u,nx,has_nx,pre,ring,P,U,rpbl,sinkl,lds,wid); else attn_unit<0,THRL_DEFAULT,false>(u,nx,has_nx,pre,ring,P,U,rpbl,sinkl,lds,wid); }
  else if(u.type==1) attn_unit<1,THRL_DEFAULT,false>(u,nx,has_nx,pre,ring,P,U,rpbl,sinkl,lds,wid);
  else attn_unit<2,THRL_DEFAULT,false>(u,nx,has_nx,pre,ring,P,U,rpbl,sinkl,lds,wid);
}
__device__ __forceinline__ Unit get_unit(int vv,int i){ if(i<2) return unit_A(2*vv+i); if(i<4){ Unit u=unit_B(2*vv+i-2); u.bias_build=(i==2)?1:0; return u; } if(i<6) return unit_C(2*vv+i-4); return unit_ctx(vv); }
__device__ __forceinline__ void attn_phase(int vcu,int G,const bf16*P,bf16*U,const float*rpbl,const float*sinkl,const float*qnl,const float*knl,bool need_ctx,char*lds,const int wid){
  bool nomaxA; { const int l=lane_id_fresh(); float a=fabsf(qnl[l]),b=fabsf(knl[l]);
    a=wave_max(a); b=wave_max(b);
    nomaxA=__builtin_amdgcn_readfirstlane((int)(11.6f*a*b<80.f))!=0;
    float*tt=(float*)(lds+LDS_T); { const int i=wid*64+l; if(i<128){ const int x=i-48; tt[i]=(x>=0&&x<16)?0.f:-INFINITY; } }
    __syncthreads(); }
  int ring=0; bool pre=false;
  for(int vv=vcu;vv<256;vv+=G){
    const int n=6+((need_ctx&&vv<48)?1:0);
    for(int i=0;i<n;++i){
      const Unit cur=get_unit(vv,i); const bool has_nx=i+1<n; const Unit nx=get_unit(vv,has_nx?i+1:i);
      run_unit(cur,nx,has_nx,pre,ring,P,U,rpbl,sinkl,lds,wid,nomaxA); pre=has_nx; } }
}
#undef SBAR
#undef WAIT_BAR
}

__device__ __forceinline__ void phase_final_norm(const Ctx& F0, float* x, const float* w) {
    const Ctx F = fresh(F0);
    const int gw = F.vcu * NWAVES + F.wave, NGW = F.G * NWAVES, lane = F.lane;
    for (int row = gw; row < ML; row += NGW) {
        float* xr = x + (size_t)row * DM;
        f32x4 xv[4]; float ss = 0.f;
#pragma unroll
        for (int j = 0; j < 4; ++j) { xv[j] = *(const f32x4*)(xr + 256 * j + 4 * lane); ss += xv[j][0] * xv[j][0] + xv[j][1] * xv[j][1] + xv[j][2] * xv[j][2] + xv[j][3] * xv[j][3]; }
        const float rstd = rsqrtf(wave_sum(ss) * (1.f / DM) + EPS);
#pragma unroll
        for (int j = 0; j < 4; ++j) { const f32x4 wv = *(const f32x4*)(w + 256 * j + 4 * lane); f32x4 y = xv[j] * rstd * wv; *(f32x4*)(xr + 256 * j + 4 * lane) = y; }
    }
}

__device__ __forceinline__ void ctx_out_proj(const Ctx& F0, const bf16_t* U, const bf16_t* WT, const float* mod, const float* xctx_in, const float* nw_next, const float* mod_next, bf16_t* An, float* ss) {
    const Ctx F = fresh(F0);
    const int lane = F.lane, fr = lane & 15, fq = lane >> 4, w = F.wave;
    LAS float* red = (LAS float*)F.lds;
    for (int it = F.vcu; it < 256; it += F.G) {
        const int row0 = ML + (it >> 4) * 32, col0 = (it & 15) * 64;
        f32x4 acc[2][4];
#pragma unroll
        for (int m = 0; m < 2; ++m)
#pragma unroll
            for (int n = 0; n < 4; ++n) acc[m][n] = (f32x4){0.f, 0.f, 0.f, 0.f};
        const bf16_t* ap = U + (size_t)(row0 + fr) * MIX + w * 192 + 8 * fq;
        const bf16_t* bp = WT + (size_t)(col0 + fr) * MIX + w * 192 + 8 * fq;
#pragma unroll
        for (int k0 = 0; k0 < 192; k0 += 32) {
            bf16x8 a[2], b[4];
#pragma unroll
            for (int m = 0; m < 2; ++m) a[m] = *(const bf16x8*)(ap + (size_t)(16 * m) * MIX + k0);
#pragma unroll
            for (int n = 0; n < 4; ++n) b[n] = *(const bf16x8*)(bp + (size_t)(16 * n) * MIX + k0);
#pragma unroll
            for (int m = 0; m < 2; ++m)
#pragma unroll
                for (int n = 0; n < 4; ++n) acc[m][n] = __builtin_amdgcn_mfma_f32_16x16x32_bf16(a[m], b[n], acc[m][n], 0, 0, 0);
        }
#pragma unroll
        for (int m = 0; m < 2; ++m)
#pragma unroll
            for (int n = 0; n < 4; ++n)
#pragma unroll
                for (int r = 0; r < 4; ++r) red[(w * 32 + 16 * m + 4 * fq + r) * 64 + 16 * n + fr] = acc[m][n][r];
        __syncthreads();
        const float* gate = mod + 2 * 3072 + 2048;
        const int col = col0 + lane;
        const float gnc = nw_next[col] * (1.f + mod_next[2 * 3072 + 1024 + col]);
#pragma unroll
        for (int j = 0; j < 4; ++j) {
            const int row = w + 8 * j;
            float s = 0.f;
#pragma unroll
            for (int ww = 0; ww < 8; ++ww) s += red[(ww * 32 + row) * 64 + lane];
            const size_t o = (size_t)(row0 - ML + row) * DM + col;
            const float xn = xctx_in[o] + gate[col] * s;
            An[(size_t)(row0 + row) * DM + col] = (bf16_t)f2bf(xn * gnc);
            const float sq = wave_sum(xn * xn);
            if (lane == 0) atomicAdd(ss + row0 + row, sq);
        }
        __syncthreads();
    }
}

__device__ __forceinline__ void phase_shift_w(const Ctx& F0, const bf16_t* WT, const float* mod_next, float* sw) {
    const Ctx F = fresh(F0);
    const int gw = F.vcu * NWAVES + F.wave, NGW = F.G * NWAVES, lane = F.lane;
    for (int p = gw; p < NIN; p += NGW) {
        const int ncol = (p & ~255) + 64 * ((p >> 5) & 3) + 32 * ((p >> 7) & 1) + (p & 31);
        const u32x4 w0 = *(const u32x4*)(WT + (size_t)p * DM + 16 * lane), w1 = *(const u32x4*)(WT + (size_t)p * DM + 16 * lane + 8);
        float wf[16];
        wf[0] = bf2f(w0.x & 0xffffu); wf[1] = bf2f(w0.x >> 16); wf[2] = bf2f(w0.y & 0xffffu); wf[3] = bf2f(w0.y >> 16); wf[4] = bf2f(w0.z & 0xffffu); wf[5] = bf2f(w0.z >> 16); wf[6] = bf2f(w0.w & 0xffffu); wf[7] = bf2f(w0.w >> 16);
        wf[8] = bf2f(w1.x & 0xffffu); wf[9] = bf2f(w1.x >> 16); wf[10] = bf2f(w1.y & 0xffffu); wf[11] = bf2f(w1.y >> 16); wf[12] = bf2f(w1.z & 0xffffu); wf[13] = bf2f(w1.z >> 16); wf[14] = bf2f(w1.w & 0xffffu); wf[15] = bf2f(w1.w >> 16);
#pragma unroll
        for (int v = 0; v < 3; ++v) {
            const float* sh = mod_next + (size_t)v * 3072 + 16 * lane; float s = 0.f;
#pragma unroll
            for (int q = 0; q < 4; ++q) { const f32x4 t = *(const f32x4*)(sh + 4 * q); s += t[0] * wf[4 * q] + t[1] * wf[4 * q + 1] + t[2] * wf[4 * q + 2] + t[3] * wf[4 * q + 3]; }
            s = wave_sum(s);
            if (lane == 0) sw[v * NIN + ncol] = s;
        }
    }
}

struct Args { const float* in[14]; float* out; unsigned char* ws; int ph_lo, ph_hi; };
typedef const Args __attribute__((address_space(4))) * KArgs;
__device__ __forceinline__ KArgs kargs() { KArgs p = (KArgs)__builtin_amdgcn_kernarg_segment_ptr(); asm volatile("" : "+s"(p)); return p; }
__global__ void __launch_bounds__(NTHREADS, 2) fwd_kernel(Args args_unused) {
    extern __shared__ __attribute__((aligned(16))) unsigned char lds[];
    Ctx F;
    F.lds = (LAS unsigned char*)lds;
    F.wave = __builtin_amdgcn_readfirstlane((int)threadIdx.x >> 6); F.lane = lane_id_fresh(); F.tid = F.wave * 64 + F.lane;
    F.G = gridDim.x; { const int bx = blockIdx.x; F.vcu = (F.G % 8 == 0) ? (bx % 8) * (F.G / 8) + bx / 8 : bx; }
    volatile LAS unsigned* MISC = (volatile LAS unsigned*)(F.lds + MISC_OFF);
    for (int u = F.tid; u < (LDS_BYTES - LDSCTL_OFF) / 4; u += NTHREADS) ((LAS unsigned*)(F.lds + LDSCTL_OFF))[u] = 0u;
    __syncthreads();
    XcdBarrier bar;
    { KArgs A = kargs(); bar = xcd_barrier_post((unsigned*)(A->ws + WS_CTL) + CW_BAR, MISC + 8); }
#define SEAM() do { KArgs A_ = kargs(); bar.bar = (unsigned*)(A_->ws + WS_CTL) + CW_BAR; xcd_barrier(bar, F.wave); } while (0)
#define WSP(T, off) ((T*)(A->ws + (off)))
    { KArgs A = kargs(); phase_prologue(F, A->in[7], A->in[8], A->in[1], A->in[3], A->in[5], A->in[6], WSP(bf16_t, WS_WTIN), WSP(bf16_t, WS_WTOUT), WSP(float, WS_TAB), WSP(float, WS_MOD)); }
    SEAM();
    { KArgs A = kargs(); phase_norm_mod(F, A->in[0], A->in[2], A->in[4], WSP(float, WS_MOD), WSP(bf16_t, WS_HX));
      phase_shift_w(F, WSP(bf16_t, WS_WTIN) + (size_t)NIN * DM, WSP(float, WS_MOD) + 3 * 3072, WSP(float, WS_SW)); }
    SEAM();
#pragma unroll
    for (int l = 0; l < 2; ++l) {
        { KArgs A = kargs(); pg8::Gemm g{WSP(bf16_t, WS_HX), WSP(bf16_t, WS_WTIN) + (size_t)l * NIN * DM, MT, NIN, DM}; pg8::StaticOrder S; S.init(MT, NIN, F.G, (int)blockIdx.x);
            pg8::EpiIn E{WSP(bf16_t, WS_P), A->in[9] + l * 64, A->in[10] + l * 64, WSP(float, WS_TAB), WSP(float, WS_SS), WSP(float, WS_SW), l};
            pg8::gemm_phase<pg8::EpiIn, pg8::StaticOrder, true, true>(F.lds, g, S, E, F.wave);
            if (PROBE_REP & 2) pg8::gemm_phase<pg8::EpiIn, pg8::StaticOrder, true, true>(F.lds, g, S, E, F.wave); }
        SEAM();
        { KArgs A = kargs(); att::attn_phase(F.vcu, F.G, WSP(bf16_t, WS_P), WSP(bf16_t, WS_U), A->in[11] + (size_t)l * 8 * 465, A->in[12] + l * 8, A->in[9] + l * 64, A->in[10] + l * 64, l == 0, (char*)lds, F.wave);
            if (PROBE_REP & 1) att::attn_phase(F.vcu, F.G, WSP(bf16_t, WS_P), WSP(bf16_t, WS_U), A->in[11] + (size_t)l * 8 * 465, A->in[12] + l * 8, A->in[9] + l * 64, A->in[10] + l * 64, l == 0, (char*)lds, F.wave); }
        SEAM();
        { KArgs A = kargs(); const float* modl = WSP(float, WS_MOD) + (size_t)l * 3 * 3072; const float* xl = l == 0 ? A->in[0] : A->out;
            if (l == 0) ctx_out_proj(F, WSP(bf16_t, WS_U), WSP(bf16_t, WS_WTOUT), modl, A->in[2], A->in[4] + DM, WSP(float, WS_MOD) + 3 * 3072, WSP(bf16_t, WS_HX), WSP(float, WS_SS));
            pg8::Gemm g{WSP(bf16_t, WS_U), WSP(bf16_t, WS_WTOUT) + (size_t)l * DM * MIX, ML, DM, MIX}; pg8::StaticOrder S; S.init(ML, DM, F.G, (int)blockIdx.x);
            pg8::EpiOut E{modl, xl, A->out, l == 0 ? 1 : 0, A->in[4] + DM, WSP(float, WS_MOD) + 3 * 3072, WSP(bf16_t, WS_HX), WSP(float, WS_SS)};
            pg8::gemm_phase<pg8::EpiOut, pg8::StaticOrder, true, true>(F.lds, g, S, E, F.wave); }
        SEAM();
    }
    { KArgs A = kargs(); phase_final_norm(F, A->out, A->in[13]); }
#undef SEAM
#undef WSP
}

extern "C" void kernel_launch(void* const* d_in, const int* in_sizes, int n_in, void* d_out, int out_size, void* d_ws, size_t ws_size, hipStream_t stream) {
    static int grid = 0;
    if (grid == 0) {
        int dev = 0, cus = 0, per_cu = 0;
        if (n_in != 14 || ws_size < WS_END) { fprintf(stderr, "kernel_launch: unexpected inputs / workspace\n"); grid = -1; return; }
        if (hipGetDevice(&dev) != hipSuccess || hipDeviceGetAttribute(&cus, hipDeviceAttributeMultiprocessorCount, dev) != hipSuccess) { grid = -1; return; }
        if (hipFuncSetAttribute((const void*)fwd_kernel, hipFuncAttributeMaxDynamicSharedMemorySize, LDS_BYTES) != hipSuccess) { fprintf(stderr, "kernel_launch: hipFuncSetAttribute failed\n"); grid = -1; return; }
        if (hipOccupancyMaxActiveBlocksPerMultiprocessor(&per_cu, (const void*)fwd_kernel, NTHREADS, LDS_BYTES) != hipSuccess || per_cu < 1) { fprintf(stderr, "kernel_launch: occupancy query says %d\n", per_cu); }
        (void)hipGetLastError();
        grid = cus;
    }
    if (grid < 0) return;
    (void)hipMemsetAsync((char*)d_ws + WS_CTL, 0, CTL_ZERO_BYTES, stream);
    Args a{};
    for (int i = 0; i < 14; ++i) a.in[i] = (const float*)d_in[i];
    a.out = (float*)d_out; a.ws = (unsigned char*)d_ws;
    a.ph_lo = 0; a.ph_hi = NPHASES;
    hipLaunchKernelGGL(fwd_kernel, dim3(grid), dim3(NTHREADS), LDS_BYTES, stream, a);
}
```
